# Optimizing an MI355X kernel written in HIP

```python
import jax, jax.numpy as jnp
from jax import lax
import numpy as np

D_MODEL = 2048
BATCH = 4
SEQ = 8192
DEPTH = 2

HEAD_DIM = 128
N_HEADS_SB = 8
N_HEADS_FOX = 8
N_HEADS_DSA = 8
N_KV_DSA = 2
IDX_HEADS = 16
IDX_DIM = 64
TOPK_MAX = 256
Q_BLOCK = 128
ROPE_THETA = 10000.0
NORM_EPS = 1e-6
N_BRANCH = 3
BRANCH_WIDTH = N_HEADS_SB * HEAD_DIM
SB_W = N_HEADS_SB * HEAD_DIM
FOX_W = N_HEADS_FOX * HEAD_DIM
DSA_W = N_HEADS_DSA * HEAD_DIM
DSA_KV_W = N_KV_DSA * HEAD_DIM
D_FF = -(-8 * D_MODEL // (3 * 256)) * 256
IN_SIZES = (SB_W, SB_W, SB_W,
            FOX_W, FOX_W, FOX_W, N_HEADS_FOX,
            DSA_W, DSA_KV_W, DSA_KV_W,
            IDX_HEADS * IDX_DIM, IDX_DIM, IDX_HEADS)
D_IN = sum(IN_SIZES)

kernel_name = "hybrid_sb_fox_dsa_gated_block"


def rmsnorm(x, g):
    xf = x.astype(jnp.float32)
    y = xf * lax.rsqrt(jnp.mean(xf * xf, axis=-1, keepdims=True) + NORM_EPS)
    return (y * g.astype(jnp.float32)).astype(x.dtype)


def rope_tables(seq, dim):
    inv = 1.0 / (ROPE_THETA ** (jnp.arange(0, dim, 2, dtype=jnp.float32) / dim))
    ang = jnp.arange(seq, dtype=jnp.float32)[:, None] * inv[None, :]
    return jnp.cos(ang), jnp.sin(ang)


def apply_rope(x, cos, sin):
    xf = x.astype(jnp.float32)
    x1, x2 = jnp.split(xf, 2, axis=-1)
    c = cos[None, :, None, :]
    s = sin[None, :, None, :]
    return jnp.concatenate([x1 * c - x2 * s, x2 * c + x1 * s], axis=-1).astype(x.dtype)


def to_blocks(a):
    b, s = a.shape[0], a.shape[1]
    return jnp.moveaxis(a.reshape((b, s // Q_BLOCK, Q_BLOCK) + a.shape[2:]), 1, 0)


def from_blocks(a):
    a = jnp.moveaxis(a, 0, 1)
    return a.reshape((a.shape[0], a.shape[1] * a.shape[2]) + a.shape[3:])


def block_starts(seq):
    return jnp.arange(seq // Q_BLOCK, dtype=jnp.int32) * Q_BLOCK


def stick_breaking_attention(q, k, v):
    S, d = q.shape[1], q.shape[3]
    scale = d ** -0.5
    spos = jnp.arange(S, dtype=jnp.int32)

    def block(args):
        qb, t0 = args
        tpos = t0 + jnp.arange(Q_BLOCK, dtype=jnp.int32)
        strict = (spos[None, :] < tpos[:, None])[None, None]
        z = jnp.einsum('bqhd,bshd->bhqs', qb, k).astype(jnp.float32) * scale
        log_keep = jnp.where(strict, jax.nn.log_sigmoid(-z), 0.0)
        log_after = lax.cumsum(log_keep, axis=3, reverse=True) - log_keep
        a = jnp.where(strict, jnp.exp(jax.nn.log_sigmoid(z) + log_after), 0.0)
        return jnp.einsum('bhqs,bshd->bqhd', a.astype(v.dtype), v)

    return from_blocks(lax.map(block, (to_blocks(q), block_starts(S))))


def forgetting_attention(q, k, v, log_f):
    S, d = q.shape[1], q.shape[3]
    scale = d ** -0.5
    spos = jnp.arange(S, dtype=jnp.int32)
    c = jnp.cumsum(log_f, axis=1)
    c_keys = jnp.transpose(c, (0, 2, 1))[:, :, None, :]

    def block(args):
        qb, cb, t0 = args
        tpos = t0 + jnp.arange(Q_BLOCK, dtype=jnp.int32)
        causal = (spos[None, :] <= tpos[:, None])[None, None]
        logits = (jnp.einsum('bqhd,bshd->bhqs', qb, k).astype(jnp.float32) * scale
                  + jnp.transpose(cb, (0, 2, 1))[..., None] - c_keys)
        p = jax.nn.softmax(jnp.where(causal, logits, -jnp.inf), axis=-1)
        return jnp.einsum('bhqs,bshd->bqhd', p.astype(v.dtype), v)

    return from_blocks(lax.map(block, (to_blocks(q), to_blocks(c), block_starts(S))))


def dsa_sparse_attention(q, k, v, iq, ik, iw, topk):
    B, S, H, d = q.shape
    G = k.shape[2]
    R = H // G
    scale = d ** -0.5
    idx_scale = IDX_DIM ** -0.5
    spos = jnp.arange(S, dtype=jnp.int32)

    def block(args):
        qb, iqb, iwb, t0 = args
        tpos = t0 + jnp.arange(Q_BLOCK, dtype=jnp.int32)
        causal = (spos[None, :] <= tpos[:, None])[None]
        rel = jax.nn.relu(jnp.einsum('bqhe,bse->bqhs', iqb, ik).astype(jnp.float32) * idx_scale)
        score = jnp.einsum('bqh,bqhs->bqs', iwb.astype(jnp.float32), rel)
        score = jnp.where(causal, score, -jnp.inf)
        _, sel = lax.top_k(score, topk)
        k_sel = jax.vmap(lambda kb, ib: kb[ib])(k, sel)
        v_sel = jax.vmap(lambda vb, ib: vb[ib])(v, sel)
        valid = (sel <= tpos[None, :, None])[:, :, None, None, :]
        qg = qb.reshape(B, Q_BLOCK, G, R, d)
        logits = jnp.einsum('bqgrd,bqkgd->bqgrk', qg, k_sel).astype(jnp.float32) * scale
        p = jax.nn.softmax(jnp.where(valid, logits, -jnp.inf), axis=-1)
        o = jnp.einsum('bqgrk,bqkgd->bqgrd', p.astype(v.dtype), v_sel)
        return o.reshape(B, Q_BLOCK, H, d)

    return from_blocks(lax.map(block, (to_blocks(q), to_blocks(iq), to_blocks(iw), block_starts(S))))


def hybrid_layer(x, cos_h, sin_h, cos_i, sin_i, topk,
                 norm_mix_g, w_in, fox_f_bias, fox_q_g, fox_k_g, dsa_q_g, dsa_k_g,
                 w_gate, w_branch, w_out, norm_ffn_g, w_ffn_gate, w_ffn_up, w_ffn_down):
    B, S, _ = x.shape
    h = rmsnorm(x, norm_mix_g)
    points = np.cumsum(IN_SIZES)[:-1].tolist()
    (sb_q, sb_k, sb_v, fox_q, fox_k, fox_v, fox_f,
     dsa_q, dsa_k, dsa_v, idx_q, idx_k, idx_w) = jnp.split(h @ w_in, points, axis=-1)
    heads = lambda a, n: a.reshape(B, S, n, -1)

    o_sb = stick_breaking_attention(heads(sb_q, N_HEADS_SB), heads(sb_k, N_HEADS_SB),
                                    heads(sb_v, N_HEADS_SB))

    log_f = jax.nn.log_sigmoid(fox_f.astype(jnp.float32) + fox_f_bias.astype(jnp.float32))
    o_fox = forgetting_attention(rmsnorm(heads(fox_q, N_HEADS_FOX), fox_q_g),
                                 rmsnorm(heads(fox_k, N_HEADS_FOX), fox_k_g),
                                 heads(fox_v, N_HEADS_FOX), log_f)

    qc = apply_rope(rmsnorm(heads(dsa_q, N_HEADS_DSA), dsa_q_g), cos_h, sin_h)
    kc = apply_rope(rmsnorm(heads(dsa_k, N_KV_DSA), dsa_k_g), cos_h, sin_h)
    iq = apply_rope(heads(idx_q, IDX_HEADS), cos_i, sin_i)
    ik = apply_rope(idx_k[:, :, None, :], cos_i, sin_i)[:, :, 0, :]
    iw = idx_w * (IDX_HEADS ** -0.5)
    o_dsa = dsa_sparse_attention(qc, kc, heads(dsa_v, N_KV_DSA), iq, ik, iw, topk)

    merged = None
    for i, o in enumerate((o_sb, o_fox, o_dsa)):
        y = jax.nn.sigmoid(h @ w_gate[i]) * (o.reshape(B, S, BRANCH_WIDTH) @ w_branch[i])
        merged = y if merged is None else merged + y
    x = x + merged @ w_out

    h2 = rmsnorm(x, norm_ffn_g)
    return x + (jax.nn.silu(h2 @ w_ffn_gate) * (h2 @ w_ffn_up)) @ w_ffn_down


def setup_inputs(seed: int = 0) -> dict:
    key = jax.random.key(seed)
    ks = jax.random.split(key, 16)
    f32 = jnp.float32

    def dense(k, shape, fan_in):
        return jax.random.normal(k, shape, f32) * (fan_in ** -0.5)

    def gain(k, shape):
        return 1.0 + 0.02 * jax.random.normal(k, shape, f32)

    return {
        "x": jax.random.normal(ks[0], (BATCH, SEQ, D_MODEL), f32),
        "norm_mix_g": gain(ks[1], (DEPTH, D_MODEL)),
        "w_in": dense(ks[2], (DEPTH, D_MODEL, D_IN), D_MODEL),
        "fox_f_bias": jax.random.uniform(ks[3], (DEPTH, N_HEADS_FOX), f32, 1.0, 4.0),
        "fox_q_g": gain(ks[4], (DEPTH, HEAD_DIM)),
        "fox_k_g": gain(ks[5], (DEPTH, HEAD_DIM)),
        "dsa_q_g": gain(ks[6], (DEPTH, HEAD_DIM)),
        "dsa_k_g": gain(ks[7], (DEPTH, HEAD_DIM)),
        "w_gate": dense(ks[8], (DEPTH, N_BRANCH, D_MODEL, D_MODEL), D_MODEL),
        "w_branch": dense(ks[9], (DEPTH, N_BRANCH, BRANCH_WIDTH, D_MODEL), BRANCH_WIDTH),
        "w_out": dense(ks[10], (DEPTH, D_MODEL, D_MODEL), D_MODEL),
        "norm_ffn_g": gain(ks[11], (DEPTH, D_MODEL)),
        "w_ffn_gate": dense(ks[12], (DEPTH, D_MODEL, D_FF), D_MODEL),
        "w_ffn_up": dense(ks[13], (DEPTH, D_MODEL, D_FF), D_MODEL),
        "w_ffn_down": dense(ks[14], (DEPTH, D_FF, D_MODEL), D_FF),
    }


def reference(x, norm_mix_g, w_in, fox_f_bias, fox_q_g, fox_k_g, dsa_q_g, dsa_k_g,
              w_gate, w_branch, w_out, norm_ffn_g, w_ffn_gate, w_ffn_up, w_ffn_down):
    S = x.shape[1]
    topk = min(TOPK_MAX, S // 4)
    cos_h, sin_h = rope_tables(S, HEAD_DIM)
    cos_i, sin_i = rope_tables(S, IDX_DIM)
    for l in range(DEPTH):
        x = hybrid_layer(x, cos_h, sin_h, cos_i, sin_i, topk,
                         norm_mix_g[l], w_in[l], fox_f_bias[l], fox_q_g[l], fox_k_g[l],
                         dsa_q_g[l], dsa_k_g[l], w_gate[l], w_branch[l], w_out[l],
                         norm_ffn_g[l], w_ffn_gate[l], w_ffn_up[l], w_ffn_down[l])
    return x
```

```cpp
#include <hip/hip_runtime.h>
#include <cstdio>
#include <cstdint>
#include <cmath>
namespace pg8 {
#define PG8_LAS __attribute__((address_space(3)))
typedef unsigned short bf16_t;
typedef short bf16x8 __attribute__((ext_vector_type(8)));
typedef float f32x4 __attribute__((ext_vector_type(4)));
typedef unsigned u32x4 __attribute__((ext_vector_type(4)));
constexpr int BM = 256, BK = 64, HALF = 128, HTB = HALF * BK * 2  , STAGE_BYTES = 8 * HTB, NXCD = 8, WGM = 8;

__host__ __device__ __forceinline__ int lds_byte(int r, int c) { const int st = (r >> 4) * 2 + (c >> 5), rr = r & 15, cc = c & 31, ob = rr * 64 + cc * 2; return st * 1024 + (ob ^ (((ob >> 9) & 1) << 5)); }
__host__ __device__ __forceinline__ void stage_rc(int b, int& R, int& C) { const int st = b / 1024, sb = b % 1024, swz = sb ^ (((sb >> 9) & 1) << 5); R = (st >> 1) * 16 + swz / 64; C = (st & 1) * 32 + (swz % 64) / 2; }
__host__ __device__ __forceinline__ int perm32(int rho) { const int n = rho >> 4, i = rho & 15; return 8 * (i >> 2) + 4 * n + (i & 3); }

struct Unit { int pm, pn, ag; };
struct Gemm { const bf16_t* A; const bf16_t* Bt; int M, N, K; size_t ag_stride; };

struct StaticOrder {
    int nM, nN, nwg, G, c;
    __host__ __device__ void init(int M, int N, int G_, int c_) { nM = M / BM; nN = N / BM; nwg = nM * nN; G = G_; c = c_; }
    __host__ __device__ bool next(int i, Unit& u) const {
        const long L = (long)i * G + c; if (L >= nwg) return false;
        int wgid = (int)L; { const int q = nwg / NXCD, r = nwg % NXCD, xcd = wgid % NXCD, off = wgid / NXCD; wgid = (xcd < r ? xcd * (q + 1) : r * (q + 1) + (xcd - r) * q) + off; }
        const int nig = WGM * nN, gid = wgid / nig, fm = gid * WGM, gsz = (nM - fm) < WGM ? (nM - fm) : WGM;
        u.pm = fm + ((wgid % nig) % gsz); u.pn = (wgid % nig) / gsz; u.ag = 0; return true;
    }
    __device__ __forceinline__ void a_ready(const Unit&) const {}
    __device__ __forceinline__ void done(const Unit&) const {}
};

__device__ __forceinline__ unsigned cvt_pk_bf16(float lo, float hi) { unsigned r; asm volatile("v_cvt_pk_bf16_f32 %0, %1, %2" : "=v"(r) : "v"(lo), "v"(hi)); return r; }
typedef float f32x2 __attribute__((ext_vector_type(2)));
constexpr int EP_M = 32768, EP_D = 2048;
constexpr float EP_EPS = 1e-6f;
constexpr size_t SEG_ELEMS = (size_t)EP_M * 1024;
__device__ __forceinline__ float rstd_of(const float* ss, int row) { return __builtin_amdgcn_rsqf(ss[row] * (1.0f / EP_D) + EP_EPS); }
__device__ __forceinline__ float bf_lo(unsigned w) { return __uint_as_float(w << 16); }
__device__ __forceinline__ float bf_hi(unsigned w) { return __uint_as_float(w & 0xffff0000u); }
__device__ __forceinline__ float sigmoid_f(float x) { return __builtin_amdgcn_rcpf(1.0f + __builtin_amdgcn_exp2f(-1.4426950408889634f * x)); }

struct EpiInProj {
    static constexpr bool PERM = true, AFTER_DRAIN = false;
    bf16_t* proj; bf16_t* dsakv; float* small; const float* ss;
    __device__ __forceinline__ void operator()(const f32x4 (&acc)[2][2][4][2], const Unit& u, int wr, int wc, int fr, int fq) const {
        const int row0 = u.pm * BM + wr * 64 + fr, cb = wc * 32 + 8 * fq;
        if (u.pn < 34) {
            bf16_t* base; int ld, colt;
            if (u.pn < 32) { base = proj + (size_t)(u.pn >> 2) * SEG_ELEMS; ld = 1024; colt = (u.pn & 3) * 256; }
            else { base = dsakv; ld = 512; colt = (u.pn - 32) * 256; }
#pragma unroll
            for (int ai = 0; ai < 2; ++ai)
#pragma unroll
                for (int m = 0; m < 4; ++m) { const int row = row0 + ai * HALF + m * 16; const float rs = rstd_of(ss, row); bf16_t* rowp = base + (size_t)row * ld + colt + cb;
#pragma unroll
                    for (int bj = 0; bj < 2; ++bj) { const f32x4 v0 = acc[ai][bj][m][0] * rs, v1 = acc[ai][bj][m][1] * rs;
                        u32x4 w; w.x = cvt_pk_bf16(v0[0], v0[1]); w.y = cvt_pk_bf16(v0[2], v0[3]); w.z = cvt_pk_bf16(v1[0], v1[1]); w.w = cvt_pk_bf16(v1[2], v1[3]);
                        *(u32x4*)(rowp + bj * HALF) = w; } }
        } else {
#pragma unroll
            for (int ai = 0; ai < 2; ++ai)
#pragma unroll
                for (int m = 0; m < 4; ++m) { const int row = row0 + ai * HALF + m * 16; const float rs = rstd_of(ss, row); float* rowp = small + (size_t)row * 256 + cb;
#pragma unroll
                    for (int bj = 0; bj < 2; ++bj) { *(f32x4*)(rowp + bj * HALF) = acc[ai][bj][m][0] * rs; *(f32x4*)(rowp + bj * HALF + 4) = acc[ai][bj][m][1] * rs; } }
        }
    }
};
struct EpiBranch {
    static constexpr bool PERM = true, AFTER_DRAIN = false;
    bf16_t* tb; size_t gstride;
    __device__ __forceinline__ void operator()(const f32x4 (&acc)[2][2][4][2], const Unit& u, int wr, int wc, int fr, int fq) const {
        const int row0 = u.pm * BM + wr * 64 + fr, col0 = (u.pn & 7) * BM + wc * 32 + 8 * fq; bf16_t* base = tb + (size_t)u.ag * gstride;
#pragma unroll
        for (int ai = 0; ai < 2; ++ai)
#pragma unroll
            for (int m = 0; m < 4; ++m) { bf16_t* rowp = base + (size_t)(row0 + ai * HALF + m * 16) * EP_D + col0;
#pragma unroll
                for (int bj = 0; bj < 2; ++bj) { const f32x4 v0 = acc[ai][bj][m][0], v1 = acc[ai][bj][m][1];
                    u32x4 w; w.x = cvt_pk_bf16(v0[0], v0[1]); w.y = cvt_pk_bf16(v0[2], v0[3]); w.z = cvt_pk_bf16(v1[0], v1[1]); w.w = cvt_pk_bf16(v1[2], v1[3]);
                    *(u32x4*)(rowp + bj * HALF) = w; } }
    }
};
struct EpiGate {
    static constexpr bool PERM = true, AFTER_DRAIN = false;
    bf16_t* tb; size_t gstride; const float* ss;
    __device__ __forceinline__ void operator()(const f32x4 (&acc)[2][2][4][2], const Unit& u, int wr, int wc, int fr, int fq) const {
        const int row0 = u.pm * BM + wr * 64 + fr, col0 = (u.pn & 7) * BM + wc * 32 + 8 * fq; const int g = u.ag;
        const bf16_t* tg = tb + (size_t)g * gstride;
#pragma unroll
        for (int ai = 0; ai < 2; ++ai)
#pragma unroll
            for (int m = 0; m < 4; ++m) { const int row = row0 + ai * HALF + m * 16; const float rs = rstd_of(ss, row); const size_t off = (size_t)row * EP_D + col0;
#pragma unroll
                for (int bj = 0; bj < 2; ++bj) { const f32x4 g0 = acc[ai][bj][m][0] * rs, g1 = acc[ai][bj][m][1] * rs;
                    const u32x4 t = *(const u32x4*)(tg + off + bj * HALF);
                    float o[8];
                    o[0] = sigmoid_f(g0[0]) * bf_lo(t.x); o[1] = sigmoid_f(g0[1]) * bf_hi(t.x); o[2] = sigmoid_f(g0[2]) * bf_lo(t.y); o[3] = sigmoid_f(g0[3]) * bf_hi(t.y);
                    o[4] = sigmoid_f(g1[0]) * bf_lo(t.z); o[5] = sigmoid_f(g1[1]) * bf_hi(t.z); o[6] = sigmoid_f(g1[2]) * bf_lo(t.w); o[7] = sigmoid_f(g1[3]) * bf_hi(t.w);
                    if (g > 0) { const u32x4 p = *(const u32x4*)(tb + off + bj * HALF);
                        o[0] += bf_lo(p.x); o[1] += bf_hi(p.x); o[2] += bf_lo(p.y); o[3] += bf_hi(p.y); o[4] += bf_lo(p.z); o[5] += bf_hi(p.z); o[6] += bf_lo(p.w); o[7] += bf_hi(p.w); }
                    u32x4 w; w.x = cvt_pk_bf16(o[0], o[1]); w.y = cvt_pk_bf16(o[2], o[3]); w.z = cvt_pk_bf16(o[4], o[5]); w.w = cvt_pk_bf16(o[6], o[7]);
                    *(u32x4*)(tb + off + bj * HALF) = w; } }
    }
};
struct EpiResid {
    static constexpr bool PERM = true, AFTER_DRAIN = false;
    const float* xin; float* xout; bf16_t* xb; float* ssn; int aux;
    __device__ __forceinline__ void operator()(const f32x4 (&acc)[2][2][4][2], const Unit& u, int wr, int wc, int fr, int fq) const {
        const int row0 = u.pm * BM + wr * 64 + fr, col0 = u.pn * BM + wc * 32 + 8 * fq;
#pragma unroll
        for (int ai = 0; ai < 2; ++ai)
#pragma unroll
            for (int m = 0; m < 4; ++m) { const int row = row0 + ai * HALF + m * 16; const size_t off = (size_t)row * EP_D + col0; float sq = 0.f;
#pragma unroll
                for (int bj = 0; bj < 2; ++bj) { const f32x4 a0 = *(const f32x4*)(xin + off + bj * HALF), a1 = *(const f32x4*)(xin + off + bj * HALF + 4);
                    const f32x4 v0 = a0 + acc[ai][bj][m][0], v1 = a1 + acc[ai][bj][m][1];
                    *(f32x4*)(xout + off + bj * HALF) = v0; *(f32x4*)(xout + off + bj * HALF + 4) = v1;
                    if (aux) { u32x4 w; w.x = cvt_pk_bf16(v0[0], v0[1]); w.y = cvt_pk_bf16(v0[2], v0[3]); w.z = cvt_pk_bf16(v1[0], v1[1]); w.w = cvt_pk_bf16(v1[2], v1[3]);
                        *(u32x4*)(xb + off + bj * HALF) = w;
                        sq += (v0[0] * v0[0] + v0[1] * v0[1]) + (v0[2] * v0[2] + v0[3] * v0[3]) + (v1[0] * v1[0] + v1[1] * v1[1]) + (v1[2] * v1[2] + v1[3] * v1[3]); } }
                if (aux) { sq += __shfl_xor(sq, 16); sq += __shfl_xor(sq, 32); if (fq == 0) atomicAdd(ssn + row, sq); } }
    }
};
struct EpiSwiGLU {
    static constexpr bool PERM = true, AFTER_DRAIN = false;
    bf16_t* act; const float* ss;
    __device__ __forceinline__ void operator()(const f32x4 (&acc)[2][2][4][2], const Unit& u, int wr, int wc, int fr, int fq) const {
        const int row0 = u.pm * BM + wr * 64 + fr, col0 = u.pn * HALF + wc * 32 + 8 * fq;
#pragma unroll
        for (int ai = 0; ai < 2; ++ai)
#pragma unroll
            for (int m = 0; m < 4; ++m) { const int row = row0 + ai * HALF + m * 16; const float rs = rstd_of(ss, row);
                float o[8];
#pragma unroll
                for (int n = 0; n < 2; ++n)
#pragma unroll
                    for (int e = 0; e < 4; ++e) { const float gt = acc[ai][0][m][n][e] * rs, up = acc[ai][1][m][n][e] * rs; o[n * 4 + e] = gt * sigmoid_f(gt) * up; }
                u32x4 w; w.x = cvt_pk_bf16(o[0], o[1]); w.y = cvt_pk_bf16(o[2], o[3]); w.z = cvt_pk_bf16(o[4], o[5]); w.w = cvt_pk_bf16(o[6], o[7]);
                *(u32x4*)(act + (size_t)row * 5632 + col0) = w; }
    }
};
struct MergedOrder {
    int c;
    __device__ __forceinline__ bool next(int i, Unit& u) const {
        if (i >= 12) return false;
        const int k = i / 3, grp = i - 3 * k, x = c & 7, y = c >> 3;
        u.pm = (k * 8 + x) * 4 + (y >> 3); u.pn = grp * 8 + (y & 7); u.ag = grp; return true;
    }
    __device__ __forceinline__ void a_ready(const Unit&) const {}
    __device__ __forceinline__ void done(const Unit&) const {}
};
template <class Epi, class Sched, bool ALIGN_EPI = false, bool SP2 = false>
__device__ __forceinline__ void gemm_phase(PG8_LAS unsigned char* lds, const Gemm g, const Sched& S, const Epi& E) {
    int tid_ = threadIdx.x; asm volatile("" : "+v"(tid_));
    const int tid = tid_, wid = __builtin_amdgcn_readfirstlane(tid >> 6), lane = tid & 63, wr = wid >> 2, wc = wid & 3, fr = lane & 15, fq = lane >> 4;
    const int K = g.K, nt = K / BK;
    unsigned voffA[2], voffB[2];
#pragma unroll
    for (int i = 0; i < 2; ++i) { int R, C; stage_rc(tid * 16 + i * 8192, R, C); const int Rb = Epi::PERM ? ((R & ~31) + perm32(R & 31)) : R;
        voffA[i] = (unsigned)(R * K + C) * 2u; voffB[i] = (unsigned)(Rb * K + C) * 2u; }
    const size_t kstep = (size_t)(BK * 2);
    const size_t hstep = (size_t)HALF * K * 2;
    const size_t tstep = 2 * hstep;
    const unsigned ldsw = (unsigned)wid * 1024u;
    const int aoff = lds_byte(wr * 64 + fr, fq * 8), boff = lds_byte(wc * 32 + fr, fq * 8);
#define PG8_SA(b, h) (((b) * 2 + (h)) * HTB)
#define PG8_SB(b, h) ((4 + (b) * 2 + (h)) * HTB)
#define PG8_STAGE(bufoff, gbase, voff) do { _Pragma("unroll") for (int _i = 0; _i < 2; ++_i) \
        __builtin_amdgcn_global_load_lds((const unsigned*)((const char*)(gbase) + (voff)[_i]), (PG8_LAS unsigned*)(lds + (bufoff) + ldsw + _i * 8192), 16, 0, 0); } while (0)
#define PG8_LDA(dst, b, h) do { _Pragma("unroll") for (int m = 0; m < 4; ++m) _Pragma("unroll") for (int k = 0; k < 2; ++k) dst[m][k] = *(const PG8_LAS bf16x8*)(lds + PG8_SA(b, h) + aoff + m * 2048 + k * 1024); } while (0)
#define PG8_LDB(dst, b, h) do { _Pragma("unroll") for (int n = 0; n < 2; ++n) _Pragma("unroll") for (int k = 0; k < 2; ++k) dst[n][k] = *(const PG8_LAS bf16x8*)(lds + PG8_SB(b, h) + boff + n * 2048 + k * 1024); } while (0)
#define PG8_MMA(ai, bj, At, Bt) do { __builtin_amdgcn_s_setprio(1); _Pragma("unroll") for (int m = 0; m < 4; ++m) _Pragma("unroll") for (int n = 0; n < 2; ++n) _Pragma("unroll") for (int k = 0; k < 2; ++k) \
        acc[ai][bj][m][n] = __builtin_amdgcn_mfma_f32_16x16x32_bf16(Bt[n][k], At[m][k], acc[ai][bj][m][n], 0, 0, 0); __builtin_amdgcn_s_setprio(0); } while (0)
#define PG8_WAIT_V(n) asm volatile("s_waitcnt vmcnt(" #n ")" ::: "memory")
#define PG8_WAIT_L(n) asm volatile("s_waitcnt lgkmcnt(" #n ")" ::: "memory")
#define PG8_BAR __builtin_amdgcn_s_barrier()
#define PG8_SCHED __builtin_amdgcn_sched_barrier(0)
    Unit cur, nxt; int ui = 0;
    if (!S.next(0, cur)) return;
    f32x4 acc[2][2][4][2];
#pragma unroll
    for (int a = 0; a < 2; ++a)
#pragma unroll
        for (int b = 0; b < 2; ++b)
#pragma unroll
            for (int m = 0; m < 4; ++m)
#pragma unroll
                for (int n = 0; n < 2; ++n) acc[a][b][m][n] = (f32x4){0.f, 0.f, 0.f, 0.f};
    bf16x8 At[4][2], B0[2][2], B1[2][2];
    const char* cA = (const char*)g.A + (size_t)cur.pm * tstep + (size_t)cur.ag * g.ag_stride; const char* cB = (const char*)g.Bt + (size_t)cur.pn * tstep;
    S.a_ready(cur);
    if constexpr (SP2) {
        PG8_STAGE(PG8_SB(0, 0), cB, voffB); PG8_STAGE(PG8_SB(0, 1), cB + hstep, voffB); PG8_STAGE(PG8_SA(0, 0), cA, voffA); PG8_STAGE(PG8_SA(0, 1), cA + hstep, voffA);
        if (wr == 1) PG8_BAR;
        PG8_WAIT_V(2); PG8_BAR;
        PG8_STAGE(PG8_SB(1, 0), cB + kstep, voffB); PG8_STAGE(PG8_SA(1, 0), cA + kstep, voffA); PG8_STAGE(PG8_SB(1, 1), cB + hstep + kstep, voffB);
        PG8_WAIT_V(6); PG8_BAR;
    } else {
        PG8_STAGE(PG8_SB(0, 0), cB, voffB); PG8_STAGE(PG8_SA(0, 0), cA, voffA); PG8_STAGE(PG8_SB(0, 1), cB + hstep, voffB); PG8_STAGE(PG8_SA(0, 1), cA + hstep, voffA);
        if (wr == 1) PG8_BAR;
        PG8_WAIT_V(4); PG8_BAR;
        PG8_STAGE(PG8_SB(1, 0), cB + kstep, voffB); PG8_STAGE(PG8_SA(1, 0), cA + kstep, voffA); PG8_STAGE(PG8_SB(1, 1), cB + hstep + kstep, voffB);
        PG8_WAIT_V(6); PG8_BAR;
    }
    for (;;) {
        const bool has_next = S.next(ui + 1, nxt);
        const char* nA = has_next ? (const char*)g.A + (size_t)nxt.pm * tstep + (size_t)nxt.ag * g.ag_stride : cA; const char* nB = has_next ? (const char*)g.Bt + (size_t)nxt.pn * tstep : cB;
        for (int t = 0; t < nt; t += 2) {
            const bool last = (t == nt - 2);
            const char* a1 = cA + (size_t)(t + 1) * kstep;
            const char* a2 = last ? nA : cA + (size_t)(t + 2) * kstep; const char* b2 = last ? nB : cB + (size_t)(t + 2) * kstep;
            const char* a3 = a2 + kstep; const char* b3 = b2 + kstep;
            if (last && has_next) S.a_ready(nxt);
            if constexpr (SP2) {
            PG8_LDB(B0, 0, 0); PG8_LDB(B1, 0, 1); PG8_SCHED; PG8_LDA(At, 0, 0); PG8_STAGE(PG8_SA(1, 1), a1 + hstep, voffA);
            PG8_WAIT_V(8); PG8_WAIT_L(0); PG8_BAR; PG8_MMA(0, 0, At, B0); PG8_MMA(0, 1, At, B1); PG8_BAR; PG8_SCHED;
            PG8_LDA(At, 0, 1); PG8_STAGE(PG8_SB(0, 0), b2, voffB); PG8_STAGE(PG8_SB(0, 1), b2 + hstep, voffB); PG8_STAGE(PG8_SA(0, 0), a2, voffA);
            PG8_WAIT_V(8); PG8_WAIT_L(0); PG8_BAR; PG8_MMA(1, 0, At, B0); PG8_MMA(1, 1, At, B1); PG8_BAR; PG8_SCHED;
            PG8_LDB(B0, 1, 0); PG8_LDB(B1, 1, 1); PG8_SCHED; PG8_LDA(At, 1, 0); PG8_STAGE(PG8_SA(0, 1), a2 + hstep, voffA);
            PG8_WAIT_V(8); PG8_WAIT_L(0); PG8_BAR; PG8_MMA(0, 0, At, B0); PG8_MMA(0, 1, At, B1); PG8_BAR; PG8_SCHED;
            PG8_LDA(At, 1, 1); PG8_STAGE(PG8_SB(1, 0), b3, voffB); PG8_STAGE(PG8_SB(1, 1), b3 + hstep, voffB); PG8_STAGE(PG8_SA(1, 0), a3, voffA);
            PG8_WAIT_V(8); PG8_WAIT_L(0); PG8_BAR; PG8_MMA(1, 0, At, B0); PG8_MMA(1, 1, At, B1); PG8_BAR; PG8_SCHED;
            } else {
            PG8_LDB(B0, 0, 0); PG8_SCHED; PG8_LDA(At, 0, 0); PG8_STAGE(PG8_SA(1, 1), a1 + hstep, voffA);
            PG8_WAIT_L(8); PG8_BAR; PG8_WAIT_L(0); PG8_MMA(0, 0, At, B0); PG8_BAR; PG8_SCHED;
            PG8_LDB(B1, 0, 1); PG8_STAGE(PG8_SB(0, 0), b2, voffB);
            PG8_BAR; PG8_WAIT_L(0); PG8_MMA(0, 1, At, B1); PG8_BAR;
            PG8_LDA(At, 0, 1); PG8_STAGE(PG8_SA(0, 0), a2, voffA);
            PG8_BAR; PG8_WAIT_L(0); PG8_MMA(1, 0, At, B0); PG8_BAR; PG8_SCHED;
            PG8_STAGE(PG8_SB(0, 1), b2 + hstep, voffB);
            PG8_WAIT_V(6); PG8_BAR; PG8_MMA(1, 1, At, B1); PG8_BAR;
            PG8_LDB(B0, 1, 0); PG8_SCHED; PG8_LDA(At, 1, 0); PG8_STAGE(PG8_SA(0, 1), a2 + hstep, voffA);
            PG8_WAIT_L(8); PG8_BAR; PG8_WAIT_L(0); PG8_MMA(0, 0, At, B0); PG8_BAR; PG8_SCHED;
            PG8_LDB(B1, 1, 1); PG8_STAGE(PG8_SB(1, 0), b3, voffB);
            PG8_BAR; PG8_WAIT_L(0); PG8_MMA(0, 1, At, B1); PG8_BAR;
            PG8_LDA(At, 1, 1); PG8_STAGE(PG8_SA(1, 0), a3, voffA);
            PG8_BAR; PG8_WAIT_L(0); PG8_MMA(1, 0, At, B0); PG8_BAR; PG8_SCHED;
            PG8_STAGE(PG8_SB(1, 1), b3 + hstep, voffB);
            PG8_WAIT_V(6); PG8_BAR; PG8_MMA(1, 1, At, B1); PG8_BAR;
            }
        }
        if constexpr (ALIGN_EPI) { if (wr == 0) PG8_BAR; }
        if constexpr (!Epi::AFTER_DRAIN) { E(acc, cur, wr, wc, fr, fq); S.done(cur); }
        if (!has_next) break;
#pragma unroll
        for (int a = 0; a < 2; ++a)
#pragma unroll
            for (int b = 0; b < 2; ++b)
#pragma unroll
                for (int m = 0; m < 4; ++m)
#pragma unroll
                    for (int n = 0; n < 2; ++n) acc[a][b][m][n] = (f32x4){0.f, 0.f, 0.f, 0.f};
        cur = nxt; cA = nA; cB = nB; ++ui;
        if constexpr (ALIGN_EPI) { if (wr == 1) PG8_BAR; }
    }
    PG8_WAIT_V(0);
    if constexpr (!ALIGN_EPI) { if (wr == 0) PG8_BAR; }
    PG8_BAR;
    if constexpr (Epi::AFTER_DRAIN) { E.fused(acc, cur, wr, wc, fr, fq, lds, wid, lane); S.done(cur); }
#undef PG8_SA
#undef PG8_SB
#undef PG8_STAGE
#undef PG8_LDA
#undef PG8_LDB
#undef PG8_MMA
#undef PG8_WAIT_V
#undef PG8_WAIT_L
#undef PG8_BAR
#undef PG8_SCHED
}
}
#define GAS __attribute__((address_space(1)))
#define LAS __attribute__((address_space(3)))
typedef unsigned short bf16;
typedef unsigned v4u __attribute__((ext_vector_type(4)));
typedef float f32x4 __attribute__((ext_vector_type(4)));
typedef short bf16x8 __attribute__((ext_vector_type(8)));
typedef GAS unsigned gu32;
typedef GAS unsigned long long gu64;
#define RLX_AGENT __ATOMIC_RELAXED, __HIP_MEMORY_SCOPE_AGENT
#define LDS_WAIT() asm volatile("s_waitcnt lgkmcnt(0)" ::: "memory")
#define VM_WAIT() asm volatile("s_waitcnt vmcnt(0)" ::: "memory")
__device__ __forceinline__ unsigned long long rt() { return __builtin_amdgcn_s_memrealtime(); }
__device__ __forceinline__ unsigned f2bf(float f) { unsigned u = __builtin_bit_cast(unsigned, f); return (u + 0x7fffu + ((u >> 16) & 1u)) >> 16; }
__device__ __forceinline__ unsigned pk2(float lo, float hi) { return f2bf(lo) | (f2bf(hi) << 16); }
#define XB_TMO      128
#define XB_XCNT(j)  (256  + 64 * (j))
#define XB_XSUB(j)  (1280 + 64 * (j))
#define XB_XGEN(j)  (2304 + 64 * (j))
#define XB_TOP      3328
#define XB_TOPGEN   3392
#define XCD_BAR_WORDS 3456
#define XB_SPIN_CAP (1u << 18)

__device__ __forceinline__ unsigned xb_ld(unsigned* p)              { return __hip_atomic_load(p, __ATOMIC_RELAXED, __HIP_MEMORY_SCOPE_AGENT); }
__device__ __forceinline__ unsigned xb_add(unsigned* p, unsigned v) { return __hip_atomic_fetch_add(p, v, __ATOMIC_RELAXED, __HIP_MEMORY_SCOPE_AGENT); }
__device__ __forceinline__ unsigned xb_xcc_id() { return (unsigned)__builtin_amdgcn_s_getreg((3 << 11) | 20) & 0xFu; }
#define XB_SPIN(cond, bar) do { unsigned _sp = 0; while (cond) { __builtin_amdgcn_s_sleep(1); \
    if ((++_sp & 255u) == 0u) { if (xb_ld(&(bar)[XB_TMO])) break; if (_sp > XB_SPIN_CAP) { atomicAdd(&(bar)[XB_TMO], 1u); break; } } } } while (0)

struct XcdBarrier {
    unsigned* bar; unsigned x;
    volatile LAS unsigned* st;
};

__device__ __forceinline__ XcdBarrier xcd_barrier_post(unsigned* bar, volatile LAS unsigned* st) {
    XcdBarrier b; b.bar = bar; b.x = xb_xcc_id(); b.st = st;
    if (threadIdx.x == 0) (void)xb_add(&bar[XB_XCNT(b.x)], 1u);
    return b;
}
__device__ __forceinline__ void xcd_barrier_complete(unsigned* bar, unsigned x, unsigned& nloc, unsigned& nx) {
    const unsigned G = gridDim.x * gridDim.y * gridDim.z;
    unsigned sum, cnt, mine, sp = 0u;
    for (;;) {
        sum = 0u; cnt = 0u; mine = 0u;
#pragma unroll
        for (unsigned j = 0; j < 16; ++j) { const unsigned c = xb_ld(&bar[XB_XCNT(j)]); sum += c; cnt += (c > 0u) ? 1u : 0u; mine = (j == x) ? c : mine; }
        if (sum == G) break;
        __builtin_amdgcn_s_sleep(1);
        if ((++sp & 255u) == 0u) { if (xb_ld(&bar[XB_TMO])) break; if (sp > XB_SPIN_CAP) { atomicAdd(&bar[XB_TMO], 1u); break; } }
    }
    nloc = mine > 0u ? mine : 1u; nx = cnt > 0u ? cnt : 1u;
}

__device__ __forceinline__ void xcd_barrier(const XcdBarrier& b) {
    asm volatile("s_waitcnt vmcnt(0)" ::: "memory");
    __syncthreads();
    if (threadIdx.x == 0) {
        unsigned* bar = b.bar;
        __builtin_amdgcn_s_waitcnt(0);
        unsigned nloc = b.st[0], nx = b.st[1];
        if (nloc == 0u) { xcd_barrier_complete(bar, b.x, nloc, nx); b.st[0] = nloc; b.st[1] = nx; }
        const unsigned old = xb_add(&bar[XB_XSUB(b.x)], 1u);
        const unsigned gen = old / nloc;
        if (old + 1u == (gen + 1u) * nloc) {
            __builtin_amdgcn_fence(__ATOMIC_RELEASE, "agent");
            asm volatile("s_waitcnt vmcnt(0)" ::: "memory");
            const unsigned og = xb_add(&bar[XB_TOP], 1u);
            const unsigned tg = og / nx;
            if (og + 1u == (tg + 1u) * nx) xb_add(&bar[XB_TOPGEN], 1u);
            else XB_SPIN(xb_ld(&bar[XB_TOPGEN]) == tg, bar);
            __builtin_amdgcn_fence(__ATOMIC_ACQUIRE, "agent");
            xb_add(&bar[XB_XGEN(b.x)], 1u);
            asm volatile("s_waitcnt vmcnt(0)" ::: "memory");
        } else {
            XB_SPIN(xb_ld(&bar[XB_XGEN(b.x)]) == gen, bar);
            __builtin_amdgcn_fence(__ATOMIC_ACQUIRE, "agent");
            asm volatile("s_waitcnt vmcnt(0)" ::: "memory");
        }
    }
    __syncthreads();
}
namespace att {
#define ALAS __attribute__((address_space(3)))
typedef unsigned short bf16_t;
typedef short bf16x8 __attribute__((ext_vector_type(8)));
typedef short s16x4 __attribute__((ext_vector_type(4)));
typedef float f32x16 __attribute__((ext_vector_type(16)));
typedef float f32x4 __attribute__((ext_vector_type(4)));
typedef unsigned u32x4 __attribute__((ext_vector_type(4)));
typedef ALAS unsigned char lchar;
constexpr int S = 8192, NB = 4, LD = 1024, HD = 128;
constexpr int SHM_K = 16384, SHM_V = 16384;
constexpr float SCALE = 0.08838834764831845f, L2E = 1.4426950408889634f, LN2 = 0.6931471805599453f;
#define KSWZ(row, colB) ((row) * 256 + ((colB) ^ (((row) & 7) << 4)))
#define SBAR() __builtin_amdgcn_sched_barrier(0)
__device__ __forceinline__ int v_st(int k, int c) { const int kk = (k & ~0xC) | ((k & 4) << 1) | ((k & 8) >> 1); return ((kk >> 3) * 4 + (c >> 5)) * 512 + ((kk & 7) * 32 + (c & 31)) * 2; }
__device__ __forceinline__ int v_rd_base(int lane) { return ((lane & 3) << 3) | (((lane >> 2) & 3) << 6) | (((lane >> 4) & 1) << 5) | (((lane >> 5) & 1) << 8); }
constexpr int v_rd_off(int d0, int ks, int half) { return d0 * 512 + ks * 4096 + half * 2048; }
__device__ __forceinline__ int crow(int r, int hi) { return (r & 3) + 8 * (r >> 2) + 4 * hi; }
__device__ __forceinline__ unsigned cvtpk(float lo, float hi) { unsigned r; asm volatile("v_cvt_pk_bf16_f32 %0, %1, %2" : "=v"(r) : "v"(lo), "v"(hi)); return r; }
__device__ __forceinline__ float pair_sum(float v) { auto rr = __builtin_amdgcn_permlane32_swap(__float_as_uint(v), __float_as_uint(v), false, false); return __uint_as_float(rr[0]) + __uint_as_float(rr[1]); }
__device__ __forceinline__ float pair_max(float v) { auto rr = __builtin_amdgcn_permlane32_swap(__float_as_uint(v), __float_as_uint(v), false, false); return fmaxf(__uint_as_float(rr[0]), __uint_as_float(rr[1])); }
__device__ __forceinline__ void pair_sum_other(float v, int hi, float& sum, float& other) {
    auto rr = __builtin_amdgcn_permlane32_swap(__float_as_uint(v), __float_as_uint(v), false, false);
    const float a = __uint_as_float(rr[0]), b = __uint_as_float(rr[1]); sum = a + b; other = hi ? a : b;
}
#define ATT_PK4(P, B_, OUT) do { unsigned a0 = cvtpk(P[B_+0], P[B_+1]), a1 = cvtpk(P[B_+2], P[B_+3]);                          \
        unsigned b0 = cvtpk(P[B_+4], P[B_+5]), b1 = cvtpk(P[B_+6], P[B_+7]);                                             \
        auto r0 = __builtin_amdgcn_permlane32_swap(a0, b0, false, false); auto r1 = __builtin_amdgcn_permlane32_swap(a1, b1, false, false); \
        u32x4 w = {r0[0], r1[0], r0[1], r1[1]}; OUT = *reinterpret_cast<bf16x8*>(&w); } while (0)

__device__ __forceinline__ void qkt(f32x16& p0, f32x16& p1, const lchar* kt, int r32, int hi, const bf16x8* qr) {
    p0 = f32x16{}; p1 = f32x16{};
    const lchar* kb[4];
#pragma unroll
    for (int dd = 0; dd < 4; ++dd) kb[dd] = kt + KSWZ(r32, (dd * 16 + hi * 8) * 2);
#pragma unroll
    for (int d0 = 0; d0 < 8; ++d0) { const lchar* a = kb[d0 & 3] + (d0 >> 2) * 128;
        bf16x8 b0 = *reinterpret_cast<const ALAS bf16x8*>(a);
        bf16x8 b1 = *reinterpret_cast<const ALAS bf16x8*>(a + 32 * 256);
        p0 = __builtin_amdgcn_mfma_f32_32x32x16_bf16(b0, qr[d0], p0, 0, 0, 0);
        p1 = __builtin_amdgcn_mfma_f32_32x32x16_bf16(b1, qr[d0], p1, 0, 0, 0); }
}
#define ATT_TRRD(dst, off) asm volatile("ds_read_b64_tr_b16 %0, %1 offset:%2" : "=&v"(dst) : "v"(vb), "i"(off) : "memory")
__device__ __forceinline__ void pv64(f32x16* o, int vb, bf16x8 pa0, bf16x8 pa1, bf16x8 pa2, bf16x8 pa3) {
#define ATT_PV_D0(d0) do { s16x4 l0, l1, l2, l3, h0, h1, h2, h3; constexpr int b_ = v_rd_off(d0, 0, 0); \
        ATT_TRRD(l0, b_); ATT_TRRD(h0, b_ + 2048); ATT_TRRD(l1, b_ + 4096); ATT_TRRD(h1, b_ + 6144); ATT_TRRD(l2, b_ + 8192); ATT_TRRD(h2, b_ + 10240); ATT_TRRD(l3, b_ + 12288); ATT_TRRD(h3, b_ + 14336); \
        asm volatile("s_waitcnt lgkmcnt(0)" ::: "memory"); SBAR();   \
        o[d0] = __builtin_amdgcn_mfma_f32_32x32x16_bf16(pa0, (bf16x8){l0[0], l0[1], l0[2], l0[3], h0[0], h0[1], h0[2], h0[3]}, o[d0], 0, 0, 0);   \
        o[d0] = __builtin_amdgcn_mfma_f32_32x32x16_bf16(pa1, (bf16x8){l1[0], l1[1], l1[2], l1[3], h1[0], h1[1], h1[2], h1[3]}, o[d0], 0, 0, 0);   \
        o[d0] = __builtin_amdgcn_mfma_f32_32x32x16_bf16(pa2, (bf16x8){l2[0], l2[1], l2[2], l2[3], h2[0], h2[1], h2[2], h2[3]}, o[d0], 0, 0, 0);   \
        o[d0] = __builtin_amdgcn_mfma_f32_32x32x16_bf16(pa3, (bf16x8){l3[0], l3[1], l3[2], l3[3], h3[0], h3[1], h3[2], h3[3]}, o[d0], 0, 0, 0); } while (0)
    ATT_PV_D0(0); ATT_PV_D0(1); ATT_PV_D0(2); ATT_PV_D0(3);
#undef ATT_PV_D0
}
__device__ __forceinline__ void pv32(f32x16* o, int vb, bf16x8 pa0, bf16x8 pa1) {
#define ATT_PV_D0(d0) do { s16x4 l0, l1, h0, h1; constexpr int b_ = v_rd_off(d0, 0, 0); \
        ATT_TRRD(l0, b_); ATT_TRRD(h0, b_ + 2048); ATT_TRRD(l1, b_ + 4096); ATT_TRRD(h1, b_ + 6144); \
        asm volatile("s_waitcnt lgkmcnt(0)" ::: "memory"); SBAR();   \
        o[d0] = __builtin_amdgcn_mfma_f32_32x32x16_bf16(pa0, (bf16x8){l0[0], l0[1], l0[2], l0[3], h0[0], h0[1], h0[2], h0[3]}, o[d0], 0, 0, 0);   \
        o[d0] = __builtin_amdgcn_mfma_f32_32x32x16_bf16(pa1, (bf16x8){l1[0], l1[1], l1[2], l1[3], h1[0], h1[1], h1[2], h1[3]}, o[d0], 0, 0, 0); } while (0)
    ATT_PV_D0(0); ATT_PV_D0(1); ATT_PV_D0(2); ATT_PV_D0(3);
#undef ATT_PV_D0
}

constexpr int A_OFF_V = 0, A_OFF_K = 32768, A_OFF_BIAS = 65536, A_OFF_WS = 66048, A_OFF_FLAG = 68096;
constexpr float SB_DONE = -120.0f;
template <int MODE>
__device__ __forceinline__ void dense_unit(lchar* lds, const bf16_t* Qb, const bf16_t* Kb, const bf16_t* Vb, bf16_t* Ob, const float* cl, const float* ctot, int b, int h, int qb) {
    int tid_ = threadIdx.x; asm volatile("" : "+v"(tid_));
    const int tid = tid_, wid = __builtin_amdgcn_readfirstlane(tid >> 6), lane = tid & 63, r32 = lane & 31, hi = lane >> 5;
    const int q0 = qb * 256, qlo = q0 + wid * 32;
    const size_t rowbase = (size_t)b * S;
    const int hc = h * HD;
    bf16x8 qr[8];
#pragma unroll
    for (int d0 = 0; d0 < 8; ++d0) qr[d0] = *(const bf16x8*)(Qb + (rowbase + qlo + r32) * LD + hc + d0 * 16 + hi * 8);
    const int sr = tid >> 4, sc = (tid & 15) * 8, vst0 = v_st(sr, sc), vst1 = v_st(32 + sr, sc), kws = KSWZ(sr, sc * 2);
    lchar* V_lds = lds + A_OFF_V; lchar* K_lds = lds + A_OFF_K;
    ALAS float* bias_l = (ALAS float*)(lds + A_OFF_BIAS);
    ALAS float* wsf = (ALAS float*)(lds + A_OFF_WS) + wid * 64;
    ALAS int* flags = (ALAS int*)(lds + A_OFF_FLAG);
    const int vb0 = (int)(unsigned)(size_t)V_lds + v_rd_base(lane);
    const float* clh = cl + (size_t)(b * 8 + h) * S; const float* cth = ctot + (b * 8 + h) * 64;
    const int jd = qb * 4 + 3;
    float dsum = 0.f;
    if (MODE == 1) dsum = -cth[qb * 2];
    bf16x8 st_k0, st_k1, st_v0, st_v1; float st_b = 0.f;
#define STAGE_LOAD(t_) do { const size_t r0_ = (rowbase + (size_t)(t_) * 64 + sr) * LD + hc + sc; \
        st_k0 = *(const bf16x8*)(Kb + r0_); st_k1 = *(const bf16x8*)(Kb + r0_ + (size_t)32 * LD); st_v0 = *(const bf16x8*)(Vb + r0_); st_v1 = *(const bf16x8*)(Vb + r0_ + (size_t)32 * LD); \
        if (MODE == 1 && tid < 64) st_b = (dsum - clh[(t_) * 64 + tid]) * L2E; } while (0)
#define STAGE_WRITE(bf_) do { *(ALAS bf16x8*)(K_lds + (bf_) * SHM_K + kws) = st_k0; *(ALAS bf16x8*)(K_lds + (bf_) * SHM_K + kws + 32 * 256) = st_k1; \
        *(ALAS bf16x8*)(V_lds + (bf_) * SHM_V + vst0) = st_v0; *(ALAS bf16x8*)(V_lds + (bf_) * SHM_V + vst1) = st_v1; \
        if (MODE == 1 && tid < 64) bias_l[(bf_) * 64 + tid] = st_b; } while (0)
    STAGE_LOAD(jd); STAGE_WRITE(0);
    if (MODE == 0 && lane == 0) { flags[wid] = 0; flags[8 + wid] = 0; }
    __syncthreads();
    float m_reg = -1e30f, l_reg = 0.f, carry = 0.f; f32x16 o[4] = {};
    bool wdone = false;
    for (int t = jd, it = 0; ; --t, ++it) {
        const int buf = it & 1, k0 = t * 64;
        if (MODE == 0 && it > 0) { int alld = 1;
#pragma unroll
            for (int w = 0; w < 8; ++w) alld &= flags[((it - 1) & 1) * 8 + w];
            if (alld) break; }
        const bool more = t > 0;
        if (more) { if (MODE == 1 && ((t - 1) & 1)) dsum += cth[(t - 1) >> 1]; STAGE_LOAD(t - 1); }
        const bool act = (MODE == 0) ? (k0 <= qlo + 30 && !wdone) : (k0 <= qlo + 31);
        if (act) {
            f32x16 p0, p1; bf16x8 pa0, pa1, pa2, pa3;
            qkt(p0, p1, K_lds + buf * SHM_K, r32, hi, qr);
            const int dq = qlo + r32 - k0 - 4 * hi;
            if (MODE == 0) {
                const bool nm = k0 + 63 >= qlo;
                f32x16 z0, z1;
#pragma unroll
                for (int r = 0; r < 16; ++r) { const int c = (r & 3) + 8 * (r >> 2);
                    float z = p0[r] * SCALE; float e = __builtin_amdgcn_exp2f(-fabsf(z) * L2E); float lk = -(fmaxf(z, 0.f) + LN2 * __builtin_amdgcn_logf(1.f + e));
                    if (nm && !(c < dq)) { lk = 0.f; z = -__builtin_inff(); } z0[r] = z; p0[r] = lk;
                    z = p1[r] * SCALE; e = __builtin_amdgcn_exp2f(-fabsf(z) * L2E); lk = -(fmaxf(z, 0.f) + LN2 * __builtin_amdgcn_logf(1.f + e));
                    if (nm && !(c + 32 < dq)) { lk = 0.f; z = -__builtin_inff(); } z1[r] = z; p1[r] = lk; }
                float U0[4], U1[4], O0[4], O1[4];
#pragma unroll
                for (int c4 = 0; c4 < 4; ++c4) { const int bq = 4 * c4;
                    p0[bq + 2] += p0[bq + 3]; p0[bq + 1] += p0[bq + 2]; p0[bq] += p0[bq + 1];
                    p1[bq + 2] += p1[bq + 3]; p1[bq + 1] += p1[bq + 2]; p1[bq] += p1[bq + 1];
                    pair_sum_other(p0[bq], hi, U0[c4], O0[c4]); pair_sum_other(p1[bq], hi, U1[c4], O1[c4]); }
                float W1[4], W0[4];
                W1[3] = carry; W1[2] = W1[3] + U1[3]; W1[1] = W1[2] + U1[2]; W1[0] = W1[1] + U1[1];
                W0[3] = W1[0] + U1[0]; W0[2] = W0[3] + U0[3]; W0[1] = W0[2] + U0[2]; W0[0] = W0[1] + U0[1];
                const float carry_new = W0[0] + U0[0];
#pragma unroll
                for (int c4 = 0; c4 < 4; ++c4) { const float f0 = W0[c4] + (hi ? 0.f : O0[c4]), f1 = W1[c4] + (hi ? 0.f : O1[c4]);
#pragma unroll
                    for (int e = 0; e < 4; ++e) { const int r = 4 * c4 + e;
                        p0[r] = __builtin_amdgcn_exp2f((z0[r] + (p0[r] + f0)) * L2E);
                        p1[r] = __builtin_amdgcn_exp2f((z1[r] + (p1[r] + f1)) * L2E); } }
                carry = carry_new;
                ATT_PK4(p0, 0, pa0); ATT_PK4(p0, 8, pa1); ATT_PK4(p1, 0, pa2); ATT_PK4(p1, 8, pa3);
                pv64(o, vb0 + buf * SHM_V, pa0, pa1, pa2, pa3);
                if (__all(carry < SB_DONE)) wdone = true;
            } else {
                constexpr float C2 = SCALE * L2E;
                const bool nm = k0 + 63 > qlo;
                const ALAS float* bl = bias_l + buf * 64 + 4 * hi;
#pragma unroll
                for (int c4 = 0; c4 < 4; ++c4) { const f32x4 b0 = *(const ALAS f32x4*)(bl + 8 * c4), b1 = *(const ALAS f32x4*)(bl + 32 + 8 * c4);
#pragma unroll
                    for (int e = 0; e < 4; ++e) { const int r = 4 * c4 + e, c = e + 8 * c4;
                        float x0 = fmaf(p0[r], C2, b0[e]), x1 = fmaf(p1[r], C2, b1[e]);
                        if (nm && !(c <= dq)) x0 = -__builtin_inff();
                        if (nm && !(c + 32 <= dq)) x1 = -__builtin_inff();
                        p0[r] = x0; p1[r] = x1; } }
                float pmax = p0[0];
#pragma unroll
                for (int r = 1; r < 16; ++r) pmax = fmaxf(pmax, p0[r]);
#pragma unroll
                for (int r = 0; r < 16; ++r) pmax = fmaxf(pmax, p1[r]);
                pmax = pair_max(pmax);
                float mn, alpha;
                if (__all(pmax - m_reg <= 11.5f)) { mn = m_reg; alpha = 1.f; }
                else { mn = fmaxf(m_reg, pmax); alpha = __builtin_amdgcn_exp2f(m_reg - mn); m_reg = mn; }
                float ps = 0.f;
#pragma unroll
                for (int r = 0; r < 16; ++r) { p0[r] = __builtin_amdgcn_exp2f(p0[r] - mn); p1[r] = __builtin_amdgcn_exp2f(p1[r] - mn); ps += p0[r] + p1[r]; }
                ps = pair_sum(ps);
                l_reg = l_reg * alpha + ps;
                if (__any(alpha < 1.f)) { if (hi == 0) wsf[r32] = alpha; asm volatile("s_waitcnt lgkmcnt(0)" ::: "memory");
#pragma unroll
                    for (int d_ = 0; d_ < 4; ++d_)
#pragma unroll
                        for (int r = 0; r < 16; ++r) o[d_][r] *= wsf[crow(r, hi)]; }
                ATT_PK4(p0, 0, pa0); ATT_PK4(p0, 8, pa1); ATT_PK4(p1, 0, pa2); ATT_PK4(p1, 8, pa3);
                pv64(o, vb0 + buf * SHM_V, pa0, pa1, pa2, pa3);
            }
        }
        if (more) STAGE_WRITE(buf ^ 1);
        if (MODE == 0 && lane == 0) flags[(it & 1) * 8 + wid] = wdone ? 1 : 0;
        __syncthreads();
        if (!more) break;
    }
#undef STAGE_LOAD
#undef STAGE_WRITE
    float rli[16];
    if (MODE == 1) { if (hi == 0) wsf[32 + r32] = l_reg; asm volatile("s_waitcnt lgkmcnt(0)" ::: "memory");
#pragma unroll
        for (int r = 0; r < 16; ++r) rli[r] = __builtin_amdgcn_rcpf(wsf[32 + crow(r, hi)]); }
    bf16_t* Ow = Ob + (rowbase + qlo) * LD + hc;
#pragma unroll
    for (int r = 0; r < 16; ++r) { const int orow = crow(r, hi);
#pragma unroll
        for (int d0 = 0; d0 < 4; ++d0) { float v = o[d0][r]; if (MODE == 1) v *= rli[r];
            const float vn = __shfl_xor(v, 1);
            if ((r32 & 1) == 0) *(unsigned*)(Ow + (size_t)orow * LD + d0 * 32 + r32) = cvtpk(v, vn); } }
    __syncthreads();
}

constexpr int D_OFF_CAND = 0, D_OFF_IK = 65536, D_IK_STAGE = 32768, D_OFF_WS = 132096;
__device__ __forceinline__ void topk_prune(ALAS unsigned* cand, int& cnt, unsigned& thr, int lane) {
    unsigned k[8];
#pragma unroll
    for (int j = 0; j < 8; ++j) { const int idx = lane + 64 * j; k[j] = idx < cnt ? cand[idx] : 0u; }
    unsigned T = 0u;
    for (int bit = 31; bit >= 0; --bit) { const unsigned Tc = T | (1u << bit); int c = 0;
#pragma unroll
        for (int j = 0; j < 8; ++j) c += __builtin_popcountll(__ballot(k[j] >= Tc));
        if (c >= 256) T = Tc; }
    int base = 0;
#pragma unroll
    for (int j = 0; j < 8; ++j) { const bool keep = k[j] >= T; const unsigned long long mk = __ballot(keep);
        const int pos = base + (int)__builtin_amdgcn_mbcnt_hi((unsigned)(mk >> 32), __builtin_amdgcn_mbcnt_lo((unsigned)mk, 0u));
        if (keep) cand[pos] = k[j]; base += __builtin_popcountll(mk); }
    cnt = base; thr = T;
}
__device__ __forceinline__ void dsa_item(lchar* lds, const bf16_t* idxq, const bf16_t* idxk, const float* idxw, const bf16_t* dsaq, const bf16_t* dsakv, bf16_t* odsa, int b, int jt) {
    int tid_ = threadIdx.x; asm volatile("" : "+v"(tid_));
    const int tid = tid_, wid = __builtin_amdgcn_readfirstlane(tid >> 6), lane = tid & 63, c = lane & 31, hi = lane >> 5;
    const int t0 = jt * 32, qw = 4 * wid; const size_t tok0 = (size_t)b * S + t0;
    ALAS unsigned* candw = (ALAS unsigned*)(lds + D_OFF_CAND) + qw * 512;
    bf16x8 A[2][4]; float wv[2][16];
#pragma unroll
    for (int mt = 0; mt < 2; ++mt) {
#pragma unroll
        for (int ks = 0; ks < 4; ++ks) A[mt][ks] = *(const bf16x8*)(idxq + (tok0 + qw + 2 * mt + (c >> 4)) * 1024 + (c & 15) * 64 + ks * 16 + hi * 8);
#pragma unroll
        for (int r = 0; r < 16; ++r) wv[mt][r] = idxw[(tok0 + qw + 2 * mt + (r >> 3)) * 16 + ((r & 3) + 8 * ((r >> 2) & 1) + 4 * hi)];
    }
    int cnt[4] = {0, 0, 0, 0}; unsigned thr[4] = {0u, 0u, 0u, 0u};
    const int nst = (t0 + 32 + 255) >> 8;
    const int skk = tid >> 1, shalf = tid & 1;
    bf16x8 sg[4];
#define IK_LOAD(s_) do { const bf16_t* src_ = idxk + ((size_t)b * S + 256 * (s_) + skk) * 64 + shalf * 32; \
        _Pragma("unroll") for (int i_ = 0; i_ < 4; ++i_) sg[i_] = *(const bf16x8*)(src_ + 8 * i_); } while (0)
#define IK_WRITE(bf_) do { lchar* dst_ = lds + D_OFF_IK + (bf_) * D_IK_STAGE + skk * 128; \
        _Pragma("unroll") for (int i_ = 0; i_ < 4; ++i_) *(ALAS bf16x8*)(dst_ + (((shalf * 4 + i_) * 16) ^ ((skk & 7) << 4))) = sg[i_]; } while (0)
    IK_LOAD(0); IK_WRITE(0);
    __syncthreads();
    for (int s = 0; s < nst; ++s) {
        const int buf = s & 1;
        if (s + 1 < nst) IK_LOAD(s + 1);
        const lchar* kb = lds + D_OFF_IK + buf * D_IK_STAGE;
        for (int j = 0; j < 8; ++j) {
            const int key0 = 256 * s + 32 * j;
            if (key0 > t0 + qw + 3) break;
            bf16x8 Bf[4];
#pragma unroll
            for (int ks = 0; ks < 4; ++ks) Bf[ks] = *(const ALAS bf16x8*)(kb + (32 * j + c) * 128 + ((ks * 32 + hi * 16) ^ ((c & 7) << 4)));
#pragma unroll
            for (int mt = 0; mt < 2; ++mt) {
                if (cnt[2 * mt] > 480) topk_prune(candw + (2 * mt) * 512, cnt[2 * mt], thr[2 * mt], lane);
                if (cnt[2 * mt + 1] > 480) topk_prune(candw + (2 * mt + 1) * 512, cnt[2 * mt + 1], thr[2 * mt + 1], lane);
                f32x16 acc = {};
#pragma unroll
                for (int ks = 0; ks < 4; ++ks) acc = __builtin_amdgcn_mfma_f32_32x32x16_bf16(A[mt][ks], Bf[ks], acc, 0, 0, 0);
                float sA = 0.f, sB = 0.f;
#pragma unroll
                for (int r = 0; r < 8; ++r) { sA = fmaf(wv[mt][r], fmaxf(acc[r], 0.f), sA); sB = fmaf(wv[mt][8 + r], fmaxf(acc[8 + r], 0.f), sB); }
                auto rr = __builtin_amdgcn_permlane32_swap(__float_as_uint(sA), __float_as_uint(sB), false, false);
                const float score = __uint_as_float(rr[0]) + __uint_as_float(rr[1]);
                const int key = key0 + c, tq = t0 + qw + 2 * mt + hi;
                unsigned u = __float_as_uint(score); u ^= (unsigned)((int)u >> 31) | 0x80000000u;
                const unsigned pk = (u & 0xFFFFE000u) | (unsigned)(8191 - key);
                const unsigned th = hi ? thr[2 * mt + 1] : thr[2 * mt];
                const bool pass = (key <= tq) && (pk > th);
                const unsigned long long mk = __ballot(pass); const unsigned mlo = (unsigned)mk, mhi = (unsigned)(mk >> 32);
                const int pos = hi ? cnt[2 * mt + 1] + (int)__builtin_amdgcn_mbcnt_hi(mhi, 0u) : cnt[2 * mt] + (int)__builtin_amdgcn_mbcnt_lo(mlo, 0u);
                if (pass) candw[(2 * mt + hi) * 512 + pos] = pk;
                cnt[2 * mt] += __builtin_popcount(mlo); cnt[2 * mt + 1] += __builtin_popcount(mhi);
            }
        }
        if (s + 1 < nst) IK_WRITE(buf ^ 1);
        __syncthreads();
    }
#undef IK_LOAD
#undef IK_WRITE
#pragma unroll
    for (int q = 0; q < 4; ++q) if (cnt[q] > 256) topk_prune(candw + q * 512, cnt[q], thr[q], lane);
    lchar* vst = lds + D_OFF_IK + wid * 8192;
    const int vb = (int)(unsigned)(size_t)vst + v_rd_base(lane);
    ALAS float* wsf = (ALAS float*)(lds + D_OFF_WS) + wid * 128;
    ALAS int* wsi = (ALAS int*)wsf;
    if (lane == 0) { wsi[64] = cnt[0]; wsi[65] = cnt[1]; wsi[66] = cnt[2]; wsi[67] = cnt[3]; }
    asm volatile("s_waitcnt lgkmcnt(0)" ::: "memory");
    constexpr float C2 = SCALE * L2E;
#pragma unroll 1
    for (int q = 0; q < 4; ++q) {
        const ALAS unsigned* cq = candw + q * 512; const int nv = __builtin_amdgcn_readfirstlane(wsi[64 + q]); const size_t tk = tok0 + qw + q;
#pragma unroll 1
        for (int g = 0; g < 2; ++g) {
            bf16x8 qs[8];
#pragma unroll
            for (int d0 = 0; d0 < 8; ++d0) { qs[d0] = (bf16x8){0, 0, 0, 0, 0, 0, 0, 0}; if (c < 4) qs[d0] = *(const bf16x8*)(dsaq + tk * 1024 + (g * 4 + c) * 128 + d0 * 16 + hi * 8); }
            float m_reg = -1e30f, l_reg = 0.f; f32x16 o[4] = {};
            for (int ch = 0; ch < 8; ++ch) {
                if (ch * 32 >= nv) break;
                const int jslot = ch * 32 + c; const unsigned ck = cq[jslot < nv ? jslot : 0]; const int kidx = 8191 - (int)(ck & 8191u);
                const bf16_t* krow = dsakv + ((size_t)b * S + kidx) * 512 + g * 128 + hi * 8;
                f32x16 p = {};
#pragma unroll
                for (int d0 = 0; d0 < 8; ++d0) { const bf16x8 kf = *(const bf16x8*)(krow + d0 * 16); p = __builtin_amdgcn_mfma_f32_32x32x16_bf16(kf, qs[d0], p, 0, 0, 0); }
#pragma unroll
                for (int i = 0; i < 8; ++i) { const int id = lane + 64 * i, kk = id >> 4, cc = id & 15, sl = ch * 32 + kk;
                    const unsigned c2 = cq[sl < nv ? sl : 0]; const int vi = 8191 - (int)(c2 & 8191u);
                    const bf16x8 vv = *(const bf16x8*)(dsakv + ((size_t)b * S + vi) * 512 + 256 + g * 128 + cc * 8);
                    *(ALAS bf16x8*)(vst + v_st(kk, cc * 8)) = vv; }
                float pmax = -__builtin_inff();
#pragma unroll
                for (int r = 0; r < 16; ++r) { float x = p[r] * C2; if (ch * 32 + crow(r, hi) >= nv) x = -__builtin_inff(); p[r] = x; pmax = fmaxf(pmax, x); }
                pmax = pair_max(pmax);
                const float mn = fmaxf(m_reg, pmax), alpha = __builtin_amdgcn_exp2f(m_reg - mn); m_reg = mn;
                float ps = 0.f;
#pragma unroll
                for (int r = 0; r < 16; ++r) { p[r] = __builtin_amdgcn_exp2f(p[r] - mn); ps += p[r]; }
                ps = pair_sum(ps); l_reg = l_reg * alpha + ps;
                if (hi == 0) wsf[c] = alpha;
                asm volatile("s_waitcnt lgkmcnt(0)" ::: "memory");
#pragma unroll
                for (int d_ = 0; d_ < 4; ++d_)
#pragma unroll
                    for (int r = 0; r < 16; ++r) o[d_][r] *= wsf[crow(r, hi)];
                bf16x8 pa0, pa1; ATT_PK4(p, 0, pa0); ATT_PK4(p, 8, pa1);
                asm volatile("s_waitcnt lgkmcnt(0)" ::: "memory");
                pv32(o, vb, pa0, pa1);
            }
            if (hi == 0) wsf[32 + c] = l_reg;
            asm volatile("s_waitcnt lgkmcnt(0)" ::: "memory");
#pragma unroll
            for (int r = 0; r < 4; ++r) { const float rl = __builtin_amdgcn_rcpf(wsf[32 + r]);
#pragma unroll
                for (int d0 = 0; d0 < 4; ++d0) { const float v = o[d0][r] * rl; const float vn = __shfl_xor(v, 1);
                    if (hi == 0 && (c & 1) == 0) *(unsigned*)(odsa + tk * 1024 + (g * 4 + r) * 128 + d0 * 32 + c) = cvtpk(v, vn); } }
        }
    }
    __syncthreads();
}
#undef ALAS
}
constexpr int NWAVES = 8;
constexpr int BATCH = 4, SEQ = 8192, DM = 2048, DEPTH = 2, M = BATCH * SEQ, DFF = 5632, NIN = 8960  ;
constexpr float NORM_EPS = 1e-6f;
constexpr size_t MiB = 1u << 20;
constexpr size_t WS_CTL = 0, CTL_ZERO_BYTES = 1 * MiB;
constexpr int CW_BAR = 4096;
constexpr size_t WS_SS = 128 * 1024;
constexpr size_t WS_TAB = 2 * MiB;
constexpr size_t WS_CL = 8 * MiB, WS_CTOT = 9 * MiB, WS_IDXK = 10 * MiB, WS_IDXW = 14 * MiB;
constexpr size_t WS_WIN = 16 * MiB, WS_WG = 51 * MiB, WS_WB = 75 * MiB, WS_WO = 87 * MiB, WS_WGU = 95 * MiB, WS_WD = 139 * MiB;
constexpr size_t WS_XB = 161 * MiB;
constexpr size_t WS_PROJ = 289 * MiB, SEG_BYTES = 64 * MiB;
constexpr size_t WS_DSAKV = WS_PROJ + 8 * SEG_BYTES, WS_SMALL = WS_DSAKV + 32 * MiB, WS_END = WS_SMALL + 32 * MiB;
static_assert(WS_END == 865 * MiB, "d_ws map");
constexpr int LDS_BYTES = 147456, RING_BYTES = 131072, MISC_OFF = RING_BYTES + 320;

__device__ __forceinline__ float wave_sum(float v) {
#pragma unroll
    for (int o = 1; o < 64; o <<= 1) v += __shfl_xor(v, o);
    return v;
}
__device__ __forceinline__ void cvt_item(const float* W, int ldw, int srccol, const float* gain, bf16* dstrow0, int K, int k0, LAS float* scr, int lane) {
#pragma unroll 8
    for (int i = 0; i < 32; ++i) { const int kk = 2 * i + (lane >> 5); float v = 0.f; if (srccol >= 0) v = W[(size_t)(k0 + kk) * ldw + srccol]; if (gain) v *= gain[k0 + kk]; scr[kk * 33 + (lane & 31)] = v; }
    LDS_WAIT(); asm volatile("" ::: "memory");
    const int c = lane & 7;
#pragma unroll
    for (int j = 0; j < 4; ++j) { const int n = (lane >> 3) + 8 * j; const LAS float* s = scr + (8 * c) * 33 + n;
        v4u o; o.x = pk2(s[0 * 33], s[1 * 33]); o.y = pk2(s[2 * 33], s[3 * 33]); o.z = pk2(s[4 * 33], s[5 * 33]); o.w = pk2(s[6 * 33], s[7 * 33]);
        *(GAS v4u*)(dstrow0 + (size_t)n * K + k0 + 8 * c) = o; }
    LDS_WAIT(); asm volatile("" ::: "memory");
}
__device__ __forceinline__ int win_srccol(int n) {
    if (n < 6144) return n;
    if (n < 7168) return 6152 + (n - 6144);
    if (n < 8192) return 7688 + (n - 7168);
    if (n < 8704) return 7176 + (n - 8192);
    if (n < 8768) return 8712 + (n - 8704);
    if (n < 8784) return 8776 + (n - 8768);
    if (n < 8792) return 6144 + (n - 8784);
    return -1;
}
struct Args { const float* in[15]; float* out; unsigned char* ws; };
typedef __attribute__((address_space(4))) const Args CArgs;

__device__ __forceinline__ void p0_prologue(CArgs& a, int l, LAS unsigned char* lds, int vcu, int NGW) {
    int tid_ = threadIdx.x; asm volatile("" : "+v"(tid_)); const int lane = tid_ & 63, wave = __builtin_amdgcn_readfirstlane(tid_ >> 6), gw = vcu * NWAVES + wave;
    unsigned char* ws = a.ws;
    LAS float* scr = (LAS float*)(lds + wave * 16384);
    const float* g_mix = a.in[1] + (size_t)l * DM; const float* g_ffn = a.in[11] + (size_t)l * DM;
    constexpr int I0 = (NIN / 32) * (DM / 64), I1 = (6144 / 32) * (DM / 64), I2 = (6144 / 32) * (1024 / 64), I3 = (DM / 32) * (DM / 64), I4 = (2 * DFF / 32) * (DM / 64), I5 = (DM / 32) * (DFF / 64);
    constexpr int NITEMS = I0 + I1 + I2 + I3 + I4 + I5;
    for (int it = gw; it < NITEMS; it += NGW) {
        int r = it;
        if (r < I0) { const int nblk = NIN / 32, kb = r / nblk, nb = r % nblk, n0 = nb * 32;
            cvt_item(a.in[2] + (size_t)l * DM * 8792, 8792, win_srccol(n0 + (lane & 31)), g_mix, (bf16*)(ws + WS_WIN) + (size_t)n0 * DM, DM, kb * 64, scr, lane); continue; } r -= I0;
        if (r < I1) { const int nblk = 6144 / 32, kb = r / nblk, nb = r % nblk, n0 = nb * 32, g = n0 >> 11;
            cvt_item(a.in[8] + (size_t)(l * 3 + g) * DM * DM, DM, (n0 & 2047) + (lane & 31), g_mix, (bf16*)(ws + WS_WG) + (size_t)n0 * DM, DM, kb * 64, scr, lane); continue; } r -= I1;
        if (r < I2) { const int nblk = 6144 / 32, kb = r / nblk, nb = r % nblk, n0 = nb * 32, g = n0 >> 11;
            cvt_item(a.in[9] + (size_t)(l * 3 + g) * 1024 * DM, DM, (n0 & 2047) + (lane & 31), nullptr, (bf16*)(ws + WS_WB) + (size_t)n0 * 1024, 1024, kb * 64, scr, lane); continue; } r -= I2;
        if (r < I3) { const int nblk = DM / 32, kb = r / nblk, nb = r % nblk, n0 = nb * 32;
            cvt_item(a.in[10] + (size_t)l * DM * DM, DM, n0 + (lane & 31), nullptr, (bf16*)(ws + WS_WO) + (size_t)n0 * DM, DM, kb * 64, scr, lane); continue; } r -= I3;
        if (r < I4) { const int nblk = 2 * DFF / 32, kb = r / nblk, nb = r % nblk, n0 = nb * 32, pn = n0 >> 8, w = n0 & 255;
            const float* src = (w < 128 ? a.in[12] : a.in[13]) + (size_t)l * DM * DFF;
            cvt_item(src, DFF, pn * 128 + (w & 127) + (lane & 31), g_ffn, (bf16*)(ws + WS_WGU) + (size_t)n0 * DM, DM, kb * 64, scr, lane); continue; } r -= I4;
        { const int nblk = DM / 32, kb = r / nblk, nb = r % nblk, n0 = nb * 32;
            cvt_item(a.in[14] + (size_t)l * DFF * DM, DM, n0 + (lane & 31), nullptr, (bf16*)(ws + WS_WD) + (size_t)n0 * DFF, DFF, kb * 64, scr, lane); }
    }
    if (l == 0) {
        const float* x = a.in[0]; bf16* xb = (bf16*)(ws + WS_XB); float* ss0 = (float*)(ws + WS_SS);
        for (int m = gw; m < M; m += NGW) {
            const GAS f32x4* xr = (const GAS f32x4*)(x + (size_t)m * DM) + lane; GAS unsigned long long* o8 = (GAS unsigned long long*)(xb + (size_t)m * DM) + lane;
            f32x4 v[8]; float s = 0.f;
#pragma unroll
            for (int j = 0; j < 8; ++j) { v[j] = xr[64 * j]; s += (v[j].x * v[j].x + v[j].y * v[j].y) + (v[j].z * v[j].z + v[j].w * v[j].w); }
#pragma unroll
            for (int j = 0; j < 8; ++j) o8[64 * j] = (unsigned long long)pk2(v[j].x, v[j].y) | ((unsigned long long)pk2(v[j].z, v[j].w) << 32);
            s = wave_sum(s);
            if (lane == 0) ss0[m] = s;
        }
        float* cos_h = (float*)(ws + WS_TAB); float* sin_h = cos_h + SEQ * 64; float* cos_i = sin_h + SEQ * 64; float* sin_i = cos_i + SEQ * 32;
        for (int idx = gw * 64 + lane; idx < SEQ * 96; idx += NGW * 64) {
            const int t = idx / 96, j = idx - t * 96;
            if (j < 64) { const float inv = 1.0f / powf(10000.0f, (float)(2 * j) / 128.0f), ang = (float)t * inv; cos_h[t * 64 + j] = cosf(ang); sin_h[t * 64 + j] = sinf(ang); }
            else { const int jj = j - 64; const float inv = 1.0f / powf(10000.0f, (float)(2 * jj) / 64.0f), ang = (float)t * inv; cos_i[t * 32 + jj] = cosf(ang); sin_i[t * 32 + jj] = sinf(ang); }
        }
    }
}

__device__ __forceinline__ void unpack8(v4u w, float* f) { f[0] = __uint_as_float(w.x << 16); f[1] = __uint_as_float(w.x & 0xffff0000u); f[2] = __uint_as_float(w.y << 16); f[3] = __uint_as_float(w.y & 0xffff0000u);
    f[4] = __uint_as_float(w.z << 16); f[5] = __uint_as_float(w.z & 0xffff0000u); f[6] = __uint_as_float(w.w << 16); f[7] = __uint_as_float(w.w & 0xffff0000u); }
__device__ __forceinline__ v4u pack8f(const float* f) { v4u o; o.x = pk2(f[0], f[1]); o.y = pk2(f[2], f[3]); o.z = pk2(f[4], f[5]); o.w = pk2(f[6], f[7]); return o; }
template <bool ROPE>
__device__ __forceinline__ void norm_row128(bf16* rowp, int nheads, const float* g, const float* cs, const float* sn, int lane) {
    const int head = lane >> 3, j = lane & 7, hh = head < nheads ? head : 0;
    bf16* p = rowp + hh * 128 + j * 8;
    float x1[8], x2[8]; unpack8(*(const GAS v4u*)p, x1); unpack8(*(const GAS v4u*)(p + 64), x2);
    float s = 0.f;
#pragma unroll
    for (int e = 0; e < 8; ++e) s += x1[e] * x1[e] + x2[e] * x2[e];
    s += __shfl_xor(s, 1); s += __shfl_xor(s, 2); s += __shfl_xor(s, 4);
    const float rs = 1.0f / sqrtf(s * (1.0f / 128.0f) + NORM_EPS);
#pragma unroll
    for (int e = 0; e < 8; ++e) { x1[e] = x1[e] * rs * g[e]; x2[e] = x2[e] * rs * g[8 + e]; }
    if (ROPE) {
        float c[8], sv[8]; *(f32x4*)c = *(const GAS f32x4*)(cs + j * 8); *(f32x4*)(c + 4) = *(const GAS f32x4*)(cs + j * 8 + 4); *(f32x4*)sv = *(const GAS f32x4*)(sn + j * 8); *(f32x4*)(sv + 4) = *(const GAS f32x4*)(sn + j * 8 + 4);
#pragma unroll
        for (int e = 0; e < 8; ++e) { const float a1 = x1[e] * c[e] - x2[e] * sv[e], a2 = x2[e] * c[e] + x1[e] * sv[e]; x1[e] = a1; x2[e] = a2; }
    }
    if (head < nheads) { *(GAS v4u*)p = pack8f(x1); *(GAS v4u*)(p + 64) = pack8f(x2); }
}
__device__ __forceinline__ void p2_post(CArgs& a, int l, LAS unsigned char* lds) {
    int tid_ = threadIdx.x; asm volatile("" : "+v"(tid_)); const int lane = tid_ & 63, wave = __builtin_amdgcn_readfirstlane(tid_ >> 6);
    unsigned char* ws = a.ws;
    const int chunk = blockIdx.x;
    bf16* proj = (bf16*)(ws + WS_PROJ); bf16* dsakv = (bf16*)(ws + WS_DSAKV); const float* small = (const float*)(ws + WS_SMALL);
    bf16* idxk = (bf16*)(ws + WS_IDXK); float* idxw = (float*)(ws + WS_IDXW);
    const float* cos_h = (const float*)(ws + WS_TAB); const float* sin_h = cos_h + SEQ * 64; const float* cos_i = sin_h + SEQ * 64; const float* sin_i = cos_i + SEQ * 32;
    LAS float* lf = (LAS float*)lds;
    const int j = lane & 7;
    float gfq[16], gfk[16], gdq[16], gdk[16];
#pragma unroll
    for (int e = 0; e < 8; ++e) { gfq[e] = a.in[4][l * 128 + j * 8 + e]; gfq[8 + e] = a.in[4][l * 128 + 64 + j * 8 + e]; gfk[e] = a.in[5][l * 128 + j * 8 + e]; gfk[8 + e] = a.in[5][l * 128 + 64 + j * 8 + e];
        gdq[e] = a.in[6][l * 128 + j * 8 + e]; gdq[8 + e] = a.in[6][l * 128 + 64 + j * 8 + e]; gdk[e] = a.in[7][l * 128 + j * 8 + e]; gdk[8 + e] = a.in[7][l * 128 + 64 + j * 8 + e]; }
    const float fbias = a.in[3][l * 8 + (lane & 7)];
    for (int tt = 0; tt < 16; ++tt) {
        const int tokl = wave * 16 + tt; const size_t m = (size_t)chunk * 128 + tokl; const int t = (int)(m & (SEQ - 1));
        norm_row128<false>(proj + 3 * SEG_BYTES / 2 + m * 1024, 8, gfq, nullptr, nullptr, lane);
        norm_row128<false>(proj + 4 * SEG_BYTES / 2 + m * 1024, 8, gfk, nullptr, nullptr, lane);
        norm_row128<true>(proj + 6 * SEG_BYTES / 2 + m * 1024, 8, gdq, cos_h + t * 64, sin_h + t * 64, lane);
        norm_row128<true>(dsakv + m * 512, 2, gdk, cos_h + t * 64, sin_h + t * 64, lane);
        {
            const int jj = lane & 3; bf16* p = proj + 7 * SEG_BYTES / 2 + m * 1024 + (lane >> 2) * 64 + jj * 8;
            float x1[8], x2[8], c[8], sv[8]; unpack8(*(const GAS v4u*)p, x1); unpack8(*(const GAS v4u*)(p + 32), x2);
            *(f32x4*)c = *(const GAS f32x4*)(cos_i + t * 32 + jj * 8); *(f32x4*)(c + 4) = *(const GAS f32x4*)(cos_i + t * 32 + jj * 8 + 4); *(f32x4*)sv = *(const GAS f32x4*)(sin_i + t * 32 + jj * 8); *(f32x4*)(sv + 4) = *(const GAS f32x4*)(sin_i + t * 32 + jj * 8 + 4);
#pragma unroll
            for (int e = 0; e < 8; ++e) { const float a1 = x1[e] * c[e] - x2[e] * sv[e], a2 = x2[e] * c[e] + x1[e] * sv[e]; x1[e] = a1; x2[e] = a2; }
            *(GAS v4u*)p = pack8f(x1); *(GAS v4u*)(p + 32) = pack8f(x2);
            if (lane < 4) {
                const float* sp = small + m * 256 + jj * 8; float k1[8], k2[8];
                *(f32x4*)k1 = *(const GAS f32x4*)sp; *(f32x4*)(k1 + 4) = *(const GAS f32x4*)(sp + 4); *(f32x4*)k2 = *(const GAS f32x4*)(sp + 32); *(f32x4*)(k2 + 4) = *(const GAS f32x4*)(sp + 36);
#pragma unroll
                for (int e = 0; e < 8; ++e) { const float a1 = k1[e] * c[e] - k2[e] * sv[e], a2 = k2[e] * c[e] + k1[e] * sv[e]; k1[e] = a1; k2[e] = a2; }
                *(GAS v4u*)(idxk + m * 64 + jj * 8) = pack8f(k1); *(GAS v4u*)(idxk + m * 64 + 32 + jj * 8) = pack8f(k2);
            }
        }
        if (lane < 16) idxw[m * 16 + lane] = small[m * 256 + 64 + lane] * 0.03125f;
        if (lane < 8) { const float v = small[m * 256 + 80 + lane] + fbias; lf[tokl * 8 + lane] = fminf(v, 0.f) - log1pf(expf(-fabsf(v))); }
    }
    LDS_WAIT(); __syncthreads();
    if (wave == 0) {
        const int head = lane & 7, sub = lane >> 3; float v[16]; float run = 0.f;
#pragma unroll
        for (int i = 0; i < 16; ++i) { run += lf[(sub * 16 + i) * 8 + head]; v[i] = run; }
        float inc = run;
        { const float u = __shfl_up(inc, 8); if (lane >= 8) inc += u; } { const float u = __shfl_up(inc, 16); if (lane >= 16) inc += u; } { const float u = __shfl_up(inc, 32); if (lane >= 32) inc += u; }
        const float excl = inc - run; const int b = chunk >> 6, ch = chunk & 63;
        float* cl = (float*)(ws + WS_CL) + (size_t)(b * 8 + head) * SEQ + ch * 128 + sub * 16;
#pragma unroll
        for (int i = 0; i < 16; ++i) cl[i] = v[i] + excl;
        if (sub == 7) ((float*)(ws + WS_CTOT))[(b * 8 + head) * 64 + ch] = inc;
    }
    __syncthreads();
}
#ifndef PH_MASK
#define PH_MASK 2047
#endif
#if defined(__HIP_DEVICE_COMPILE__)
__device__ __forceinline__ CArgs& kargs() { CArgs* p = (CArgs*)__builtin_amdgcn_kernarg_segment_ptr(); asm volatile("" : "+s"(p)); return *p; }
#else
__device__ CArgs& kargs();
#endif
__global__ void __launch_bounds__(NWAVES * 64, 2) hybrid_fwd(Args args_unused) {
    extern __shared__ __attribute__((aligned(16))) unsigned char lds_raw[];
    LAS unsigned char* lds = (LAS unsigned char*)lds_raw;
    volatile LAS unsigned* MISC = (volatile LAS unsigned*)(lds + MISC_OFF);
    const int tid = threadIdx.x;
    const int G = gridDim.x, bx = blockIdx.x;
    const int vcu = (bx & 7) * (G >> 3) + (bx >> 3);
    gu32* ctl = (gu32*)(kargs().ws + WS_CTL);
    for (int u = tid; u < (LDS_BYTES - RING_BYTES) / 4; u += NWAVES * 64) ((LAS unsigned*)(lds + RING_BYTES))[u] = 0u;
    __syncthreads();
    XcdBarrier bar = xcd_barrier_post((unsigned*)(ctl + CW_BAR), MISC + 8);

    constexpr size_t SEG_E = SEG_BYTES / 2;
#define PH_PTRS() CArgs& args = kargs(); unsigned char* ws = args.ws; bf16* xb = (bf16*)(ws + WS_XB); bf16* proj = (bf16*)(ws + WS_PROJ); bf16* dsakv = (bf16*)(ws + WS_DSAKV); float* small = (float*)(ws + WS_SMALL); \
        float* ssA = (float*)(ws + WS_SS) + (size_t)(2 * l) * M; float* ssB = ssA + M; float* ssN = ssB + M; (void)xb; (void)proj; (void)dsakv; (void)small; (void)ssA; (void)ssB; (void)ssN; (void)args
#pragma unroll 1
    for (int l = 0; l < DEPTH; ++l) {
#if PH_MASK & 1
        { PH_PTRS(); p0_prologue(args, l, lds, vcu, G * NWAVES); }
#endif
        xcd_barrier(bar);
#if PH_MASK & 2
        {   PH_PTRS(); pg8::Gemm g{xb, (const bf16*)(ws + WS_WIN), M, NIN, DM, 0}; pg8::StaticOrder S; S.init(M, NIN, G, bx);
            pg8::EpiInProj E{proj, dsakv, small, ssA};
            pg8::gemm_phase<pg8::EpiInProj, pg8::StaticOrder, true, true>(lds, g, S, E); }
#endif
        xcd_barrier(bar);
#if PH_MASK & 4
        { PH_PTRS(); p2_post(args, l, lds); }
#endif
        xcd_barrier(bar);
        {   PH_PTRS(); const float* cl = (const float*)(ws + WS_CL); const float* ctot = (const float*)(ws + WS_CTOT);
            att::lchar* al = (att::lchar*)lds;
            const int bh = vcu >> 3, sub = vcu & 7;
#if PH_MASK & 8
#pragma unroll 1
            for (int i = 0; i < 4; ++i)
                att::dense_unit<0>(al, proj + 0 * SEG_E, proj + 1 * SEG_E, proj + 2 * SEG_E, proj + 0 * SEG_E, cl, ctot, bh >> 3, bh & 7, sub * 4 + i);
#endif
#if PH_MASK & 16
#pragma unroll 1
            for (int i = 0; i < 4; ++i) { const int p = sub * 2 + (i >> 1), qb = (i & 1) ? 31 - p : p;
                att::dense_unit<1>(al, proj + 3 * SEG_E, proj + 4 * SEG_E, proj + 5 * SEG_E, proj + 3 * SEG_E, cl, ctot, bh >> 3, bh & 7, qb); }
#endif
#if PH_MASK & 32
#pragma unroll 1
            for (int i = 0; i < 4; ++i) { const int p = (vcu & 63) * 2 + (i >> 1), jt = (i & 1) ? 255 - p : p;
                att::dsa_item(al, proj + 7 * SEG_E, (const bf16*)(ws + WS_IDXK), (const float*)(ws + WS_IDXW), proj + 6 * SEG_E, dsakv, proj + 6 * SEG_E, vcu >> 6, jt); }
#endif
        }
        xcd_barrier(bar);
        {   PH_PTRS(); pg8::MergedOrder S{bx};
#if PH_MASK & 64
            {   pg8::Gemm g{proj, (const bf16*)(ws + WS_WB), M, 6144, 1024, 3 * SEG_BYTES};
                pg8::EpiBranch E{proj + SEG_E, 3 * SEG_E};
                pg8::gemm_phase<pg8::EpiBranch, pg8::MergedOrder, true, true>(lds, g, S, E); }
#endif
#if PH_MASK & 128
            {   pg8::Gemm g{xb, (const bf16*)(ws + WS_WG), M, 6144, DM, 0};
                pg8::EpiGate E{proj + SEG_E, 3 * SEG_E, ssA};
                pg8::gemm_phase<pg8::EpiGate, pg8::MergedOrder, true, true>(lds, g, S, E); }
#endif
        }
        xcd_barrier(bar);
#if PH_MASK & 256
        {   PH_PTRS(); pg8::Gemm g{proj + SEG_E, (const bf16*)(ws + WS_WO), M, DM, DM, 0}; pg8::StaticOrder S; S.init(M, DM, G, bx);
            pg8::EpiResid E{l == 0 ? args.in[0] : args.out, args.out, xb, ssB, 1};
            pg8::gemm_phase<pg8::EpiResid, pg8::StaticOrder, true, true>(lds, g, S, E); }
#endif
        xcd_barrier(bar);
#if PH_MASK & 512
        {   PH_PTRS(); pg8::Gemm g{xb, (const bf16*)(ws + WS_WGU), M, 2 * DFF, DM, 0}; pg8::StaticOrder S; S.init(M, 2 * DFF, G, bx);
            pg8::EpiSwiGLU E{proj, ssB};
            pg8::gemm_phase<pg8::EpiSwiGLU, pg8::StaticOrder, true, true>(lds, g, S, E); }
#endif
        xcd_barrier(bar);
#if PH_MASK & 1024
        {   PH_PTRS(); pg8::Gemm g{proj, (const bf16*)(ws + WS_WD), M, DM, DFF, 0}; pg8::StaticOrder S; S.init(M, DM, G, bx);
            pg8::EpiResid E{args.out, args.out, xb, ssN, l + 1 < DEPTH ? 1 : 0};
            pg8::gemm_phase<pg8::EpiResid, pg8::StaticOrder, true, true>(lds, g, S, E); }
#endif
        if (l + 1 < DEPTH) xcd_barrier(bar);
    }
}

extern "C" void kernel_launch(void* const* d_in, const int* in_sizes, int n_in, void* d_out, int out_size, void* d_ws, size_t ws_size, hipStream_t stream) {
    static int grid = 0;
    if (grid == 0) {
        if (n_in != 15 || in_sizes[0] != M * DM || out_size != M * DM || ws_size < WS_END) { fprintf(stderr, "kernel_launch: shape/workspace mismatch (n_in %d, ws %zu)\n", n_in, ws_size); grid = -1; return; }
        int dev = 0, cus = 0;
        if (hipGetDevice(&dev) != hipSuccess || hipDeviceGetAttribute(&cus, hipDeviceAttributeMultiprocessorCount, dev) != hipSuccess) { grid = -1; return; }
        if (hipFuncSetAttribute((const void*)hybrid_fwd, hipFuncAttributeMaxDynamicSharedMemorySize, LDS_BYTES) != hipSuccess) { fprintf(stderr, "kernel_launch: hipFuncSetAttribute failed\n"); grid = -1; return; }
        int per_cu = 0;
        if (hipOccupancyMaxActiveBlocksPerMultiprocessor(&per_cu, (const void*)hybrid_fwd, NWAVES * 64, LDS_BYTES) != hipSuccess || per_cu < 1) fprintf(stderr, "kernel_launch: occupancy query reports %d\n", per_cu);
        (void)hipGetLastError();
        if (cus < 256) { fprintf(stderr, "kernel_launch: needs 256 CUs, device has %d\n", cus); grid = -1; return; }
        grid = 256;
    }
    if (grid < 0) return;
    if (hipMemsetAsync((char*)d_ws + WS_CTL, 0, CTL_ZERO_BYTES, stream) != hipSuccess) return;
    Args a{};
    for (int i = 0; i < 15; ++i) a.in[i] = (const float*)d_in[i];
    a.out = (float*)d_out; a.ws = (unsigned char*)d_ws;
    hipLaunchKernelGGL(hybrid_fwd, dim3(grid), dim3(NWAVES * 64), LDS_BYTES, stream, a);
}
```

```cpp
#include <hip/hip_runtime.h>
#include <cstdio>
#include <cstdint>
#include <cmath>
namespace pg8 {
#define PG8_LAS __attribute__((address_space(3)))
typedef unsigned short bf16_t;
typedef short bf16x8 __attribute__((ext_vector_type(8)));
typedef float f32x4 __attribute__((ext_vector_type(4)));
typedef unsigned u32x4 __attribute__((ext_vector_type(4)));
constexpr int BM = 256, BK = 64, HALF = 128, HTB = HALF * BK * 2  , STAGE_BYTES = 8 * HTB, NXCD = 8, WGM = 8;

__host__ __device__ __forceinline__ int lds_byte(int r, int c) { const int st = (r >> 4) * 2 + (c >> 5), rr = r & 15, cc = c & 31, ob = rr * 64 + cc * 2; return st * 1024 + (ob ^ (((ob >> 9) & 1) << 5)); }
__host__ __device__ __forceinline__ void stage_rc(int b, int& R, int& C) { const int st = b / 1024, sb = b % 1024, swz = sb ^ (((sb >> 9) & 1) << 5); R = (st >> 1) * 16 + swz / 64; C = (st & 1) * 32 + (swz % 64) / 2; }
__host__ __device__ __forceinline__ int perm32(int rho) { const int n = rho >> 4, i = rho & 15; return 8 * (i >> 2) + 4 * n + (i & 3); }

struct Unit { int pm, pn, ag; };
struct Gemm { const bf16_t* A; const bf16_t* Bt; int M, N, K; size_t ag_stride; int wave; size_t ag2 = 0; bool ag2on = false;
    __device__ __forceinline__ size_t agoff(int ag) const { return (ag2on && ag == 2) ? ag2 : (size_t)ag * ag_stride; } };

struct StaticOrder {
    int nM, nN, nwg, G, c;
    __host__ __device__ void init(int M, int N, int G_, int c_) { nM = M / BM; nN = N / BM; nwg = nM * nN; G = G_; c = c_; }
    __host__ __device__ bool next(int i, Unit& u) const {
        const long L = (long)i * G + c; if (L >= nwg) return false;
        int wgid = (int)L; { const int q = nwg / NXCD, r = nwg % NXCD, xcd = wgid % NXCD, off = wgid / NXCD; wgid = (xcd < r ? xcd * (q + 1) : r * (q + 1) + (xcd - r) * q) + off; }
        const int nig = WGM * nN, gid = wgid / nig, fm = gid * WGM, gsz = (nM - fm) < WGM ? (nM - fm) : WGM;
        u.pm = fm + ((wgid % nig) % gsz); u.pn = (wgid % nig) / gsz; u.ag = 0; return true;
    }
    __device__ __forceinline__ void a_ready(const Unit&) const {}
    __device__ __forceinline__ void done(const Unit&) const {}
};

__device__ __forceinline__ unsigned cvt_pk_bf16(float lo, float hi) { unsigned r; asm volatile("v_cvt_pk_bf16_f32 %0, %1, %2" : "=v"(r) : "v"(lo), "v"(hi)); return r; }
typedef float f32x2 __attribute__((ext_vector_type(2)));
typedef int i32x4 __attribute__((ext_vector_type(4)));
typedef int i32x8 __attribute__((ext_vector_type(8)));
constexpr int EP_M = 32768, EP_D = 2048;
constexpr float EP_EPS = 1e-6f;
constexpr size_t SEG_ELEMS = (size_t)EP_M * 1024;
typedef unsigned long long ssq_t;
constexpr float SSQ = 1048576.0f, SSQI = 1.0f / 1048576.0f;
__device__ __forceinline__ ssq_t ssq_of(float s) { return (ssq_t)(s * SSQ + 0.5f); }
__device__ __forceinline__ float rstd_of(const ssq_t* ss, int row) { return __builtin_amdgcn_rsqf((float)ss[row] * (SSQI / EP_D) + EP_EPS); }
__device__ __forceinline__ float bf_lo(unsigned w) { return __uint_as_float(w << 16); }
__device__ __forceinline__ float bf_hi(unsigned w) { return __uint_as_float(w & 0xffff0000u); }
__device__ __forceinline__ float fp8rt(float v, float s) {
    v = fminf(fmaxf(v * s, -448.f), 448.f); const int w = __builtin_amdgcn_cvt_pk_fp8_f32(v, v, 0, false); return __builtin_amdgcn_cvt_f32_fp8(w, 0) / s; }
__device__ __forceinline__ unsigned pk4_fp8e(float a, float b, float c, float d) {
    a = fminf(fmaxf(a, -448.f), 448.f); b = fminf(fmaxf(b, -448.f), 448.f); c = fminf(fmaxf(c, -448.f), 448.f); d = fminf(fmaxf(d, -448.f), 448.f);
    int w = __builtin_amdgcn_cvt_pk_fp8_f32(a, b, 0, false); w = __builtin_amdgcn_cvt_pk_fp8_f32(c, d, w, true); return (unsigned)w; }
__device__ __forceinline__ float sigmoid_f(float x) { return __builtin_amdgcn_rcpf(1.0f + __builtin_amdgcn_exp2f(-1.4426950408889634f * x)); }

struct EpiInProj {
    static constexpr bool PERM = true, AFTER_DRAIN = false, IDEMPOTENT = true;
    bf16_t* proj; bf16_t* dsakv; float* small; const ssq_t* ss;
    __device__ __forceinline__ void operator()(const f32x4 (&acc)[2][2][4][2], const Unit& u, int wr, int wc, int fr, int fq) const {
        const int row0 = u.pm * BM + wr * 64 + fr, cb = wc * 32 + 8 * fq;
        float rsv[2][4]; ssq_t rq[2][4];
#pragma unroll
        for (int ai = 0; ai < 2; ++ai)
#pragma unroll
            for (int m = 0; m < 4; ++m) rq[ai][m] = ss[row0 + ai * HALF + m * 16];
        asm volatile("" : "+v"(rq[0][0]), "+v"(rq[0][1]), "+v"(rq[0][2]), "+v"(rq[0][3]), "+v"(rq[1][0]), "+v"(rq[1][1]), "+v"(rq[1][2]), "+v"(rq[1][3]));
#pragma unroll
        for (int ai = 0; ai < 2; ++ai)
#pragma unroll
            for (int m = 0; m < 4; ++m) rsv[ai][m] = (float)rq[ai][m] * SSQI;
        asm volatile("" : "+v"(rsv[0][0]), "+v"(rsv[0][1]), "+v"(rsv[0][2]), "+v"(rsv[0][3]), "+v"(rsv[1][0]), "+v"(rsv[1][1]), "+v"(rsv[1][2]), "+v"(rsv[1][3]));
#pragma unroll
        for (int ai = 0; ai < 2; ++ai)
#pragma unroll
            for (int m = 0; m < 4; ++m) rsv[ai][m] = __builtin_amdgcn_rsqf(rsv[ai][m] * (1.0f / EP_D) + EP_EPS);
        if (u.pn < 34) {
            bf16_t* base; int ld, colt;
            if (u.pn < 32) { base = proj + (size_t)(u.pn >> 2) * SEG_ELEMS; ld = 1024; colt = (u.pn & 3) * 256; }
            else { base = dsakv; ld = 512; colt = (u.pn - 32) * 256; }
#pragma unroll
            for (int ai = 0; ai < 2; ++ai)
#pragma unroll
                for (int m = 0; m < 4; ++m) { const int row = row0 + ai * HALF + m * 16; const float rs = rsv[ai][m]; bf16_t* rowp = base + (size_t)row * ld + colt + cb;
#pragma unroll
                    for (int bj = 0; bj < 2; ++bj) { const f32x4 v0 = acc[ai][bj][m][0] * rs, v1 = acc[ai][bj][m][1] * rs;
                        u32x4 w; w.x = cvt_pk_bf16(v0[0], v0[1]); w.y = cvt_pk_bf16(v0[2], v0[3]); w.z = cvt_pk_bf16(v1[0], v1[1]); w.w = cvt_pk_bf16(v1[2], v1[3]);
                        __builtin_nontemporal_store(w, (u32x4*)(rowp + bj * HALF)); } }
        } else {
#pragma unroll
            for (int ai = 0; ai < 2; ++ai)
#pragma unroll
                for (int m = 0; m < 4; ++m) { const int row = row0 + ai * HALF + m * 16; const float rs = rsv[ai][m]; float* rowp = small + (size_t)row * 256 + cb;
#pragma unroll
                    for (int bj = 0; bj < 2; ++bj) { *(f32x4*)(rowp + bj * HALF) = acc[ai][bj][m][0] * rs; *(f32x4*)(rowp + bj * HALF + 4) = acc[ai][bj][m][1] * rs; } }
        }
    }
};
template <bool I8>
struct EpiBranch {
    static constexpr bool PERM = true, AFTER_DRAIN = false, IDEMPOTENT = true;
    bf16_t* tb; size_t gstride; const float* rs8; const float* cs8;
    __device__ __forceinline__ void operator()(const f32x4 (&acc)[2][2][4][2], const Unit& u, int wr, int wc, int fr, int fq) const {
        const int row0 = u.pm * BM + wr * 64 + fr, col0 = (u.pn & 7) * BM + wc * 32 + 8 * fq; bf16_t* base = tb + (size_t)u.ag * gstride;
        float rsc[2][4]; f32x4 cs[2][2];
        if constexpr (I8) {
            const float* cp = cs8 + u.pn * BM + wc * 32 + 8 * fq;
#pragma unroll
            for (int bj = 0; bj < 2; ++bj) { cs[bj][0] = *(const f32x4*)(cp + bj * HALF); cs[bj][1] = *(const f32x4*)(cp + bj * HALF + 4); }
#pragma unroll
            for (int ai = 0; ai < 2; ++ai)
#pragma unroll
                for (int m = 0; m < 4; ++m) rsc[ai][m] = rs8[(size_t)u.ag * EP_M + row0 + ai * HALF + m * 16]; }
#pragma unroll
        for (int ai = 0; ai < 2; ++ai)
#pragma unroll
            for (int m = 0; m < 4; ++m) { bf16_t* rowp = base + (size_t)(row0 + ai * HALF + m * 16) * EP_D + col0;
#pragma unroll
                for (int bj = 0; bj < 2; ++bj) { f32x4 v0 = acc[ai][bj][m][0], v1 = acc[ai][bj][m][1];
                    if constexpr (I8) { const float r = rsc[ai][m];
                        const float a0 = v0[0], a1 = v0[1], a2 = v0[2], a3 = v0[3], b0 = v1[0], b1 = v1[1], b2 = v1[2], b3 = v1[3];
                        v0 = (f32x4){(float)__float_as_int(a0), (float)__float_as_int(a1), (float)__float_as_int(a2), (float)__float_as_int(a3)} * (cs[bj][0] * r);
                        v1 = (f32x4){(float)__float_as_int(b0), (float)__float_as_int(b1), (float)__float_as_int(b2), (float)__float_as_int(b3)} * (cs[bj][1] * r); }
                    u32x4 w; w.x = cvt_pk_bf16(v0[0], v0[1]); w.y = cvt_pk_bf16(v0[2], v0[3]); w.z = cvt_pk_bf16(v1[0], v1[1]); w.w = cvt_pk_bf16(v1[2], v1[3]);
                    *(u32x4*)(rowp + bj * HALF) = w; } }
    }
};
template <bool I8>
struct EpiGate {
    static constexpr bool PERM = true, AFTER_DRAIN = false, IDEMPOTENT = false;
    bf16_t* tb; size_t gstride; const ssq_t* ss; float fscale; const float* rs8; const float* cs8;
    __device__ __forceinline__ void operator()(const f32x4 (&acc)[2][2][4][2], const Unit& u, int wr, int wc, int fr, int fq) const {
        const int row0 = u.pm * BM + wr * 64 + fr, col0 = (u.pn & 7) * BM + wc * 32 + 8 * fq; const int g = u.ag;
        const bf16_t* tg = tb + (size_t)g * gstride;
        float rsv[2][4]; ssq_t rq[2][4];
        if constexpr (I8) {
#pragma unroll
            for (int ai = 0; ai < 2; ++ai)
#pragma unroll
                for (int m = 0; m < 4; ++m) rsv[ai][m] = rs8[row0 + ai * HALF + m * 16]; }
        else {
#pragma unroll
        for (int ai = 0; ai < 2; ++ai)
#pragma unroll
            for (int m = 0; m < 4; ++m) rq[ai][m] = ss[row0 + ai * HALF + m * 16];
        asm volatile("" : "+v"(rq[0][0]), "+v"(rq[0][1]), "+v"(rq[0][2]), "+v"(rq[0][3]), "+v"(rq[1][0]), "+v"(rq[1][1]), "+v"(rq[1][2]), "+v"(rq[1][3]));
#pragma unroll
        for (int ai = 0; ai < 2; ++ai)
#pragma unroll
            for (int m = 0; m < 4; ++m) rsv[ai][m] = (float)rq[ai][m] * SSQI;
        asm volatile("" : "+v"(rsv[0][0]), "+v"(rsv[0][1]), "+v"(rsv[0][2]), "+v"(rsv[0][3]), "+v"(rsv[1][0]), "+v"(rsv[1][1]), "+v"(rsv[1][2]), "+v"(rsv[1][3]));
#pragma unroll
        for (int ai = 0; ai < 2; ++ai)
#pragma unroll
            for (int m = 0; m < 4; ++m) rsv[ai][m] = __builtin_amdgcn_rsqf(rsv[ai][m] * (1.0f / EP_D) + EP_EPS);
        }
#pragma unroll
        for (int ai = 0; ai < 2; ++ai)
#pragma unroll
          for (int bh = 0; bh < (I8 ? 2 : 1); ++bh) { const int bj0 = I8 ? bh : 0, bj1 = I8 ? bh + 1 : 2;
            f32x4 cs[2][2];
            if constexpr (I8) { const float* cp = cs8 + u.pn * BM + wc * 32 + 8 * fq + bh * HALF; cs[bh][0] = *(const f32x4*)cp; cs[bh][1] = *(const f32x4*)(cp + 4); }
            u32x4 tv[4][2], pv[4][2];
#pragma unroll
            for (int m = 0; m < 4; ++m)
#pragma unroll
                for (int bj = bj0; bj < bj1; ++bj) { const size_t off = (size_t)(row0 + ai * HALF + m * 16) * EP_D + col0 + bj * HALF;
                    tv[m][bj] = *(const u32x4*)(tg + off); pv[m][bj] = (u32x4){0u, 0u, 0u, 0u}; if (g > 0) pv[m][bj] = *(const u32x4*)(tb + off); }
#pragma unroll
            for (int m = 0; m < 4; ++m) { const float nrs = -1.4426950408889634f * ((!I8 && fscale != 0.f) ? fscale : rsv[ai][m]); const size_t off = (size_t)(row0 + ai * HALF + m * 16) * EP_D + col0;
#pragma unroll
                for (int bj = bj0; bj < bj1; ++bj) { const u32x4 t = tv[m][bj], p = pv[m][bj]; u32x4 w;
#pragma unroll
                    for (int q = 0; q < 4; ++q) {
                        f32x2 x = {acc[ai][bj][m][q >> 1][2 * (q & 1)], acc[ai][bj][m][q >> 1][2 * (q & 1) + 1]};
                        if constexpr (I8) { const float x0_ = x[0], x1_ = x[1];
                            x = (f32x2){(float)__float_as_int(x0_) * cs[bj][q >> 1][2 * (q & 1)], (float)__float_as_int(x1_) * cs[bj][q >> 1][2 * (q & 1) + 1]}; }
                        const f32x2 a = x * nrs; const f32x2 d = (f32x2){__builtin_amdgcn_exp2f(a[0]), __builtin_amdgcn_exp2f(a[1])} + 1.0f;
                        const f32x2 r = {__builtin_amdgcn_rcpf(d[0]), __builtin_amdgcn_rcpf(d[1])};
                        const f32x2 o = r * (f32x2){bf_lo(t[q]), bf_hi(t[q])} + (f32x2){bf_lo(p[q]), bf_hi(p[q])};
                        w[q] = cvt_pk_bf16(o[0], o[1]); }
                    *(u32x4*)(tb + off + bj * HALF) = w; } }
        }
    }
};
template <bool LAST> struct EpiResid {
    static constexpr bool PERM = true, AFTER_DRAIN = false, IDEMPOTENT = false;
    bf16_t* xb; float* xout; ssq_t* ssn; bf16_t* xbo; float ascale;
    __device__ __forceinline__ void operator()(const f32x4 (&acc)[2][2][4][2], const Unit& u, int wr, int wc, int fr, int fq) const {
        const int row0 = u.pm * BM + wr * 64 + fr, col0 = u.pn * BM + wc * 32 + 8 * fq;
#pragma unroll
        for (int ai = 0; ai < 2; ++ai) {
            u32x4 xv[4][2];
#pragma unroll
            for (int m = 0; m < 4; ++m)
#pragma unroll
                for (int bj = 0; bj < 2; ++bj) xv[m][bj] = *(const u32x4*)(xb + (size_t)(row0 + ai * HALF + m * 16) * EP_D + col0 + bj * HALF);
#pragma unroll
            for (int m = 0; m < 4; ++m) { const int row = row0 + ai * HALF + m * 16; const size_t off = (size_t)row * EP_D + col0; float sq = 0.f;
#pragma unroll
                for (int bj = 0; bj < 2; ++bj) { const u32x4 xw = xv[m][bj];
                    f32x4 v0 = acc[ai][bj][m][0] * ascale, v1 = acc[ai][bj][m][1] * ascale;
                    v0[0] += bf_lo(xw.x); v0[1] += bf_hi(xw.x); v0[2] += bf_lo(xw.y); v0[3] += bf_hi(xw.y); v1[0] += bf_lo(xw.z); v1[1] += bf_hi(xw.z); v1[2] += bf_lo(xw.w); v1[3] += bf_hi(xw.w);
                    if (LAST) { *(f32x4*)(xout + off + bj * HALF) = v0; *(f32x4*)(xout + off + bj * HALF + 4) = v1; }
                    else { u32x4 w; w.x = cvt_pk_bf16(v0[0], v0[1]); w.y = cvt_pk_bf16(v0[2], v0[3]); w.z = cvt_pk_bf16(v1[0], v1[1]); w.w = cvt_pk_bf16(v1[2], v1[3]);
                        *(u32x4*)(xbo + off + bj * HALF) = w;
                        sq += (v0[0] * v0[0] + v0[1] * v0[1]) + (v0[2] * v0[2] + v0[3] * v0[3]) + (v1[0] * v1[0] + v1[1] * v1[1]) + (v1[2] * v1[2] + v1[3] * v1[3]); } }
                if (!LAST) { sq += __shfl_xor(sq, 16); sq += __shfl_xor(sq, 32); if (fq == 0) atomicAdd(ssn + row, ssq_of(sq)); } }
        }
    }
};
template <bool I8>
struct EpiSwiGLU {
    static constexpr bool PERM = true, AFTER_DRAIN = false, IDEMPOTENT = true;
    bf16_t* act; const ssq_t* ss; unsigned char* act8;
    const float* rs8; const float* cs8;
    __device__ __forceinline__ void operator()(const f32x4 (&acc)[2][2][4][2], const Unit& u, int wr, int wc, int fr, int fq) const {
        const int row0 = u.pm * BM + wr * 64 + fr, col0 = u.pn * HALF + wc * 32 + 8 * fq;
        float rsv[2][4]; ssq_t rq[2][4];
        float rsc[2][4]; f32x4 cg[2], cu[2];
        if constexpr (I8) {
            const float* cp = cs8 + u.pn * BM + wc * 32 + 8 * fq;
            cg[0] = *(const f32x4*)cp; cg[1] = *(const f32x4*)(cp + 4); cu[0] = *(const f32x4*)(cp + HALF); cu[1] = *(const f32x4*)(cp + HALF + 4);
#pragma unroll
            for (int ai = 0; ai < 2; ++ai)
#pragma unroll
                for (int m = 0; m < 4; ++m) rsc[ai][m] = rs8[row0 + ai * HALF + m * 16]; }
#pragma unroll
        for (int ai = 0; ai < 2; ++ai)
#pragma unroll
            for (int m = 0; m < 4; ++m) rq[ai][m] = ss[row0 + ai * HALF + m * 16];
        asm volatile("" : "+v"(rq[0][0]), "+v"(rq[0][1]), "+v"(rq[0][2]), "+v"(rq[0][3]), "+v"(rq[1][0]), "+v"(rq[1][1]), "+v"(rq[1][2]), "+v"(rq[1][3]));
#pragma unroll
        for (int ai = 0; ai < 2; ++ai)
#pragma unroll
            for (int m = 0; m < 4; ++m) rsv[ai][m] = (float)rq[ai][m] * SSQI;
        asm volatile("" : "+v"(rsv[0][0]), "+v"(rsv[0][1]), "+v"(rsv[0][2]), "+v"(rsv[0][3]), "+v"(rsv[1][0]), "+v"(rsv[1][1]), "+v"(rsv[1][2]), "+v"(rsv[1][3]));
#pragma unroll
        for (int ai = 0; ai < 2; ++ai)
#pragma unroll
            for (int m = 0; m < 4; ++m) { rsv[ai][m] = rsv[ai][m] * (1.0f / EP_D) + EP_EPS;
                if constexpr (I8) { const float r = rsc[ai][m]; rsv[ai][m] *= __builtin_amdgcn_rcpf(r * r); } }
#pragma unroll
        for (int ai = 0; ai < 2; ++ai)
#pragma unroll
            for (int m = 0; m < 4; ++m) { const int row = row0 + ai * HALF + m * 16; const float v = rsv[ai][m], nrs = -1.4426950408889634f * __builtin_amdgcn_rsqf(v);
                u32x4 w; float of[8];
#pragma unroll
                for (int q = 0; q < 4; ++q) {
                    f32x2 gt = {acc[ai][0][m][q >> 1][2 * (q & 1)], acc[ai][0][m][q >> 1][2 * (q & 1) + 1]}, up = {acc[ai][1][m][q >> 1][2 * (q & 1)], acc[ai][1][m][q >> 1][2 * (q & 1) + 1]};
                    if constexpr (I8) {
                        const float g0_ = gt[0], g1_ = gt[1], u0_ = up[0], u1_ = up[1];
                        gt = (f32x2){(float)__float_as_int(g0_) * cg[q >> 1][2 * (q & 1)], (float)__float_as_int(g1_) * cg[q >> 1][2 * (q & 1) + 1]};
                        up = (f32x2){(float)__float_as_int(u0_) * cu[q >> 1][2 * (q & 1)], (float)__float_as_int(u1_) * cu[q >> 1][2 * (q & 1) + 1]}; }
                    const f32x2 a = gt * nrs; const f32x2 d = (f32x2){__builtin_amdgcn_exp2f(a[0]), __builtin_amdgcn_exp2f(a[1])} * v + v;
                    const f32x2 o = (gt * up) * (f32x2){__builtin_amdgcn_rcpf(d[0]), __builtin_amdgcn_rcpf(d[1])};
                    of[2 * q] = o[0]; of[2 * q + 1] = o[1];
                    w[q] = cvt_pk_bf16(o[0], o[1]); }
                if (act8 != nullptr) { typedef unsigned v2u_ __attribute__((ext_vector_type(2)));
                    const v2u_ w8 = {pk4_fp8e(of[0] * 16.f, of[1] * 16.f, of[2] * 16.f, of[3] * 16.f), pk4_fp8e(of[4] * 16.f, of[5] * 16.f, of[6] * 16.f, of[7] * 16.f)};
                    __builtin_nontemporal_store(w8, (v2u_*)(act8 + (size_t)row * 5632 + col0)); }
                else __builtin_nontemporal_store(w, (u32x4*)(act + (size_t)row * 5632 + col0)); }
    }
};
struct MergedOrder {
    int c;
    __device__ __forceinline__ bool next(int i, Unit& u) const {
        if (i >= 12) return false;
        const int k = i / 3, grp = i - 3 * k, x = c & 7, y = c >> 3;
        u.pm = (k * 8 + x) * 4 + (y >> 3); u.pn = grp * 8 + (y & 7); u.ag = grp; return true;
    }
    __device__ __forceinline__ void a_ready(const Unit&) const {}
    __device__ __forceinline__ void done(const Unit&) const {}
};
template <class Epi, class Sched, bool ALIGN_EPI = false, bool SP2 = false, int F8 = 0>
__device__ __forceinline__ void gemm_phase(PG8_LAS unsigned char* lds, const Gemm g, const Sched& S, const Epi& E) {
    int tid_ = g.wave * 64 + (int)__builtin_amdgcn_mbcnt_hi(~0u, __builtin_amdgcn_mbcnt_lo(~0u, 0u)); asm volatile("" : "+v"(tid_));
    const int tid = tid_, wid = __builtin_amdgcn_readfirstlane(tid >> 6), lane = tid & 63, wr = wid >> 2, wc = wid & 3, fr = lane & 15, fq = lane >> 4;
    const int K = g.K, nt = K / BK;
    unsigned voffA[2], voffB[2];
#pragma unroll
    for (int i = 0; i < 2; ++i) { int R, C; stage_rc(tid * 16 + i * 8192, R, C); const int Rb = Epi::PERM ? ((R & ~31) + perm32(R & 31)) : R;
        voffA[i] = (unsigned)(R * K + C) * 2u; voffB[i] = (unsigned)(Rb * K + C) * 2u; }
    const size_t kstep = (size_t)(BK * 2);
    const size_t hstep = (size_t)HALF * K * 2;
    const size_t tstep = 2 * hstep;
    const unsigned ldsw = (unsigned)wid * 1024u;
    const int aoff = lds_byte(wr * 64 + fr, fq * 8), boff = lds_byte(wc * 32 + fr, fq * 8);
#define PG8_SA(b, h) (((b) * 2 + (h)) * HTB)
#define PG8_SB(b, h) ((4 + (b) * 2 + (h)) * HTB)
#define PG8_STAGE(bufoff, gbase, voff) do { _Pragma("unroll") for (int _i = 0; _i < 2; ++_i) \
        __builtin_amdgcn_global_load_lds((const unsigned*)((const char*)(gbase) + (voff)[_i]), (PG8_LAS unsigned*)(lds + (bufoff) + ldsw + _i * 8192), 16, 0, 0); } while (0)
#define PG8_LDA(dst, b, h) do { _Pragma("unroll") for (int m = 0; m < 4; ++m) _Pragma("unroll") for (int k = 0; k < 2; ++k) dst[m][k] = *(const PG8_LAS bf16x8*)(lds + PG8_SA(b, h) + aoff + m * 2048 + k * 1024); } while (0)
#define PG8_LDB(dst, b, h) do { _Pragma("unroll") for (int n = 0; n < 2; ++n) _Pragma("unroll") for (int k = 0; k < 2; ++k) dst[n][k] = *(const PG8_LAS bf16x8*)(lds + PG8_SB(b, h) + boff + n * 2048 + k * 1024); } while (0)
#define PG8_MMA(ai, bj, At, Bt) do { __builtin_amdgcn_s_setprio(1); _Pragma("unroll") for (int m = 0; m < 4; ++m) _Pragma("unroll") for (int n = 0; n < 2; ++n) _Pragma("unroll") for (int k = 0; k < 2; ++k) \
        acc[ai][bj][m][n] = __builtin_amdgcn_mfma_f32_16x16x32_bf16(Bt[n][k], At[m][k], acc[ai][bj][m][n], 0, 0, 0); __builtin_amdgcn_s_setprio(0); } while (0)
#define PG8_MMA8(ai, bj, At, Bt) do { __builtin_amdgcn_s_setprio(1); _Pragma("unroll") for (int m = 0; m < 4; ++m) _Pragma("unroll") for (int n = 0; n < 2; ++n) { \
        const i32x8 a8_ = __builtin_shufflevector(*(const i32x4*)&At[m][0], *(const i32x4*)&At[m][1], 0, 1, 2, 3, 4, 5, 6, 7), b8_ = __builtin_shufflevector(*(const i32x4*)&Bt[n][0], *(const i32x4*)&Bt[n][1], 0, 1, 2, 3, 4, 5, 6, 7); \
        asm volatile("v_mfma_f32_16x16x128_f8f6f4 %0, %1, %2, %0" : "+v"(acc[ai][bj][m][n]) : "v"(b8_), "v"(a8_)); } __builtin_amdgcn_s_setprio(0); } while (0)
#define PG8_MMAI(ai, bj, At, Bt) do { __builtin_amdgcn_s_setprio(1); _Pragma("unroll") for (int k = 0; k < 2; ++k) _Pragma("unroll") for (int m = 0; m < 4; ++m) _Pragma("unroll") for (int n = 0; n < 2; ++n) \
        asm volatile("v_mfma_i32_16x16x64_i8 %0, %1, %2, %0" : "+v"(acc[ai][bj][m][n]) : "v"(*(const i32x4*)&Bt[n][k]), "v"(*(const i32x4*)&At[m][k])); __builtin_amdgcn_s_setprio(0); } while (0)
#define PG8_MMAX(ai, bj, At, Bt) do { if constexpr (F8 == 2) PG8_MMAI(ai, bj, At, Bt); else if constexpr (F8 == 1) PG8_MMA8(ai, bj, At, Bt); else PG8_MMA(ai, bj, At, Bt); } while (0)
#define PG8_WAIT_V(n) asm volatile("s_waitcnt vmcnt(" #n ")" ::: "memory")
#define PG8_WAIT_L(n) asm volatile("s_waitcnt lgkmcnt(" #n ")" ::: "memory")
#define PG8_BAR __builtin_amdgcn_s_barrier()
#define PG8_SCHED __builtin_amdgcn_sched_barrier(0)
    Unit cur, nxt; int ui = 0;
    if (!S.next(0, cur)) return;
    f32x4 acc[2][2][4][2];
#pragma unroll
    for (int a = 0; a < 2; ++a)
#pragma unroll
        for (int b = 0; b < 2; ++b)
#pragma unroll
            for (int m = 0; m < 4; ++m)
#pragma unroll
                for (int n = 0; n < 2; ++n) acc[a][b][m][n] = (f32x4){0.f, 0.f, 0.f, 0.f};
    bf16x8 At[4][2], B0[2][2], B1[2][2];
    const char* cA = (const char*)g.A + (size_t)cur.pm * tstep + g.agoff(cur.ag); const char* cB = (const char*)g.Bt + (size_t)cur.pn * tstep;
    S.a_ready(cur);
    if constexpr (SP2) {
        PG8_STAGE(PG8_SB(0, 0), cB, voffB); PG8_STAGE(PG8_SB(0, 1), cB + hstep, voffB); PG8_STAGE(PG8_SA(0, 0), cA, voffA); PG8_STAGE(PG8_SA(0, 1), cA + hstep, voffA);
        if (wr == 1) PG8_BAR;
        PG8_WAIT_V(2); PG8_BAR;
        PG8_STAGE(PG8_SB(1, 0), cB + kstep, voffB); PG8_STAGE(PG8_SA(1, 0), cA + kstep, voffA); PG8_STAGE(PG8_SB(1, 1), cB + hstep + kstep, voffB);
        PG8_WAIT_V(6); PG8_BAR;
    } else {
        PG8_STAGE(PG8_SB(0, 0), cB, voffB); PG8_STAGE(PG8_SA(0, 0), cA, voffA); PG8_STAGE(PG8_SB(0, 1), cB + hstep, voffB); PG8_STAGE(PG8_SA(0, 1), cA + hstep, voffA);
        if (wr == 1) PG8_BAR;
        PG8_WAIT_V(4); PG8_BAR;
        PG8_STAGE(PG8_SB(1, 0), cB + kstep, voffB); PG8_STAGE(PG8_SA(1, 0), cA + kstep, voffA); PG8_STAGE(PG8_SB(1, 1), cB + hstep + kstep, voffB);
        PG8_WAIT_V(6); PG8_BAR;
    }
    for (;;) {
        const bool has_next = S.next(ui + 1, nxt);
        const char* nA = has_next ? (const char*)g.A + (size_t)nxt.pm * tstep + g.agoff(nxt.ag) : cA; const char* nB = has_next ? (const char*)g.Bt + (size_t)nxt.pn * tstep : cB;
        for (int t = 0; t < nt; t += 2) {
            const bool last = (t == nt - 2);
            const char* a1 = cA + (size_t)(t + 1) * kstep;
            const char* a2 = last ? nA : cA + (size_t)(t + 2) * kstep; const char* b2 = last ? nB : cB + (size_t)(t + 2) * kstep;
            const char* a3 = a2 + kstep; const char* b3 = b2 + kstep;
            if (last && has_next) S.a_ready(nxt);
            if constexpr (SP2) {
            PG8_LDB(B0, 0, 0); PG8_LDB(B1, 0, 1); PG8_SCHED; PG8_LDA(At, 0, 0); PG8_STAGE(PG8_SA(1, 1), a1 + hstep, voffA);
            PG8_WAIT_V(8); PG8_WAIT_L(0); PG8_BAR; PG8_MMAX(0, 0, At, B0); PG8_MMAX(0, 1, At, B1); PG8_BAR; PG8_SCHED;
            PG8_LDA(At, 0, 1); PG8_STAGE(PG8_SB(0, 0), b2, voffB); PG8_STAGE(PG8_SB(0, 1), b2 + hstep, voffB); PG8_STAGE(PG8_SA(0, 0), a2, voffA);
            PG8_WAIT_V(8); PG8_WAIT_L(0); PG8_BAR; PG8_MMAX(1, 0, At, B0); PG8_MMAX(1, 1, At, B1); PG8_BAR; PG8_SCHED;
            PG8_LDB(B0, 1, 0); PG8_LDB(B1, 1, 1); PG8_SCHED; PG8_LDA(At, 1, 0); PG8_STAGE(PG8_SA(0, 1), a2 + hstep, voffA);
            PG8_WAIT_V(8); PG8_WAIT_L(0); PG8_BAR; PG8_MMAX(0, 0, At, B0); PG8_MMAX(0, 1, At, B1); PG8_BAR; PG8_SCHED;
            PG8_LDA(At, 1, 1); PG8_STAGE(PG8_SB(1, 0), b3, voffB); PG8_STAGE(PG8_SB(1, 1), b3 + hstep, voffB); PG8_STAGE(PG8_SA(1, 0), a3, voffA);
            PG8_WAIT_V(8); PG8_WAIT_L(0); PG8_BAR; PG8_MMAX(1, 0, At, B0); PG8_MMAX(1, 1, At, B1); PG8_BAR; PG8_SCHED;
            } else {
            PG8_LDB(B0, 0, 0); PG8_SCHED; PG8_LDA(At, 0, 0); PG8_STAGE(PG8_SA(1, 1), a1 + hstep, voffA);
            PG8_WAIT_L(8); PG8_BAR; PG8_WAIT_L(0); PG8_MMA(0, 0, At, B0); PG8_BAR; PG8_SCHED;
            PG8_LDB(B1, 0, 1); PG8_STAGE(PG8_SB(0, 0), b2, voffB);
            PG8_BAR; PG8_WAIT_L(0); PG8_MMA(0, 1, At, B1); PG8_BAR;
            PG8_LDA(At, 0, 1); PG8_STAGE(PG8_SA(0, 0), a2, voffA);
            PG8_BAR; PG8_WAIT_L(0); PG8_MMA(1, 0, At, B0); PG8_BAR; PG8_SCHED;
            PG8_STAGE(PG8_SB(0, 1), b2 + hstep, voffB);
            PG8_WAIT_V(6); PG8_BAR; PG8_MMA(1, 1, At, B1); PG8_BAR;
            PG8_LDB(B0, 1, 0); PG8_SCHED; PG8_LDA(At, 1, 0); PG8_STAGE(PG8_SA(0, 1), a2 + hstep, voffA);
            PG8_WAIT_L(8); PG8_BAR; PG8_WAIT_L(0); PG8_MMA(0, 0, At, B0); PG8_BAR; PG8_SCHED;
            PG8_LDB(B1, 1, 1); PG8_STAGE(PG8_SB(1, 0), b3, voffB);
            PG8_BAR; PG8_WAIT_L(0); PG8_MMA(0, 1, At, B1); PG8_BAR;
            PG8_LDA(At, 1, 1); PG8_STAGE(PG8_SA(1, 0), a3, voffA);
            PG8_BAR; PG8_WAIT_L(0); PG8_MMA(1, 0, At, B0); PG8_BAR; PG8_SCHED;
            PG8_STAGE(PG8_SB(1, 1), b3 + hstep, voffB);
            PG8_WAIT_V(6); PG8_BAR; PG8_MMA(1, 1, At, B1); PG8_BAR;
            }
        }
        if constexpr (F8 != 0) asm volatile("s_nop 15\n\ts_nop 15" ::: "memory");
        if constexpr (ALIGN_EPI) { if (wr == 0) PG8_BAR; }
        if constexpr (!Epi::AFTER_DRAIN) { E(acc, cur, wr, wc, fr, fq);
#if defined(DUPE)
            if constexpr (Epi::IDEMPOTENT) { asm volatile("" ::: "memory"); E(acc, cur, wr, wc, fr, fq); }
#endif
            S.done(cur); }
        if (!has_next) break;
#pragma unroll
        for (int a = 0; a < 2; ++a)
#pragma unroll
            for (int b = 0; b < 2; ++b)
#pragma unroll
                for (int m = 0; m < 4; ++m)
#pragma unroll
                    for (int n = 0; n < 2; ++n) acc[a][b][m][n] = (f32x4){0.f, 0.f, 0.f, 0.f};
        cur = nxt; cA = nA; cB = nB; ++ui;
        if constexpr (ALIGN_EPI) { if (wr == 1) PG8_BAR; }
    }
    PG8_WAIT_V(0);
    if constexpr (!ALIGN_EPI) { if (wr == 0) PG8_BAR; }
    PG8_BAR;
    if constexpr (Epi::AFTER_DRAIN) { E.fused(acc, cur, wr, wc, fr, fq, lds, wid, lane); S.done(cur); }
#undef PG8_SA
#undef PG8_SB
#undef PG8_STAGE
#undef PG8_LDA
#undef PG8_LDB
#undef PG8_MMA
#undef PG8_WAIT_V
#undef PG8_WAIT_L
#undef PG8_BAR
#undef PG8_SCHED
}
}
#define GAS __attribute__((address_space(1)))
#define LAS __attribute__((address_space(3)))
typedef unsigned short bf16;
typedef unsigned v4u __attribute__((ext_vector_type(4)));
typedef float f32x4 __attribute__((ext_vector_type(4)));
typedef short bf16x8 __attribute__((ext_vector_type(8)));
typedef GAS unsigned gu32;
typedef GAS unsigned long long gu64;
#define RLX_AGENT __ATOMIC_RELAXED, __HIP_MEMORY_SCOPE_AGENT
#define LDS_WAIT() asm volatile("s_waitcnt lgkmcnt(0)" ::: "memory")
#define VM_WAIT() asm volatile("s_waitcnt vmcnt(0)" ::: "memory")
__device__ __forceinline__ unsigned long long rt() { return __builtin_amdgcn_s_memrealtime(); }
__device__ __forceinline__ unsigned f2bf(float f) { unsigned u = __builtin_bit_cast(unsigned, f); return (u + 0x7fffu + ((u >> 16) & 1u)) >> 16; }
__device__ __forceinline__ unsigned pk2(float lo, float hi) { return f2bf(lo) | (f2bf(hi) << 16); }
__device__ __forceinline__ int lane_id() { return (int)__builtin_amdgcn_mbcnt_hi(~0u, __builtin_amdgcn_mbcnt_lo(~0u, 0u)); }
#define XB_TMO      128
#define XB_XCNT(j)  (256  + 64 * (j))
#define XB_XSUB(j)  (1280 + 64 * (j))
#define XB_XGEN(j)  (2304 + 64 * (j))
#define XB_TOP      3328
#define XB_TOPGEN   3392
#define XCD_BAR_WORDS 3456
#define XB_SPIN_CAP (1u << 18)

__device__ __forceinline__ unsigned xb_ld(unsigned* p)              { return __hip_atomic_load(p, __ATOMIC_RELAXED, __HIP_MEMORY_SCOPE_AGENT); }
__device__ __forceinline__ unsigned xb_add(unsigned* p, unsigned v) { return __hip_atomic_fetch_add(p, v, __ATOMIC_RELAXED, __HIP_MEMORY_SCOPE_AGENT); }
__device__ __forceinline__ unsigned xb_xcc_id() { return (unsigned)__builtin_amdgcn_s_getreg((3 << 11) | 20) & 0xFu; }
#define XB_SPIN(cond, bar) do { unsigned _sp = 0; while (cond) { __builtin_amdgcn_s_sleep(1); \
    if ((++_sp & 255u) == 0u) { if (xb_ld(&(bar)[XB_TMO])) break; if (_sp > XB_SPIN_CAP) { atomicAdd(&(bar)[XB_TMO], 1u); break; } } } } while (0)

struct XcdBarrier {
    unsigned* bar; unsigned x; unsigned w;
    volatile LAS unsigned* st;
};

__device__ __forceinline__ XcdBarrier xcd_barrier_post(unsigned* bar, volatile LAS unsigned* st) {
    XcdBarrier b; b.bar = bar; b.x = xb_xcc_id(); b.st = st; b.w = (unsigned)__builtin_amdgcn_readfirstlane((int)(threadIdx.x >> 6));
    if (threadIdx.x == 0) (void)xb_add(&bar[XB_XCNT(b.x)], 1u);
    return b;
}
__device__ __forceinline__ void xcd_barrier_complete(unsigned* bar, unsigned x, unsigned& nloc, unsigned& nx) {
    const unsigned G = gridDim.x * gridDim.y * gridDim.z;
    unsigned sum, cnt, mine, sp = 0u;
    for (;;) {
        sum = 0u; cnt = 0u; mine = 0u;
#pragma unroll
        for (unsigned j = 0; j < 16; ++j) { const unsigned c = xb_ld(&bar[XB_XCNT(j)]); sum += c; cnt += (c > 0u) ? 1u : 0u; mine = (j == x) ? c : mine; }
        if (sum == G) break;
        __builtin_amdgcn_s_sleep(1);
        if ((++sp & 255u) == 0u) { if (xb_ld(&bar[XB_TMO])) break; if (sp > XB_SPIN_CAP) { atomicAdd(&bar[XB_TMO], 1u); break; } }
    }
    nloc = mine > 0u ? mine : 1u; nx = cnt > 0u ? cnt : 1u;
}

__device__ __forceinline__ void xcd_barrier(const XcdBarrier& b) {
    asm volatile("s_waitcnt vmcnt(0)" ::: "memory");
    __syncthreads();
    if (b.w == 0u && lane_id() == 0) {
        unsigned* bar = b.bar;
        __builtin_amdgcn_s_waitcnt(0);
        unsigned nloc = b.st[0], nx = b.st[1];
        if (nloc == 0u) { xcd_barrier_complete(bar, b.x, nloc, nx); b.st[0] = nloc; b.st[1] = nx; }
        const unsigned old = xb_add(&bar[XB_XSUB(b.x)], 1u);
        const unsigned gen = old / nloc;
        if (old + 1u == (gen + 1u) * nloc) {
            __builtin_amdgcn_fence(__ATOMIC_RELEASE, "agent");
            asm volatile("s_waitcnt vmcnt(0)" ::: "memory");
            const unsigned og = xb_add(&bar[XB_TOP], 1u);
            const unsigned tg = og / nx;
            if (og + 1u == (tg + 1u) * nx) xb_add(&bar[XB_TOPGEN], 1u);
            else XB_SPIN(xb_ld(&bar[XB_TOPGEN]) == tg, bar);
            __builtin_amdgcn_fence(__ATOMIC_ACQUIRE, "agent");
            xb_add(&bar[XB_XGEN(b.x)], 1u);
            asm volatile("s_waitcnt vmcnt(0)" ::: "memory");
        } else {
            XB_SPIN(xb_ld(&bar[XB_XGEN(b.x)]) == gen, bar);
            __builtin_amdgcn_fence(__ATOMIC_ACQUIRE, "agent");
            asm volatile("s_waitcnt vmcnt(0)" ::: "memory");
        }
    }
    __syncthreads();
}
namespace att {
#ifndef FOX_HORIZON
#define FOX_HORIZON 30.f
#endif
#ifndef DSA_UNION
#define DSA_UNION 1
#endif
#ifndef DSA_CHECK
#define DSA_CHECK 0
#endif
#define DSA_DENSE_HOOK
#ifndef PRUNE_AT
#define PRUNE_AT 480
#endif
#ifndef DUPX
#define DUPX 0
#endif
#define ALAS __attribute__((address_space(3)))
typedef unsigned short bf16_t;
typedef short bf16x8 __attribute__((ext_vector_type(8)));
typedef short s16x4 __attribute__((ext_vector_type(4)));
typedef float f32x16 __attribute__((ext_vector_type(16)));
typedef float f32x4 __attribute__((ext_vector_type(4)));
typedef unsigned u32x4 __attribute__((ext_vector_type(4)));
typedef ALAS unsigned char lchar;
constexpr int S = 8192, NB = 4, LD = 1024, HD = 128;
constexpr int SHM_K = 16384, SHM_V = 16384;
constexpr float SCALE = 0.08838834764831845f, L2E = 1.4426950408889634f, LN2 = 0.6931471805599453f;
#define KSWZ(row, colB) ((row) * 256 + ((colB) ^ (((row) & 7) << 4)))
#define SBAR() __builtin_amdgcn_sched_barrier(0)
__device__ __forceinline__ int v_st(int k, int c) { const int kk = (k & ~0xC) | ((k & 4) << 1) | ((k & 8) >> 1); return ((kk >> 3) * 4 + (c >> 5)) * 512 + ((kk & 7) * 32 + (c & 31)) * 2; }
__device__ __forceinline__ int v_rd_base(int lane) { return ((lane & 3) << 3) | (((lane >> 2) & 3) << 6) | (((lane >> 4) & 1) << 5) | (((lane >> 5) & 1) << 8); }
constexpr int v_rd_off(int d0, int ks, int half) { return d0 * 512 + ks * 4096 + half * 2048; }
__device__ __forceinline__ int crow(int r, int hi) { return (r & 3) + 8 * (r >> 2) + 4 * hi; }
__device__ __forceinline__ unsigned cvtpk(float lo, float hi) { unsigned r; asm volatile("v_cvt_pk_bf16_f32 %0, %1, %2" : "=v"(r) : "v"(lo), "v"(hi)); return r; }
__device__ __forceinline__ float pair_sum(float v) { auto rr = __builtin_amdgcn_permlane32_swap(__float_as_uint(v), __float_as_uint(v), false, false); return __uint_as_float(rr[0]) + __uint_as_float(rr[1]); }
__device__ __forceinline__ float pair_max(float v) { auto rr = __builtin_amdgcn_permlane32_swap(__float_as_uint(v), __float_as_uint(v), false, false); return fmaxf(__uint_as_float(rr[0]), __uint_as_float(rr[1])); }
__device__ __forceinline__ void pair_sum_other(float v, int hi, float& sum, float& other) {
    auto rr = __builtin_amdgcn_permlane32_swap(__float_as_uint(v), __float_as_uint(v), false, false);
    const float a = __uint_as_float(rr[0]), b = __uint_as_float(rr[1]); sum = a + b; other = hi ? a : b;
}
#define ATT_PK4(P, B_, OUT) do { unsigned a0 = cvtpk(P[B_+0], P[B_+1]), a1 = cvtpk(P[B_+2], P[B_+3]);                          \
        unsigned b0 = cvtpk(P[B_+4], P[B_+5]), b1 = cvtpk(P[B_+6], P[B_+7]);                                             \
        auto r0 = __builtin_amdgcn_permlane32_swap(a0, b0, false, false); auto r1 = __builtin_amdgcn_permlane32_swap(a1, b1, false, false); \
        u32x4 w = {r0[0], r1[0], r0[1], r1[1]}; OUT = *reinterpret_cast<bf16x8*>(&w); } while (0)

__device__ __forceinline__ void qkt(f32x16& p0, f32x16& p1, const lchar* kt, int r32, int hi, const bf16x8* qr) {
    p0 = f32x16{}; p1 = f32x16{};
    const lchar* kb[4];
#pragma unroll
    for (int dd = 0; dd < 4; ++dd) kb[dd] = kt + KSWZ(r32, (dd * 16 + hi * 8) * 2);
    bf16x8 ka[2], kc[2];
    ka[0] = *reinterpret_cast<const ALAS bf16x8*>(kb[0]); ka[1] = *reinterpret_cast<const ALAS bf16x8*>(kb[0] + 32 * 256);
#pragma unroll
    for (int d0 = 0; d0 < 8; ++d0) {
        if (d0 < 7) { const lchar* a = kb[(d0 + 1) & 3] + ((d0 + 1) >> 2) * 128; kc[0] = *reinterpret_cast<const ALAS bf16x8*>(a); kc[1] = *reinterpret_cast<const ALAS bf16x8*>(a + 32 * 256); }
        SBAR();
        p0 = __builtin_amdgcn_mfma_f32_32x32x16_bf16(ka[0], qr[d0], p0, 0, 0, 0);
        p1 = __builtin_amdgcn_mfma_f32_32x32x16_bf16(ka[1], qr[d0], p1, 0, 0, 0);
        SBAR();
        ka[0] = kc[0]; ka[1] = kc[1]; }
}
#define ATT_TRRD(dst, off) asm volatile("ds_read_b64_tr_b16 %0, %1 offset:%2" : "=&v"(dst) : "v"(vb), "i"(off) : "memory")
__device__ __forceinline__ void pv64(f32x16* o, int vb, bf16x8 pa0, bf16x8 pa1, bf16x8 pa2, bf16x8 pa3) {
#define ATT_RD8(S, d0) do { constexpr int b_ = v_rd_off(d0, 0, 0); ATT_TRRD(S##l0, b_); ATT_TRRD(S##h0, b_ + 2048); ATT_TRRD(S##l1, b_ + 4096); ATT_TRRD(S##h1, b_ + 6144); \
        ATT_TRRD(S##l2, b_ + 8192); ATT_TRRD(S##h2, b_ + 10240); ATT_TRRD(S##l3, b_ + 12288); ATT_TRRD(S##h3, b_ + 14336); } while (0)
#define ATT_MM4(S, d0) do { \
        o[d0] = __builtin_amdgcn_mfma_f32_32x32x16_bf16(pa0, (bf16x8){S##l0[0], S##l0[1], S##l0[2], S##l0[3], S##h0[0], S##h0[1], S##h0[2], S##h0[3]}, o[d0], 0, 0, 0);   \
        o[d0] = __builtin_amdgcn_mfma_f32_32x32x16_bf16(pa1, (bf16x8){S##l1[0], S##l1[1], S##l1[2], S##l1[3], S##h1[0], S##h1[1], S##h1[2], S##h1[3]}, o[d0], 0, 0, 0);   \
        o[d0] = __builtin_amdgcn_mfma_f32_32x32x16_bf16(pa2, (bf16x8){S##l2[0], S##l2[1], S##l2[2], S##l2[3], S##h2[0], S##h2[1], S##h2[2], S##h2[3]}, o[d0], 0, 0, 0);   \
        o[d0] = __builtin_amdgcn_mfma_f32_32x32x16_bf16(pa3, (bf16x8){S##l3[0], S##l3[1], S##l3[2], S##l3[3], S##h3[0], S##h3[1], S##h3[2], S##h3[3]}, o[d0], 0, 0, 0); } while (0)
    s16x4 al0, al1, al2, al3, ah0, ah1, ah2, ah3, bl0, bl1, bl2, bl3, bh0, bh1, bh2, bh3, cl0, cl1, cl2, cl3, ch0, ch1, ch2, ch3, dl0, dl1, dl2, dl3, dh0, dh1, dh2, dh3;
    SBAR();
    ATT_RD8(a, 0); ATT_RD8(b, 1);
    asm volatile("s_waitcnt lgkmcnt(8)" ::: "memory"); SBAR(); ATT_MM4(a, 0); SBAR();
    ATT_RD8(c, 2);
    asm volatile("s_waitcnt lgkmcnt(8)" ::: "memory"); SBAR(); ATT_MM4(b, 1); SBAR();
    ATT_RD8(d, 3);
    asm volatile("s_waitcnt lgkmcnt(8)" ::: "memory"); SBAR(); ATT_MM4(c, 2); SBAR();
    asm volatile("s_waitcnt lgkmcnt(0)" ::: "memory"); SBAR(); ATT_MM4(d, 3);
#undef ATT_RD8
#undef ATT_MM4
}
__device__ __forceinline__ void pv32(f32x16* o, int vb, bf16x8 pa0, bf16x8 pa1) {
#define ATT_PV_D0(d0) do { s16x4 l0, l1, h0, h1; constexpr int b_ = v_rd_off(d0, 0, 0); \
        ATT_TRRD(l0, b_); ATT_TRRD(h0, b_ + 2048); ATT_TRRD(l1, b_ + 4096); ATT_TRRD(h1, b_ + 6144); \
        asm volatile("s_waitcnt lgkmcnt(0)" ::: "memory"); SBAR();   \
        o[d0] = __builtin_amdgcn_mfma_f32_32x32x16_bf16(pa0, (bf16x8){l0[0], l0[1], l0[2], l0[3], h0[0], h0[1], h0[2], h0[3]}, o[d0], 0, 0, 0);   \
        o[d0] = __builtin_amdgcn_mfma_f32_32x32x16_bf16(pa1, (bf16x8){l1[0], l1[1], l1[2], l1[3], h1[0], h1[1], h1[2], h1[3]}, o[d0], 0, 0, 0); } while (0)
    ATT_PV_D0(0); ATT_PV_D0(1); ATT_PV_D0(2); ATT_PV_D0(3);
#undef ATT_PV_D0
}

__device__ __forceinline__ float bfl(unsigned w) { return __uint_as_float(w << 16); }
__device__ __forceinline__ float bfh(unsigned w) { return __uint_as_float(w & 0xffff0000u); }
template <bool ROPE>
__device__ __forceinline__ void q_row_norm(bf16x8 (&q)[8], const float* g, const float* cs, const float* sn, int hi) {
    float x[8][8]; float s = 0.f;
#pragma unroll
    for (int d0 = 0; d0 < 8; ++d0) { const u32x4 w = *reinterpret_cast<const u32x4*>(&q[d0]);
        x[d0][0] = bfl(w[0]); x[d0][1] = bfh(w[0]); x[d0][2] = bfl(w[1]); x[d0][3] = bfh(w[1]); x[d0][4] = bfl(w[2]); x[d0][5] = bfh(w[2]); x[d0][6] = bfl(w[3]); x[d0][7] = bfh(w[3]);
#pragma unroll
        for (int j = 0; j < 8; ++j) s += x[d0][j] * x[d0][j]; }
    s = pair_sum(s);
    const float rs = 1.0f / sqrtf(s * (1.0f / 128.0f) + 1e-6f);
#pragma unroll
    for (int d0 = 0; d0 < 8; ++d0) { const float* gp = g + d0 * 16 + hi * 8; const f32x4 g0 = *(const f32x4*)gp, g1 = *(const f32x4*)(gp + 4);
#pragma unroll
        for (int j = 0; j < 4; ++j) { x[d0][j] = x[d0][j] * rs * g0[j]; x[d0][4 + j] = x[d0][4 + j] * rs * g1[j]; } }
    if (ROPE) {
#pragma unroll
        for (int d0 = 0; d0 < 4; ++d0) { const int i0 = d0 * 16 + hi * 8; const f32x4 c0 = *(const f32x4*)(cs + i0), c1 = *(const f32x4*)(cs + i0 + 4), s0 = *(const f32x4*)(sn + i0), s1 = *(const f32x4*)(sn + i0 + 4);
#pragma unroll
            for (int j = 0; j < 8; ++j) { const float cc = j < 4 ? c0[j & 3] : c1[j & 3], ss = j < 4 ? s0[j & 3] : s1[j & 3];
                const float a1 = x[d0][j] * cc - x[d0 + 4][j] * ss, a2 = x[d0 + 4][j] * cc + x[d0][j] * ss; x[d0][j] = a1; x[d0 + 4][j] = a2; } }
    }
#pragma unroll
    for (int d0 = 0; d0 < 8; ++d0) { u32x4 w = {cvtpk(x[d0][0], x[d0][1]), cvtpk(x[d0][2], x[d0][3]), cvtpk(x[d0][4], x[d0][5]), cvtpk(x[d0][6], x[d0][7])}; q[d0] = *reinterpret_cast<bf16x8*>(&w); }
}
__device__ __forceinline__ void idxq_rope(bf16x8 (&a)[4], const float* cs, const float* sn, int hi) {
#pragma unroll
    for (int ks = 0; ks < 2; ++ks) { const int i0 = ks * 16 + hi * 8; const f32x4 c0 = *(const f32x4*)(cs + i0), c1 = *(const f32x4*)(cs + i0 + 4), s0 = *(const f32x4*)(sn + i0), s1 = *(const f32x4*)(sn + i0 + 4);
        const u32x4 w1 = *reinterpret_cast<const u32x4*>(&a[ks]), w2 = *reinterpret_cast<const u32x4*>(&a[ks + 2]); float y1[8], y2[8];
#pragma unroll
        for (int j = 0; j < 8; ++j) { const float cc = j < 4 ? c0[j & 3] : c1[j & 3], ss = j < 4 ? s0[j & 3] : s1[j & 3];
            const float x1 = (j & 1) ? bfh(w1[j >> 1]) : bfl(w1[j >> 1]), x2 = (j & 1) ? bfh(w2[j >> 1]) : bfl(w2[j >> 1]);
            y1[j] = x1 * cc - x2 * ss; y2[j] = x2 * cc + x1 * ss; }
        u32x4 o1 = {cvtpk(y1[0], y1[1]), cvtpk(y1[2], y1[3]), cvtpk(y1[4], y1[5]), cvtpk(y1[6], y1[7])}, o2 = {cvtpk(y2[0], y2[1]), cvtpk(y2[2], y2[3]), cvtpk(y2[4], y2[5]), cvtpk(y2[6], y2[7])};
        a[ks] = *reinterpret_cast<bf16x8*>(&o1); a[ks + 2] = *reinterpret_cast<bf16x8*>(&o2); }
}

constexpr int A_OFF_V = 0, A_OFF_K = 32768, A_OFF_BIAS = 65536, A_OFF_WS = 66048, A_OFF_FLAG = 68096;
constexpr float SB_DONE = -40.0f;
template <int MODE>
__device__ __forceinline__ void dense_unit(lchar* lds, const bf16_t* Qb, const bf16_t* Kb, const bf16_t* Vb, bf16_t* Ob, const float* cl, const float* ctot, const float* gq, const float* gk, int b, int h, int qb, int wave_) {
    int tid_ = wave_ * 64 + (int)__builtin_amdgcn_mbcnt_hi(~0u, __builtin_amdgcn_mbcnt_lo(~0u, 0u)); asm volatile("" : "+v"(tid_));
    const int tid = tid_, wid = __builtin_amdgcn_readfirstlane(tid >> 6), lane = tid & 63, r32 = lane & 31, hi = lane >> 5;
    const int q0 = qb * 256, qlo = q0 + wid * 32;
    const size_t rowbase = (size_t)b * S;
    const int hc = h * HD;
    bf16x8 qr[8];
#pragma unroll
    for (int d0 = 0; d0 < 8; ++d0) qr[d0] = *(const bf16x8*)(Qb + (rowbase + qlo + r32) * LD + hc + d0 * 16 + hi * 8);
    if (MODE == 1) q_row_norm<false>(qr, gq, nullptr, nullptr, hi);
    const int sr = tid >> 4, sc = (tid & 15) * 8, vst0 = v_st(sr, sc), vst1 = v_st(32 + sr, sc), kws = KSWZ(sr, sc * 2);
    lchar* V_lds = lds + A_OFF_V; lchar* K_lds = lds + A_OFF_K;
    ALAS float* bias_l = (ALAS float*)(lds + A_OFF_BIAS);
    ALAS float* wsf = (ALAS float*)(lds + A_OFF_WS) + wid * 64;
    ALAS int* flags = (ALAS int*)(lds + A_OFF_FLAG);
    const int vb0 = (int)(unsigned)(size_t)V_lds + v_rd_base(lane);
    const float* clh = cl + (size_t)(b * 8 + h) * S; const float* cth = ctot + (b * 8 + h) * 64;
    const int jd = qb * 4 + 3;
    float dsum = 0.f, skip_thr = 0.f, mrow = 0.f, zh2 = 0.f, zrow = 0.f, xrow = -__builtin_inff(), vpost = -__builtin_inff(); int nact = 0;
    if (MODE == 1) { dsum = -cth[qb * 2];
        float a_ = fmaxf(fabsf(gq[lane]), fabsf(gq[lane + 64])), b_ = fmaxf(fabsf(gk[lane]), fabsf(gk[lane + 64]));
#pragma unroll
        for (int o_ = 32; o_ >= 1; o_ >>= 1) { a_ = fmaxf(a_, __shfl_xor(a_, o_)); b_ = fmaxf(b_, __shfl_xor(b_, o_)); }
        skip_thr = -(2.f * 11.3138f * a_ * b_ + FOX_HORIZON) * L2E;
        zh2 = FOX_HORIZON * L2E;
        {   float q2 = 0.f;
#pragma unroll
            for (int d0 = 0; d0 < 8; ++d0) { const u32x4 w = *reinterpret_cast<const u32x4*>(&qr[d0]);
#pragma unroll
                for (int j = 0; j < 4; ++j) { const float lo = bfl(w[j]), hh = bfh(w[j]); q2 += lo * lo + hh * hh; } }
            zrow = sqrtf(pair_sum(q2)) * b_ * L2E * 1.004f; }
        mrow = fminf(11.3138f * a_ * b_ * L2E, 50.f) + ((wid >= 4 ? -cth[qb * 2] : 0.f) - clh[qlo + r32]) * L2E; }
    bf16x8 st_k0, st_k1, st_v0, st_v1; float st_b = 0.f;
#define STAGE_LOAD(t_) do { const size_t r0_ = (rowbase + (size_t)(t_) * 64 + sr) * LD + hc + sc; \
        st_k0 = *(const bf16x8*)(Kb + r0_); st_k1 = *(const bf16x8*)(Kb + r0_ + (size_t)32 * LD); st_v0 = *(const bf16x8*)(Vb + r0_); st_v1 = *(const bf16x8*)(Vb + r0_ + (size_t)32 * LD); \
        if (MODE == 1 && tid < 64) st_b = (dsum - clh[(t_) * 64 + tid]) * L2E; } while (0)
#define STAGE_WRITE(bf_) do { *(ALAS bf16x8*)(K_lds + (bf_) * SHM_K + kws) = st_k0; *(ALAS bf16x8*)(K_lds + (bf_) * SHM_K + kws + 32 * 256) = st_k1; \
        *(ALAS bf16x8*)(V_lds + (bf_) * SHM_V + vst0) = st_v0; *(ALAS bf16x8*)(V_lds + (bf_) * SHM_V + vst1) = st_v1; \
        if (MODE == 1 && tid < 64) bias_l[(bf_) * 64 + tid] = st_b; } while (0)
    STAGE_LOAD(jd); STAGE_WRITE(0);
    { int z_ = 0; asm volatile("" : "+v"(z_));
      if (MODE == 1 && tid == 0) { flags[16] = z_; flags[17] = z_; }
      if (MODE == 0 && lane == 0) { flags[wid] = z_; flags[8 + wid] = z_; } }
    __syncthreads();
    float l_reg = 0.f, carry = 0.f; f32x16 o[4] = {};
    bool wdone = false;
    for (int t = jd, it = 0; ; --t, ++it) {
        const int buf = it & 1, k0 = t * 64;
        if (MODE == 0 && it > 0) { int alld = 1;
#pragma unroll
            for (int w = 0; w < 8; ++w) alld &= flags[((it - 1) & 1) * 8 + w];
            if (alld) break; }
        if (MODE == 1 && it > 0 && flags[16 + ((it - 1) & 1)]) break;
        const bool more = t > 0;
        if (more) { if (MODE == 1 && ((t - 1) & 1)) dsum += cth[(t - 1) >> 1]; STAGE_LOAD(t - 1); }
        const bool act = (MODE == 0) ? (k0 <= qlo + 30 && !wdone) : (k0 <= qlo + 31);
        if (act) {
            f32x16 p0, p1; bf16x8 pa0, pa1, pa2, pa3;
            qkt(p0, p1, K_lds + buf * SHM_K, r32, hi, qr);
            const int dq = qlo + r32 - k0 - 4 * hi;
            if (MODE == 0) {
                const bool nm = k0 + 63 >= qlo;
                f32x16 z0, z1;
#pragma unroll
                for (int r = 0; r < 16; ++r) { const int c = (r & 3) + 8 * (r >> 2);
                    float z = p0[r] * SCALE; float e = __builtin_amdgcn_exp2f(-fabsf(z) * L2E); float lk = -(fmaxf(z, 0.f) + LN2 * __builtin_amdgcn_logf(1.f + e));
                    if (nm && !(c < dq)) { lk = 0.f; z = -__builtin_inff(); } z0[r] = z; p0[r] = lk;
                    z = p1[r] * SCALE; e = __builtin_amdgcn_exp2f(-fabsf(z) * L2E); lk = -(fmaxf(z, 0.f) + LN2 * __builtin_amdgcn_logf(1.f + e));
                    if (nm && !(c + 32 < dq)) { lk = 0.f; z = -__builtin_inff(); } z1[r] = z; p1[r] = lk; }
                float U0[4], U1[4], O0[4], O1[4];
#pragma unroll
                for (int c4 = 0; c4 < 4; ++c4) { const int bq = 4 * c4;
                    p0[bq + 2] += p0[bq + 3]; p0[bq + 1] += p0[bq + 2]; p0[bq] += p0[bq + 1];
                    p1[bq + 2] += p1[bq + 3]; p1[bq + 1] += p1[bq + 2]; p1[bq] += p1[bq + 1];
                    pair_sum_other(p0[bq], hi, U0[c4], O0[c4]); pair_sum_other(p1[bq], hi, U1[c4], O1[c4]); }
                float W1[4], W0[4];
                W1[3] = carry; W1[2] = W1[3] + U1[3]; W1[1] = W1[2] + U1[2]; W1[0] = W1[1] + U1[1];
                W0[3] = W1[0] + U1[0]; W0[2] = W0[3] + U0[3]; W0[1] = W0[2] + U0[2]; W0[0] = W0[1] + U0[1];
                const float carry_new = W0[0] + U0[0];
#pragma unroll
                for (int c4 = 0; c4 < 4; ++c4) { const float f0 = W0[c4] + (hi ? 0.f : O0[c4]), f1 = W1[c4] + (hi ? 0.f : O1[c4]);
#pragma unroll
                    for (int e = 0; e < 4; ++e) { const int r = 4 * c4 + e;
                        p0[r] = __builtin_amdgcn_exp2f((z0[r] + (p0[r] + f0)) * L2E);
                        p1[r] = __builtin_amdgcn_exp2f((z1[r] + (p1[r] + f1)) * L2E); } }
                carry = carry_new;
                ATT_PK4(p0, 0, pa0); ATT_PK4(p0, 8, pa1); ATT_PK4(p1, 0, pa2); ATT_PK4(p1, 8, pa3);
                pv64(o, vb0 + buf * SHM_V, pa0, pa1, pa2, pa3);
                if (__all(carry < SB_DONE)) wdone = true;
            } else {
                constexpr float C2 = SCALE * L2E;
                const bool nm = k0 + 63 > qlo;
                const ALAS float* bl = bias_l + buf * 64 + 4 * hi;
#pragma unroll
                for (int c4 = 0; c4 < 4; ++c4) { const f32x4 b0 = *(const ALAS f32x4*)(bl + 8 * c4), b1 = *(const ALAS f32x4*)(bl + 32 + 8 * c4);
#pragma unroll
                    for (int e = 0; e < 4; ++e) { const int r = 4 * c4 + e, c = e + 8 * c4;
                        float x0 = fmaf(p0[r], C2, b0[e]) - mrow, x1 = fmaf(p1[r], C2, b1[e]) - mrow;
                        if (nm && !(c <= dq)) x0 = -__builtin_inff();
                        if (nm && !(c + 32 <= dq)) x1 = -__builtin_inff();
                        p0[r] = x0; p1[r] = x1; } }
                if (nact < 2) { float xm = -__builtin_inff();
#pragma unroll
                    for (int r = 0; r < 16; ++r) xm = fmaxf(xm, fmaxf(p0[r], p1[r]));
                    xrow = fmaxf(xrow, xm); ++nact;
                    if (nact == 2 || t == 0) { float v = pair_max(xrow) + mrow - zrow;
#pragma unroll
                        for (int o_ = 16; o_ >= 1; o_ >>= 1) v = fminf(v, __shfl_xor(v, o_));
                        vpost = v; } }
                float ps = 0.f;
#pragma unroll
                for (int r = 0; r < 16; ++r) { p0[r] = __builtin_amdgcn_exp2f(p0[r]); p1[r] = __builtin_amdgcn_exp2f(p1[r]); ps += p0[r] + p1[r]; }
                l_reg += pair_sum(ps);
                ATT_PK4(p0, 0, pa0); ATT_PK4(p0, 8, pa1); ATT_PK4(p1, 0, pa2); ATT_PK4(p1, 8, pa3);
                pv64(o, vb0 + buf * SHM_V, pa0, pa1, pa2, pa3);
            }
        }
        if (more) STAGE_WRITE(buf ^ 1);
        if (MODE == 0 && lane == 0) flags[(it & 1) * 8 + wid] = wdone ? 1 : 0;
        if (MODE == 1 && lane == 0) ((ALAS float*)flags)[20 + (it & 1) * 8 + wid] = vpost;
        if (MODE == 1 && tid == 63) { float gm = -__builtin_inff();
            if (it > 0) { gm = ((ALAS float*)flags)[20 + ((it - 1) & 1) * 8];
#pragma unroll
                for (int w = 1; w < 8; ++w) gm = fminf(gm, ((ALAS float*)flags)[20 + ((it - 1) & 1) * 8 + w]); }
            flags[16 + (it & 1)] = (more && st_b < fmaxf(skip_thr, gm - zh2)) ? 1 : 0; }
        __syncthreads();
        if (!more) break;
    }
#undef STAGE_LOAD
#undef STAGE_WRITE
    float rli[16];
    if (MODE == 1) { if (hi == 0) wsf[32 + r32] = l_reg; asm volatile("s_waitcnt lgkmcnt(0)" ::: "memory");
#pragma unroll
        for (int r = 0; r < 16; ++r) rli[r] = __builtin_amdgcn_rcpf(wsf[32 + crow(r, hi)]); }
    bf16_t* Ow = Ob + (rowbase + qlo) * LD + hc;
#pragma unroll
    for (int r = 0; r < 16; ++r) { const int orow = crow(r, hi);
#pragma unroll
        for (int d0 = 0; d0 < 4; ++d0) { float v = o[d0][r]; if (MODE == 1) v *= rli[r];
            const float vn = __shfl_xor(v, 1);
            if ((r32 & 1) == 0) *(unsigned*)(Ow + (size_t)orow * LD + d0 * 32 + r32) = cvtpk(v, vn); } }
    __syncthreads();
}

constexpr int D_OFF_CAND = 0, D_OFF_IK = 65536, D_IK_STAGE = 32768, D_OFF_WS = 132096;
__device__ __forceinline__ float relu_raw(float x) { const int b = __builtin_bit_cast(int, x); return __builtin_bit_cast(float, b > 0 ? b : 0); }
template <bool FULL>
__device__ __forceinline__ void topk_prune(ALAS unsigned* cand, int& cnt, unsigned& thr, int lane) {
    unsigned k[8]; unsigned mx = 0u;
#pragma unroll
    for (int j = 0; j < 8; ++j) { const int idx = lane + 64 * j; k[j] = idx < cnt ? cand[idx] : 0u; mx = k[j] > mx ? k[j] : mx; }
#define ATT_DPPMAX(ctrl, rmask) do { const unsigned t_ = (unsigned)__builtin_amdgcn_update_dpp((int)mx, (int)mx, ctrl, rmask, 0xF, false); mx = t_ > mx ? t_ : mx; } while (0)
    ATT_DPPMAX(0x121, 0xF); ATT_DPPMAX(0x122, 0xF); ATT_DPPMAX(0x124, 0xF); ATT_DPPMAX(0x128, 0xF);
    ATT_DPPMAX(0x142, 0xA); ATT_DPPMAX(0x143, 0xC);
#undef ATT_DPPMAX
    mx = (unsigned)__builtin_amdgcn_readlane((int)mx, 63);
    const int hb = 31 - __builtin_clz(mx ^ thr);
    unsigned T = hb == 31 ? 0u : ((thr >> (hb + 1)) << (hb + 1)); int cT = cnt;
    for (int bit = hb; bit >= 0; --bit) {
        if (FULL ? cT == 256 : cT <= 288) break;
        const unsigned Tc = T | (1u << bit); int c = 0;
#pragma unroll
        for (int j = 0; j < 8; ++j) c += __builtin_popcountll(__ballot(k[j] >= Tc));
        if (c >= 256) { T = Tc; cT = c; } }
    int base = 0;
#pragma unroll
    for (int j = 0; j < 8; ++j) { const bool keep = (lane + 64 * j < cnt) && k[j] >= T; const unsigned long long mk = __ballot(keep);
        const int pos = base + (int)__builtin_amdgcn_mbcnt_hi((unsigned)(mk >> 32), __builtin_amdgcn_mbcnt_lo((unsigned)mk, 0u));
        if (keep) cand[pos] = k[j]; base += __builtin_popcountll(mk); }
    cnt = base; thr = T ? T - 1u : 0u;
}
__device__ __forceinline__ void dsa_item(lchar* lds, const bf16_t* idxq, const bf16_t* idxk, const float* idxw, const bf16_t* dsaq, const bf16_t* dsakv, bf16_t* odsa, unsigned* dmask, unsigned* dscr, bf16_t* ochk, unsigned* chkflag, const float* gq, const float* gk, const float* tab, int b, int jt, int wave_) {
    int tid_ = wave_ * 64 + (int)__builtin_amdgcn_mbcnt_hi(~0u, __builtin_amdgcn_mbcnt_lo(~0u, 0u)); asm volatile("" : "+v"(tid_));
    const int tid = tid_, wid = __builtin_amdgcn_readfirstlane(tid >> 6), lane = tid & 63, c = lane & 31, hi = lane >> 5;
    const int t0 = jt * 32, qw = 4 * wid; const size_t tok0 = (size_t)b * S + t0;
    ALAS unsigned* candw = (ALAS unsigned*)(lds + D_OFF_CAND) + qw * 512;
    const int skk = tid >> 1, shalf = tid & 1;
    bf16x8 sg[4];
#define IK_LOAD(s_) do { const bf16_t* src_ = idxk + ((size_t)b * S + 256 * (s_) + skk) * 64 + shalf * 32; \
        _Pragma("unroll") for (int i_ = 0; i_ < 4; ++i_) sg[i_] = *(const bf16x8*)(src_ + 8 * i_); } while (0)
#define IK_WRITE(bf_) do { lchar* dst_ = lds + D_OFF_IK + (bf_) * D_IK_STAGE + skk * 128; \
        _Pragma("unroll") for (int i_ = 0; i_ < 4; ++i_) *(ALAS bf16x8*)(dst_ + (((shalf * 4 + i_) * 16) ^ ((skk & 7) << 4))) = sg[i_]; } while (0)
    IK_LOAD(0);
    bf16x8 A[2][4]; float wv[2][16];
#pragma unroll
    for (int mt = 0; mt < 2; ++mt) {
#pragma unroll
        for (int ks = 0; ks < 4; ++ks) A[mt][ks] = *(const bf16x8*)(idxq + (tok0 + qw + 2 * mt + (c >> 4)) * 1024 + (c & 15) * 64 + ks * 16 + hi * 8);
#pragma unroll
        for (int r = 0; r < 16; ++r) wv[mt][r] = idxw[(tok0 + qw + 2 * mt + (r >> 3)) * 16 + ((r & 3) + 8 * ((r >> 2) & 1) + 4 * hi)];
    }
#pragma unroll
    for (int mt = 0; mt < 2; ++mt) { const size_t tq_ = (size_t)(t0 + qw + 2 * mt + (c >> 4)); idxq_rope(A[mt], tab + (size_t)S * 128 + tq_ * 32, tab + (size_t)S * 160 + tq_ * 32, hi); }
    int cnt[4]; unsigned thr[4];
#ifndef REPI
#define REPI 1
#endif
#pragma unroll 1
    for (int repi = 0; repi < REPI; ++repi) {
    cnt[0] = cnt[1] = cnt[2] = cnt[3] = 0; thr[0] = thr[1] = thr[2] = thr[3] = 0u;
    const unsigned him = hi ? 0xFFFFFFFFu : 0u; const int cbase[2] = {(int)(unsigned)(size_t)(candw + hi * 512), (int)(unsigned)(size_t)(candw + (2 + hi) * 512)};
    unsigned thv[2] = {0u, 0u};
    const int nst = (t0 + 32 + 255) >> 8;
#pragma unroll
    for (int mt = 0; mt < 2; ++mt) {
#pragma unroll
        for (int ks = 0; ks < 4; ++ks) asm volatile("" :: "v"(A[mt][ks]));
#pragma unroll
        for (int r = 0; r < 16; ++r) asm volatile("" :: "v"(wv[mt][r])); }
    IK_WRITE(0);
    __syncthreads();
    for (int s = 0; s < nst; ++s) {
        const int buf = s & 1;
        if (s + 1 < nst) IK_LOAD(s + 1);
        const lchar* kb = lds + D_OFF_IK + buf * D_IK_STAGE;
        int jmax = ((t0 + qw + 3 - 256 * s) >> 5) + 1; jmax = jmax > 8 ? 8 : jmax;
#define IDX_LOADB(BX, j_) do { const int jj_ = (j_) < 7 ? (j_) : 7; _Pragma("unroll") for (int ks = 0; ks < 4; ++ks) BX[ks] = *(const ALAS bf16x8*)(kb + (32 * jj_ + c) * 128 + ((ks * 32 + hi * 16) ^ ((c & 7) << 4))); } while (0)
#define IDX_MMA(ACC, MT, BX) do { ACC = f32x16{}; _Pragma("unroll") for (int ks = 0; ks < 4; ++ks) ACC = __builtin_amdgcn_mfma_f32_32x32x16_bf16(A[MT][ks], BX[ks], ACC, 0, 0, 0); } while (0)
#define IDX_STEP(ACCN, MTN, BX, ACC, MT, key0_) do { const int key = (key0_) + c; const unsigned kinv = (unsigned)(8191 - key); \
            float sA = 0.f, sB = 0.f; \
            _Pragma("unroll") for (int ks = 0; ks < 4; ++ks) { SBAR(); \
                if (ks == 0) ACCN = __builtin_amdgcn_mfma_f32_32x32x16_bf16(A[MTN][0], BX[0], f32x16{}, 0, 0, 0); else ACCN = __builtin_amdgcn_mfma_f32_32x32x16_bf16(A[MTN][ks], BX[ks], ACCN, 0, 0, 0); \
                SBAR(); \
                _Pragma("unroll") for (int r = 2 * ks; r < 2 * ks + 2; ++r) { sA = fmaf(wv[MT][r], relu_raw(ACC[r]), sA); sB = fmaf(wv[MT][8 + r], relu_raw(ACC[8 + r]), sB); } } \
            SBAR(); \
            auto rr = __builtin_amdgcn_permlane32_swap(__float_as_uint(sA), __float_as_uint(sB), false, false); \
            const float score = __uint_as_float(rr[0]) + __uint_as_float(rr[1]);       \
            const int tq = t0 + qw + 2 * MT + hi; \
            unsigned u = __float_as_uint(score); u ^= (unsigned)((int)u >> 31) | 0x80000000u; \
            const unsigned pk = (u & 0xFFFFE000u) | kinv; \
            unsigned long long mk;                                                           \
            asm volatile("v_cmp_le_i32_e64 %0, %1, %2\n\tv_cmp_gt_u32_e64 vcc, %3, %4\n\ts_and_b64 %0, %0, vcc" : "=&s"(mk) : "v"(key), "v"(tq), "v"(pk), "v"(thv[MT]) : "vcc"); \
            const unsigned mlo = (unsigned)mk, mhi = (unsigned)(mk >> 32); \
            const int nlo = __builtin_popcount(mlo), nhi = __builtin_popcount(mhi); \
            const int below = (int)__builtin_amdgcn_mbcnt_hi(mhi, __builtin_amdgcn_mbcnt_lo(mlo, 0u));       \
            const int sdiff_ = cnt[2 * MT + 1] - nlo - cnt[2 * MT];                            \
            const int pos = (int)(him & (unsigned)sdiff_) + cnt[2 * MT] + below; \
            {   const int slot_ = cbase[MT] + 4 * pos; unsigned long long sv_;                   \
                asm volatile("s_and_saveexec_b64 %0, %1\n\tds_write_b32 %2, %3\n\ts_mov_b64 exec, %0" : "=&s"(sv_) : "s"(mk), "v"(slot_), "v"(pk) : "memory"); } \
            cnt[2 * MT] += nlo; cnt[2 * MT + 1] += nhi; } while (0)
#define IDX_PRUNE() do { if ((cnt[0] | cnt[1] | cnt[2] | cnt[3]) > 255) {             \
            _Pragma("unroll") for (int q = 0; q < 4; ++q) if (cnt[q] > PRUNE_AT) topk_prune<false>(candw + q * 512, cnt[q], thr[q], lane); \
            thv[0] = hi ? thr[1] : thr[0]; thv[1] = hi ? thr[3] : thr[2]; } } while (0)
        if (jmax > 0) {
            bf16x8 B0[4], B1[4]; f32x16 acc0, acc1;
            IDX_LOADB(B0, 0);
            IDX_MMA(acc0, 0, B0);
            for (int j = 0; j < jmax; j += 2) {
                IDX_PRUNE();
                IDX_LOADB(B1, j + 1);
                IDX_STEP(acc1, 1, B0, acc0, 0, 256 * s + 32 * j);
                IDX_STEP(acc0, 0, B1, acc1, 1, 256 * s + 32 * j);
                if (j + 1 >= jmax) break;
                IDX_PRUNE();
                IDX_LOADB(B0, j + 2);
                IDX_STEP(acc1, 1, B1, acc0, 0, 256 * s + 32 * (j + 1));
                IDX_STEP(acc0, 0, B0, acc1, 1, 256 * s + 32 * (j + 1));
            }
        }
#undef IDX_LOADB
#undef IDX_MMA
#undef IDX_STEP
#undef IDX_PRUNE
        if (s + 1 < nst) IK_WRITE(buf ^ 1);
        __syncthreads();
    }
    }
#undef IK_LOAD
#undef IK_WRITE
#pragma unroll
    for (int q = 0; q < 4; ++q) {
        if (cnt[q] > 256) topk_prune<true>(candw + q * 512, cnt[q], thr[q], lane);
        ALAS unsigned* cq = candw + q * 512; ALAS unsigned* mq = cq + 256;
        unsigned kk[4];
#pragma unroll
        for (int j = 0; j < 4; ++j) { const int idx = lane + 64 * j; kk[j] = idx < cnt[q] ? cq[idx] : 0xFFFFFFFFu; }
#pragma unroll
        for (int j = 0; j < 4; ++j) mq[lane + 64 * j] = 0u;
#pragma unroll
        for (int j = 0; j < 4; ++j) if (kk[j] != 0xFFFFFFFFu) { const unsigned key = 8191u - (kk[j] & 8191u); __hip_atomic_fetch_or(mq + (key >> 5), 1u << (key & 31u), __ATOMIC_RELAXED, __HIP_MEMORY_SCOPE_WORKGROUP); }
        asm volatile("s_waitcnt lgkmcnt(0)" ::: "memory");
#if !DSA_UNION || DSA_CHECK
#pragma unroll
        for (int j = 0; j < 4; ++j) dmask[(qw + q) * 256 + lane + 64 * j] = mq[lane + 64 * j];
#endif
    }
    asm volatile("s_waitcnt vmcnt(0) lgkmcnt(0)" ::: "memory");
    __syncthreads();
#if !DSA_UNION
    { bf16_t* odense = odsa;
    {
        const int g = wid >> 2, wq = wid & 3, qrow = wq * 8 + (c >> 2), head = g * 4 + (c & 3);
        float za_ = fmaxf(fabsf(gq[lane]), fabsf(gq[lane + 64])), zb_ = fmaxf(fabsf(gk[lane]), fabsf(gk[lane + 64]));
#pragma unroll
        for (int o_ = 32; o_ >= 1; o_ >>= 1) { za_ = fmaxf(za_, __shfl_xor(za_, o_)); zb_ = fmaxf(zb_, __shfl_xor(zb_, o_)); }
        const float nshift = -fminf(11.3138f * za_ * zb_ * L2E, 50.f);
        bf16x8 qr[8];
#pragma unroll
        for (int d0 = 0; d0 < 8; ++d0) qr[d0] = *(const bf16x8*)(dsaq + (tok0 + qrow) * 1024 + head * 128 + d0 * 16 + hi * 8);
        q_row_norm<true>(qr, gq, tab + (size_t)(t0 + qrow) * 64, tab + (size_t)S * 64 + (size_t)(t0 + qrow) * 64, hi);
        const unsigned long long* mrow = (const unsigned long long*)(dmask + qrow * 256);
        lchar* st0 = lds;
        const int sr = tid >> 4, sc = (tid & 15) * 8, vst0 = v_st(sr, sc), vst1 = v_st(32 + sr, sc), kws = KSWZ(sr, sc * 2);
        const int vb0 = (int)(unsigned)(size_t)(st0 + 32768 + g * 16384) + v_rd_base(lane);
        ALAS float* wsf = (ALAS float*)(lds + D_OFF_WS) + wid * 128;
        bf16x8 sg2[8];
#define KV_LOAD(t_) do { const bf16_t* src_ = dsakv + ((size_t)b * S + (size_t)(t_) * 64 + sr) * 512 + sc; \
        _Pragma("unroll") for (int i_ = 0; i_ < 4; ++i_) { sg2[2 * i_] = *(const bf16x8*)(src_ + i_ * 128); sg2[2 * i_ + 1] = *(const bf16x8*)(src_ + i_ * 128 + (size_t)32 * 512); } } while (0)
#define KV_WRITE(bf_) do { lchar* st = st0 + (bf_) * 65536; *(ALAS bf16x8*)(st + kws) = sg2[0]; *(ALAS bf16x8*)(st + kws + 32 * 256) = sg2[1]; *(ALAS bf16x8*)(st + 16384 + kws) = sg2[2]; *(ALAS bf16x8*)(st + 16384 + kws + 32 * 256) = sg2[3]; \
        *(ALAS bf16x8*)(st + 32768 + vst0) = sg2[4]; *(ALAS bf16x8*)(st + 32768 + vst1) = sg2[5]; *(ALAS bf16x8*)(st + 49152 + vst0) = sg2[6]; *(ALAS bf16x8*)(st + 49152 + vst1) = sg2[7]; } while (0)
        const int nt = (t0 + 32 + 63) >> 6;
        KV_LOAD(0); KV_WRITE(0);
        unsigned long long mw = __hip_atomic_load(mrow, __ATOMIC_RELAXED, __HIP_MEMORY_SCOPE_AGENT);
        __syncthreads();
        float l_reg = 0.f; f32x16 o[4] = {};
        constexpr float C2 = SCALE * L2E;
        for (int t = 0; t < nt; ++t) {
            const int buf = t & 1;
            const unsigned w0 = (unsigned)mw >> (4 * hi), w1 = (unsigned)(mw >> 32) >> (4 * hi);
            if (t + 1 < nt) { KV_LOAD(t + 1); mw = __hip_atomic_load(mrow + t + 1, __ATOMIC_RELAXED, __HIP_MEMORY_SCOPE_AGENT); }
            if (__any((w0 | w1) != 0u)) {
                f32x16 p0, p1; bf16x8 pa0, pa1, pa2, pa3;
                qkt(p0, p1, st0 + buf * 65536 + g * 16384, c, hi, qr);
                float ps = 0.f;
#pragma unroll
                for (int r = 0; r < 16; ++r) { const int bp = (r & 3) + 8 * (r >> 2);
                    const unsigned m0 = (unsigned)__builtin_amdgcn_sbfe((int)w0, bp, 1), m1 = (unsigned)__builtin_amdgcn_sbfe((int)w1, bp, 1);
                    const float x0 = __uint_as_float((__float_as_uint(fmaf(p0[r], C2, nshift)) & m0) | (0xFF800000u & ~m0)), x1 = __uint_as_float((__float_as_uint(fmaf(p1[r], C2, nshift)) & m1) | (0xFF800000u & ~m1));
                    p0[r] = __builtin_amdgcn_exp2f(x0); p1[r] = __builtin_amdgcn_exp2f(x1); ps += p0[r] + p1[r]; }
                l_reg += pair_sum(ps);
                ATT_PK4(p0, 0, pa0); ATT_PK4(p0, 8, pa1); ATT_PK4(p1, 0, pa2); ATT_PK4(p1, 8, pa3);
                pv64(o, vb0 + buf * 65536, pa0, pa1, pa2, pa3);
            }
            if (t + 1 < nt) KV_WRITE(buf ^ 1);
            __syncthreads();
        }
#undef KV_LOAD
#undef KV_WRITE
        if (hi == 0) wsf[32 + c] = l_reg;
        asm volatile("s_waitcnt lgkmcnt(0)" ::: "memory");
#pragma unroll
        for (int r = 0; r < 16; ++r) { const int orow = crow(r, hi); const float rl = __builtin_amdgcn_rcpf(wsf[32 + orow]);
            bf16_t* op = odense + (tok0 + wq * 8 + (orow >> 2)) * 1024 + (g * 4 + (orow & 3)) * 128;
#pragma unroll
            for (int d0 = 0; d0 < 4; ++d0) { const float v = o[d0][r] * rl; const float vn = __shfl_xor(v, 1);
                if ((c & 1) == 0) *(unsigned*)(op + d0 * 32 + c) = cvtpk(v, vn); } }
    }
    }
#endif

#if DSA_UNION
    {
        const int g = wid >> 2, wq = wid & 3, qrow = wq * 8 + (c >> 2), head = g * 4 + (c & 3);
        unsigned short* ul = (unsigned short*)(dscr + wid * 2048);
        unsigned* cm = dscr + wid * 2048 + 1152;
        ALAS unsigned short* ull = (ALAS unsigned short*)(lds + D_OFF_IK) + wid * 2176;
        const ALAS unsigned* mb = (const ALAS unsigned*)(lds + D_OFF_CAND) + (wq * 8) * 512 + 256;
        int nch;
        {
            unsigned U[4];
#pragma unroll
            for (int i = 0; i < 4; ++i) { unsigned u = 0u;
#pragma unroll
                for (int qq = 0; qq < 8; ++qq) u |= mb[qq * 512 + 4 * lane + i];
                U[i] = u; }
            const int n = __builtin_popcount(U[0]) + __builtin_popcount(U[1]) + __builtin_popcount(U[2]) + __builtin_popcount(U[3]);
            int incl = n;
#pragma unroll
            for (int d = 1; d < 64; d <<= 1) { const int t = __shfl_up(incl, d); if (lane >= d) incl += t; }
            int pos = incl - n; const int nU = __builtin_amdgcn_readlane(incl, 63);
#pragma unroll
            for (int i = 0; i < 4; ++i) { unsigned u = U[i];
                while (u) { const int bp = __builtin_ctz(u); const unsigned short kv = (unsigned short)((4 * lane + i) * 32 + bp); ul[pos] = kv; ull[pos] = kv; ++pos; u &= u - 1u; } }
            nch = (nU + 31) >> 5;
            if (lane < 32 && nU + lane < nch * 32) ul[nU + lane] = 0;
            asm volatile("s_waitcnt lgkmcnt(0)" ::: "memory");
            for (int c0 = 0; c0 < nch; c0 += 2) {
                const int ch = c0 + hi, j = ch * 32 + c; const bool valid = ch < nch && j < nU;
                const unsigned k = valid ? (unsigned)ull[valid ? j : 0] : 0u;
                unsigned mine = 0u;
#pragma unroll
                for (int qq = 0; qq < 8; ++qq) { const bool bit = valid && ((mb[qq * 512 + (k >> 5)] >> (k & 31u)) & 1u);
                    const unsigned long long mk = __ballot(bit);
                    const unsigned mv = hi ? (unsigned)(mk >> 32) : (unsigned)mk;
                    mine = (c == qq) ? mv : mine; }
                if (c < 8) cm[(c0 + hi) * 8 + c] = mine;
            }
        }
        asm volatile("s_waitcnt vmcnt(0) lgkmcnt(0)" ::: "memory");
        __syncthreads();
#if DSA_CHECK
        { bf16_t* odense = ochk;
    {
        const int g = wid >> 2, wq = wid & 3, qrow = wq * 8 + (c >> 2), head = g * 4 + (c & 3);
        float za_ = fmaxf(fabsf(gq[lane]), fabsf(gq[lane + 64])), zb_ = fmaxf(fabsf(gk[lane]), fabsf(gk[lane + 64]));
#pragma unroll
        for (int o_ = 32; o_ >= 1; o_ >>= 1) { za_ = fmaxf(za_, __shfl_xor(za_, o_)); zb_ = fmaxf(zb_, __shfl_xor(zb_, o_)); }
        const float nshift = -fminf(11.3138f * za_ * zb_ * L2E, 50.f);
        bf16x8 qr[8];
#pragma unroll
        for (int d0 = 0; d0 < 8; ++d0) qr[d0] = *(const bf16x8*)(dsaq + (tok0 + qrow) * 1024 + head * 128 + d0 * 16 + hi * 8);
        q_row_norm<true>(qr, gq, tab + (size_t)(t0 + qrow) * 64, tab + (size_t)S * 64 + (size_t)(t0 + qrow) * 64, hi);
        const unsigned long long* mrow = (const unsigned long long*)(dmask + qrow * 256);
        lchar* st0 = lds;
        const int sr = tid >> 4, sc = (tid & 15) * 8, vst0 = v_st(sr, sc), vst1 = v_st(32 + sr, sc), kws = KSWZ(sr, sc * 2);
        const int vb0 = (int)(unsigned)(size_t)(st0 + 32768 + g * 16384) + v_rd_base(lane);
        ALAS float* wsf = (ALAS float*)(lds + D_OFF_WS) + wid * 128;
        bf16x8 sg2[8];
#define KV_LOAD(t_) do { const bf16_t* src_ = dsakv + ((size_t)b * S + (size_t)(t_) * 64 + sr) * 512 + sc; \
        _Pragma("unroll") for (int i_ = 0; i_ < 4; ++i_) { sg2[2 * i_] = *(const bf16x8*)(src_ + i_ * 128); sg2[2 * i_ + 1] = *(const bf16x8*)(src_ + i_ * 128 + (size_t)32 * 512); } } while (0)
#define KV_WRITE(bf_) do { lchar* st = st0 + (bf_) * 65536; *(ALAS bf16x8*)(st + kws) = sg2[0]; *(ALAS bf16x8*)(st + kws + 32 * 256) = sg2[1]; *(ALAS bf16x8*)(st + 16384 + kws) = sg2[2]; *(ALAS bf16x8*)(st + 16384 + kws + 32 * 256) = sg2[3]; \
        *(ALAS bf16x8*)(st + 32768 + vst0) = sg2[4]; *(ALAS bf16x8*)(st + 32768 + vst1) = sg2[5]; *(ALAS bf16x8*)(st + 49152 + vst0) = sg2[6]; *(ALAS bf16x8*)(st + 49152 + vst1) = sg2[7]; } while (0)
        const int nt = (t0 + 32 + 63) >> 6;
        KV_LOAD(0); KV_WRITE(0);
        unsigned long long mw = __hip_atomic_load(mrow, __ATOMIC_RELAXED, __HIP_MEMORY_SCOPE_AGENT);
        __syncthreads();
        float l_reg = 0.f; f32x16 o[4] = {};
        constexpr float C2 = SCALE * L2E;
        for (int t = 0; t < nt; ++t) {
            const int buf = t & 1;
            const unsigned w0 = (unsigned)mw >> (4 * hi), w1 = (unsigned)(mw >> 32) >> (4 * hi);
            if (t + 1 < nt) { KV_LOAD(t + 1); mw = __hip_atomic_load(mrow + t + 1, __ATOMIC_RELAXED, __HIP_MEMORY_SCOPE_AGENT); }
            if (__any((w0 | w1) != 0u)) {
                f32x16 p0, p1; bf16x8 pa0, pa1, pa2, pa3;
                qkt(p0, p1, st0 + buf * 65536 + g * 16384, c, hi, qr);
                float ps = 0.f;
#pragma unroll
                for (int r = 0; r < 16; ++r) { const int bp = (r & 3) + 8 * (r >> 2);
                    const unsigned m0 = (unsigned)__builtin_amdgcn_sbfe((int)w0, bp, 1), m1 = (unsigned)__builtin_amdgcn_sbfe((int)w1, bp, 1);
                    const float x0 = __uint_as_float((__float_as_uint(fmaf(p0[r], C2, nshift)) & m0) | (0xFF800000u & ~m0)), x1 = __uint_as_float((__float_as_uint(fmaf(p1[r], C2, nshift)) & m1) | (0xFF800000u & ~m1));
                    p0[r] = __builtin_amdgcn_exp2f(x0); p1[r] = __builtin_amdgcn_exp2f(x1); ps += p0[r] + p1[r]; }
                l_reg += pair_sum(ps);
                ATT_PK4(p0, 0, pa0); ATT_PK4(p0, 8, pa1); ATT_PK4(p1, 0, pa2); ATT_PK4(p1, 8, pa3);
                pv64(o, vb0 + buf * 65536, pa0, pa1, pa2, pa3);
            }
            if (t + 1 < nt) KV_WRITE(buf ^ 1);
            __syncthreads();
        }
#undef KV_LOAD
#undef KV_WRITE
        if (hi == 0) wsf[32 + c] = l_reg;
        asm volatile("s_waitcnt lgkmcnt(0)" ::: "memory");
#pragma unroll
        for (int r = 0; r < 16; ++r) { const int orow = crow(r, hi); const float rl = __builtin_amdgcn_rcpf(wsf[32 + orow]);
            bf16_t* op = odense + (tok0 + wq * 8 + (orow >> 2)) * 1024 + (g * 4 + (orow & 3)) * 128;
#pragma unroll
            for (int d0 = 0; d0 < 4; ++d0) { const float v = o[d0][r] * rl; const float vn = __shfl_xor(v, 1);
                if ((c & 1) == 0) *(unsigned*)(op + d0 * 32 + c) = cvtpk(v, vn); } }
    }
        }
        __syncthreads();
#endif
#ifdef DUPU
#define UN_KMASK(x_) ((x_) & kmask_)
#pragma unroll 1
        for (int rep_ = 0; rep_ < 2; ++rep_) {
        const int kmask_ = rep_ == 0 ? (DUPU) : 0xFFFF; bf16_t* const oout_ = rep_ == 0 ? ochk : odsa;
#else
#define UN_KMASK(x_) (x_)
        { bf16_t* const oout_ = odsa;
#endif
        float za_ = fmaxf(fabsf(gq[lane]), fabsf(gq[lane + 64])), zb_ = fmaxf(fabsf(gk[lane]), fabsf(gk[lane + 64]));
#pragma unroll
        for (int o_ = 32; o_ >= 1; o_ >>= 1) { za_ = fmaxf(za_, __shfl_xor(za_, o_)); zb_ = fmaxf(zb_, __shfl_xor(zb_, o_)); }
        const float nshift = -fminf(11.3138f * za_ * zb_ * L2E, 50.f);
        bf16x8 qr[8];
#pragma unroll
        for (int d0 = 0; d0 < 8; ++d0) qr[d0] = *(const bf16x8*)(dsaq + (tok0 + qrow) * 1024 + head * 128 + d0 * 16 + hi * 8);
        q_row_norm<true>(qr, gq, tab + (size_t)(t0 + qrow) * 64, tab + (size_t)S * 64 + (size_t)(t0 + qrow) * 64, hi);
        lchar* kt = lds + wid * 16384; lchar* vt = kt + 8192;
        const int vb = (int)(unsigned)(size_t)vt + v_rd_base(lane);
        ALAS float* wsf = (ALAS float*)(lds + D_OFF_WS) + wid * 128;
        const int grow = lane >> 4, gpc = lane & 15;
        const bf16_t* kvb = dsakv + (size_t)b * S * 512 + g * 128 + gpc * 8;
        bf16x8 kx[8], vx[8];
        int idxv = __hip_atomic_load(ul + c, __ATOMIC_RELAXED, __HIP_MEMORY_SCOPE_AGENT);
#define UN_GATHER() do { _Pragma("unroll") for (int i_ = 0; i_ < 8; ++i_) { const int kr_ = UN_KMASK(__shfl(idxv, grow + 4 * i_)); const bf16_t* rp_ = kvb + (size_t)kr_ * 512; kx[i_] = *(const bf16x8*)rp_; vx[i_] = *(const bf16x8*)(rp_ + 256); } } while (0)
        UN_GATHER();
        if (nch > 1) idxv = __hip_atomic_load(ul + 32 + c, __ATOMIC_RELAXED, __HIP_MEMORY_SCOPE_AGENT);
        unsigned cw = __hip_atomic_load(cm + (c >> 2), __ATOMIC_RELAXED, __HIP_MEMORY_SCOPE_AGENT);
        float l_reg = 0.f; f32x16 o[4] = {};
        constexpr float C2 = SCALE * L2E;
#ifdef DSA_BREAK
        if (nch > 3) nch -= 1;
#endif
        for (int ch = 0; ch < nch; ++ch) {
#pragma unroll
            for (int i = 0; i < 8; ++i) { const int r = grow + 4 * i; *(ALAS bf16x8*)(kt + KSWZ(r, gpc * 16)) = kx[i]; *(ALAS bf16x8*)(vt + v_st(r, gpc * 8)) = vx[i]; }
            const unsigned w0 = cw >> (4 * hi);
            if (ch + 1 < nch) { UN_GATHER(); cw = __hip_atomic_load(cm + (ch + 1) * 8 + (c >> 2), __ATOMIC_RELAXED, __HIP_MEMORY_SCOPE_AGENT); if (ch + 2 < nch) idxv = __hip_atomic_load(ul + (ch + 2) * 32 + c, __ATOMIC_RELAXED, __HIP_MEMORY_SCOPE_AGENT); }
            asm volatile("s_waitcnt lgkmcnt(0)" ::: "memory");
            f32x16 p = {};
            {   const lchar* kb4[4];
#pragma unroll
                for (int dd = 0; dd < 4; ++dd) kb4[dd] = kt + KSWZ(c, (dd * 16 + hi * 8) * 2);
                bf16x8 ka = *reinterpret_cast<const ALAS bf16x8*>(kb4[0]), kc;
#pragma unroll
                for (int d0 = 0; d0 < 8; ++d0) {
                    if (d0 < 7) kc = *reinterpret_cast<const ALAS bf16x8*>(kb4[(d0 + 1) & 3] + ((d0 + 1) >> 2) * 128);
                    SBAR(); p = __builtin_amdgcn_mfma_f32_32x32x16_bf16(ka, qr[d0], p, 0, 0, 0); SBAR(); ka = kc; } }
            float ps = 0.f;
#pragma unroll
            for (int r = 0; r < 16; ++r) { const unsigned m0 = (unsigned)__builtin_amdgcn_sbfe((int)w0, (r & 3) + 8 * (r >> 2), 1);
                const float x0 = __uint_as_float((__float_as_uint(fmaf(p[r], C2, nshift)) & m0) | (0xFF800000u & ~m0));
                p[r] = __builtin_amdgcn_exp2f(x0); ps += p[r]; }
            l_reg += pair_sum(ps);
            bf16x8 pa0, pa1; ATT_PK4(p, 0, pa0); ATT_PK4(p, 8, pa1);
            pv32(o, vb, pa0, pa1);
        }
#undef UN_GATHER
#undef UN_KMASK
        if (hi == 0) wsf[32 + c] = l_reg;
        asm volatile("s_waitcnt lgkmcnt(0)" ::: "memory");
#pragma unroll
        for (int r = 0; r < 16; ++r) { const int orow = crow(r, hi); const float rl = __builtin_amdgcn_rcpf(wsf[32 + orow]);
            bf16_t* op = oout_ + (tok0 + wq * 8 + (orow >> 2)) * 1024 + (g * 4 + (orow & 3)) * 128;
#pragma unroll
            for (int d0 = 0; d0 < 4; ++d0) { const float v = o[d0][r] * rl; const float vn = __shfl_xor(v, 1);
                if ((c & 1) == 0) *(unsigned*)(op + d0 * 32 + c) = cvtpk(v, vn); } }
        }
#if DSA_CHECK
        asm volatile("s_waitcnt vmcnt(0)" ::: "memory");
        {
            float worst = 0.f;
            for (int e = lane; e < 8 * 512; e += 64) { const size_t off = (tok0 + wq * 8 + (e >> 9)) * 1024 + g * 512 + (e & 511);
                const unsigned short ua = __hip_atomic_load((unsigned short*)odsa + off, __ATOMIC_RELAXED, __HIP_MEMORY_SCOPE_AGENT), ub = __hip_atomic_load((unsigned short*)ochk + off, __ATOMIC_RELAXED, __HIP_MEMORY_SCOPE_AGENT);
                const float fa = __uint_as_float((unsigned)ua << 16), fb = __uint_as_float((unsigned)ub << 16); worst = fmaxf(worst, fabsf(fa - fb) - 0.02f * fabsf(fb)); }
            if (worst > 0.004f || !(worst == worst)) __hip_atomic_fetch_or(chkflag, 1u, __ATOMIC_RELAXED, __HIP_MEMORY_SCOPE_AGENT);
        }
#endif
    }
#endif
    __syncthreads();
}
#undef ALAS
}
#ifndef F8DOWN_INNER
#define F8DOWN_INNER 0
#endif
#ifndef F8DOWN_LAST
#define F8DOWN_LAST 1
#endif
#define F8DOWN(l) (((l) + 1 < DEPTH) ? (F8DOWN_INNER != 0) : (F8DOWN_LAST != 0))
#ifndef I8FFN
#define I8FFN 1
#endif
#ifndef I8BR
#define I8BR 1
#endif
#ifndef I8GATE
#define I8GATE 1
#endif
constexpr int NWAVES = 8;
constexpr int BATCH = 4, SEQ = 8192, DM = 2048, DEPTH = 2, M = BATCH * SEQ, DFF = 5632, NIN = 8960  ;
constexpr float NORM_EPS = 1e-6f;
constexpr size_t MiB = 1u << 20;
constexpr size_t WS_CTL = 0, CTL_ZERO_BYTES = 2 * MiB;
constexpr int CW_BAR = 4096, CW_QUEUE = 8192;
constexpr size_t WS_SS = 128 * 1024;
constexpr size_t WS_CMAX = 1536 * 1024;
constexpr size_t WS_CS8 = 1664 * 1024, WS_RS8 = 1792 * 1024;
constexpr size_t WS_CMAXG = 1408 * 1024, WS_CSG = 1472 * 1024;
constexpr size_t WS_CMAXB = 1920 * 1024, WS_CSB = 1968 * 1024;
constexpr size_t WS_TAB = 2 * MiB;
constexpr size_t WS_CL = 8 * MiB, WS_CTOT = 9 * MiB, WS_IDXK = 10 * MiB, WS_IDXW = 14 * MiB;
constexpr size_t WS_WIN = 16 * MiB, WS_WG = 51 * MiB, WS_WB = 75 * MiB, WS_WO = 87 * MiB, WS_WGU = 95 * MiB, WS_WD = 139 * MiB;
constexpr size_t WS_XB = 161 * MiB;
constexpr size_t WS_PROJ = 289 * MiB, SEG_BYTES = 64 * MiB;
constexpr size_t WS_DSAKV = WS_PROJ + 8 * SEG_BYTES, WS_SMALL = WS_DSAKV + 32 * MiB, WS_END = WS_SMALL + 32 * MiB;
constexpr size_t WS_DMASK = WS_SMALL + 32 * MiB;
static_assert(WS_END == 865 * MiB && WS_DMASK == WS_END, "d_ws map");
constexpr size_t WS_DSCR = WS_DMASK + 8 * MiB;
constexpr size_t WS_H8 = WS_DSCR + 16 * MiB;
constexpr size_t WS_TOTAL = WS_H8 + 64 * MiB;
constexpr size_t WS_OB8 = WS_TOTAL, WS_OB8_2 = 95 * MiB, WS_RSB = 8 * MiB;
constexpr size_t WS_RSG = WS_TOTAL + 64 * MiB;
constexpr size_t WS_DUMMY = WS_TOTAL;
constexpr int LDS_BYTES = 147456, RING_BYTES = 131072, MISC_OFF = RING_BYTES + 320;

__device__ __forceinline__ float wave_sum(float v) {
#pragma unroll
    for (int o = 1; o < 64; o <<= 1) v += __shfl_xor(v, o);
    return v;
}
__device__ __forceinline__ void cvt_item(const float* W, int ldw, int srccol, const float* gain, bf16* dstrow0, int K, int k0, LAS float* scr, int lane, float emu8 = 0.f) {
    const float* wp = W + (size_t)(k0 + (lane >> 5)) * ldw + (srccol >= 0 ? srccol : 0);
#pragma unroll
    for (int h = 0; h < 2; ++h) { float v[16];
#pragma unroll
        for (int i = 0; i < 16; ++i) v[i] = wp[(size_t)(2 * (16 * h + i)) * ldw];
#pragma unroll
        for (int i = 0; i < 16; ++i) scr[(2 * (16 * h + i) + (lane >> 5)) * 33 + (lane & 31)] = (srccol >= 0) ? v[i] : 0.f; }
    LDS_WAIT(); asm volatile("" ::: "memory");
    const int c = lane & 7;
    f32x4 g0 = {1.f, 1.f, 1.f, 1.f}, g1 = g0;
    if (gain) { g0 = *(const GAS f32x4*)(gain + k0 + 8 * c); g1 = *(const GAS f32x4*)(gain + k0 + 8 * c + 4); }
#pragma unroll
    for (int j = 0; j < 4; ++j) { const int n = (lane >> 3) + 8 * j; const LAS float* s = scr + (8 * c) * 33 + n;
        float q_[8] = {s[0 * 33] * g0.x, s[1 * 33] * g0.y, s[2 * 33] * g0.z, s[3 * 33] * g0.w, s[4 * 33] * g1.x, s[5 * 33] * g1.y, s[6 * 33] * g1.z, s[7 * 33] * g1.w};
        if (emu8 != 0.f) {
#pragma unroll
            for (int i_ = 0; i_ < 8; ++i_) { const float v_ = fminf(fmaxf(q_[i_] * emu8, -448.f), 448.f); const int w_ = __builtin_amdgcn_cvt_pk_fp8_f32(v_, v_, 0, false); q_[i_] = __builtin_amdgcn_cvt_f32_fp8(w_, 0) / emu8; } }
        v4u o; o.x = pk2(q_[0], q_[1]); o.y = pk2(q_[2], q_[3]); o.z = pk2(q_[4], q_[5]); o.w = pk2(q_[6], q_[7]);
        *(GAS v4u*)(dstrow0 + (size_t)n * K + k0 + 8 * c) = o; }
    LDS_WAIT(); asm volatile("" ::: "memory");
}
__device__ __forceinline__ unsigned pk4_fp8(float a, float b, float c, float d) {
    a = fminf(fmaxf(a, -448.f), 448.f); b = fminf(fmaxf(b, -448.f), 448.f); c = fminf(fmaxf(c, -448.f), 448.f); d = fminf(fmaxf(d, -448.f), 448.f);
    int w = __builtin_amdgcn_cvt_pk_fp8_f32(a, b, 0, false); w = __builtin_amdgcn_cvt_pk_fp8_f32(c, d, w, true); return (unsigned)w;
}
__device__ __forceinline__ void cvt_item8(const float* W, int ldw, int srccol, const float* gain, unsigned char* dstrow0, int K, int k0, LAS float* scr, int lane) {
    const float* wp = W + (size_t)(k0 + (lane >> 5)) * ldw + srccol;
#pragma unroll
    for (int h = 0; h < 2; ++h) { float v[16];
#pragma unroll
        for (int i = 0; i < 16; ++i) v[i] = wp[(size_t)(2 * (16 * h + i)) * ldw];
#pragma unroll
        for (int i = 0; i < 16; ++i) scr[(2 * (16 * h + i) + (lane >> 5)) * 33 + (lane & 31)] = v[i]; }
    LDS_WAIT(); asm volatile("" ::: "memory");
    const int c = lane & 7;
    f32x4 g0 = {256.f, 256.f, 256.f, 256.f}, g1 = g0;
    if (gain) { g0 = *(const GAS f32x4*)(gain + k0 + 8 * c) * 256.f; g1 = *(const GAS f32x4*)(gain + k0 + 8 * c + 4) * 256.f; }
#pragma unroll
    for (int j = 0; j < 4; ++j) { const int n = (lane >> 3) + 8 * j; const LAS float* s = scr + (8 * c) * 33 + n;
        typedef unsigned v2u_ __attribute__((ext_vector_type(2)));
        const v2u_ o = {pk4_fp8(s[0 * 33] * g0.x, s[1 * 33] * g0.y, s[2 * 33] * g0.z, s[3 * 33] * g0.w), pk4_fp8(s[4 * 33] * g1.x, s[5 * 33] * g1.y, s[6 * 33] * g1.z, s[7 * 33] * g1.w)};
        *(GAS v2u_*)(dstrow0 + (size_t)n * K + k0 + 8 * c) = o; }
    LDS_WAIT(); asm volatile("" ::: "memory");
}
__device__ __forceinline__ void colmax_item(const float* W, int ldw, int srccol, const float* gain, unsigned* cmaxrow0, int k0, int lane) {
    const int hi = lane >> 5; const float* wp = W + (size_t)(k0 + hi) * ldw + srccol; float m = 0.f;
#pragma unroll
    for (int h = 0; h < 2; ++h) { float v[16], g[16];
#pragma unroll
        for (int i = 0; i < 16; ++i) { v[i] = wp[(size_t)(2 * (16 * h + i)) * ldw]; g[i] = gain ? gain[k0 + 2 * (16 * h + i) + hi] : 1.0f; }
#pragma unroll
        for (int i = 0; i < 16; ++i) m = fmaxf(m, fabsf(v[i] * g[i])); }
    { auto rr = __builtin_amdgcn_permlane32_swap(__float_as_uint(m), __float_as_uint(m), false, false); m = fmaxf(__uint_as_float(rr[0]), __uint_as_float(rr[1])); }
    if (hi == 0) atomicMax(cmaxrow0 + (lane & 31), __float_as_uint(m));
}
__device__ __forceinline__ unsigned q8byte(float x, float scale) { return __float_as_uint(fmaf(x, scale, 12582912.f)) & 255u; }
__device__ __forceinline__ unsigned pk4_i8(float a, float b, float c, float d, float s) { return q8byte(a, s) | (q8byte(b, s) << 8) | (q8byte(c, s) << 16) | (q8byte(d, s) << 24); }
__device__ __forceinline__ void cvt_item_i8(const float* W, int ldw, int srccol, const float* gain, const unsigned* cmaxrow0, float* cs8row0, unsigned char* dstrow0, int K, int k0, LAS float* scr, int lane) {
    const float* wp = W + (size_t)(k0 + (lane >> 5)) * ldw + srccol;
#pragma unroll
    for (int h = 0; h < 2; ++h) { float v[16];
#pragma unroll
        for (int i = 0; i < 16; ++i) v[i] = wp[(size_t)(2 * (16 * h + i)) * ldw];
#pragma unroll
        for (int i = 0; i < 16; ++i) scr[(2 * (16 * h + i) + (lane >> 5)) * 33 + (lane & 31)] = v[i]; }
    LDS_WAIT(); asm volatile("" ::: "memory");
    const int c = lane & 7;
    f32x4 g0 = {1.f, 1.f, 1.f, 1.f}, g1 = g0;
    if (gain) { g0 = *(const GAS f32x4*)(gain + k0 + 8 * c); g1 = *(const GAS f32x4*)(gain + k0 + 8 * c + 4); }
#pragma unroll
    for (int j = 0; j < 4; ++j) { const int n = (lane >> 3) + 8 * j; const LAS float* s = scr + (8 * c) * 33 + n;
        const float mx = __uint_as_float(cmaxrow0[n]), sc = mx > 0.f ? 127.f / mx : 0.f;
        if (k0 == 0 && c == 0) cs8row0[n] = mx * (1.0f / 127.f);
        typedef unsigned v2u_ __attribute__((ext_vector_type(2)));
        const v2u_ o = {pk4_i8(s[0 * 33] * g0.x, s[1 * 33] * g0.y, s[2 * 33] * g0.z, s[3 * 33] * g0.w, sc), pk4_i8(s[4 * 33] * g1.x, s[5 * 33] * g1.y, s[6 * 33] * g1.z, s[7 * 33] * g1.w, sc)};
        *(GAS v2u_*)(dstrow0 + (size_t)n * K + k0 + 8 * c) = o; }
    LDS_WAIT(); asm volatile("" ::: "memory");
}
__device__ __forceinline__ int win_srccol(int n) {
    if (n < 6144) return n;
    if (n < 7168) return 6152 + (n - 6144);
    if (n < 8192) return 7688 + (n - 7168);
    if (n < 8704) return 7176 + (n - 8192);
    if (n < 8768) return 8712 + (n - 8704);
    if (n < 8784) return 8776 + (n - 8768);
    if (n < 8792) return 6144 + (n - 8784);
    return -1;
}
struct Args { const float* in[15]; float* out; unsigned char* ws; };
typedef __attribute__((address_space(4))) const Args CArgs;

__device__ __forceinline__ void p0_prologue(CArgs& a, int l, LAS unsigned char* lds, int vcu, int NGW, int wave) {
    int lane = lane_id(); asm volatile("" : "+v"(lane)); const int gw = vcu * NWAVES + wave;
    unsigned char* ws = a.ws;
    LAS float* scr = (LAS float*)(lds + wave * 16384);
    const float* g_mix = a.in[1] + (size_t)l * DM; const float* g_ffn = a.in[11] + (size_t)l * DM;
    constexpr int I0 = (NIN / 32) * (DM / 64), I1 = (6144 / 32) * (DM / 64), I2 = (6144 / 32) * (1024 / 64), I3 = (DM / 32) * (DM / 64), I4 = (2 * DFF / 32) * (DM / 64), I5 = (DM / 32) * (DFF / 64);
    constexpr int NITEMS = I0 + I1 + I2 + I3 + I4 + I5;
    for (int it = gw; it < NITEMS; it += NGW) {
        int r = it;
        if (r < I0) { const int nblk = NIN / 32, kb = r / nblk, nb = r % nblk, n0 = nb * 32;
            cvt_item(a.in[2] + (size_t)l * DM * 8792, 8792, win_srccol(n0 + (lane & 31)), g_mix, (bf16*)(ws + WS_WIN) + (size_t)n0 * DM, DM, kb * 64, scr, lane); continue; } r -= I0;
        if (r < I1) { const int nblk = 6144 / 32, kb = r / nblk, nb = r % nblk, n0 = nb * 32, g = n0 >> 11;
            if (I8GATE) colmax_item(a.in[8] + (size_t)(l * 3 + g) * DM * DM, DM, (n0 & 2047) + (lane & 31), g_mix, (unsigned*)(ws + WS_CMAXG) + (size_t)l * 6144 + n0, kb * 64, lane);
            else cvt_item8(a.in[8] + (size_t)(l * 3 + g) * DM * DM, DM, (n0 & 2047) + (lane & 31), g_mix, ws + WS_WG + (size_t)n0 * DM, DM, kb * 64, scr, lane);
            continue; } r -= I1;
        if (r < I2) { const int nblk = 6144 / 32, kb = r / nblk, nb = r % nblk, n0 = nb * 32, g = n0 >> 11;
            if (I8BR) colmax_item(a.in[9] + (size_t)(l * 3 + g) * 1024 * DM, DM, (n0 & 2047) + (lane & 31), nullptr, (unsigned*)(ws + WS_CMAXB) + (size_t)l * 6144 + n0, kb * 64, lane);
            else cvt_item(a.in[9] + (size_t)(l * 3 + g) * 1024 * DM, DM, (n0 & 2047) + (lane & 31), nullptr, (bf16*)(ws + WS_WB) + (size_t)n0 * 1024, 1024, kb * 64, scr, lane);
            continue; } r -= I2;
        if (r < I3) { const int nblk = DM / 32, kb = r / nblk, nb = r % nblk, n0 = nb * 32;
            cvt_item(a.in[10] + (size_t)l * DM * DM, DM, n0 + (lane & 31), nullptr, (bf16*)(ws + WS_WO) + (size_t)n0 * DM, DM, kb * 64, scr, lane); continue; } r -= I3;
        if (r < I4) { const int nblk = 2 * DFF / 32, kb = r / nblk, nb = r % nblk, n0 = nb * 32, pn = n0 >> 8, w = n0 & 255;
            const float* src = (w < 128 ? a.in[12] : a.in[13]) + (size_t)l * DM * DFF;
            if (I8FFN) colmax_item(src, DFF, pn * 128 + (w & 127) + (lane & 31), g_ffn, (unsigned*)(ws + WS_CMAX) + (size_t)l * 2 * DFF + n0, kb * 64, lane);
            else cvt_item(src, DFF, pn * 128 + (w & 127) + (lane & 31), g_ffn, (bf16*)(ws + WS_WGU) + (size_t)n0 * DM, DM, kb * 64, scr, lane);
            continue; } r -= I4;
        { const int nblk = DM / 32, kb = r / nblk, nb = r % nblk, n0 = nb * 32;
            if (F8DOWN(l)) cvt_item8(a.in[14] + (size_t)l * DFF * DM, DM, n0 + (lane & 31), nullptr, ws + WS_WD + (size_t)n0 * DFF, DFF, kb * 64, scr, lane);
            else cvt_item(a.in[14] + (size_t)l * DFF * DM, DM, n0 + (lane & 31), nullptr, (bf16*)(ws + WS_WD) + (size_t)n0 * DFF, DFF, kb * 64, scr, lane); }
    }
    if (l == 0) {
        const float* x = a.in[0]; bf16* xb = (bf16*)(ws + WS_XB); pg8::ssq_t* ss0 = (pg8::ssq_t*)(ws + WS_SS);
        if (gw < M) {
            f32x4 v[8], w[8];
            { const GAS f32x4* xr = (const GAS f32x4*)(x + (size_t)gw * DM) + lane;
#pragma unroll
              for (int j = 0; j < 8; ++j) v[j] = xr[64 * j]; }
#pragma unroll 1
            for (int m = gw; m < M; m += NGW) {
                const bool more = m + NGW < M;
                if (more) { const GAS f32x4* xn = (const GAS f32x4*)(x + (size_t)(m + NGW) * DM) + lane;
#pragma unroll
                    for (int j = 0; j < 8; ++j) w[j] = xn[64 * j]; }
                GAS unsigned long long* o8 = (GAS unsigned long long*)(xb + (size_t)m * DM) + lane; float s = 0.f;
#pragma unroll
                for (int j = 0; j < 8; ++j) s += (v[j].x * v[j].x + v[j].y * v[j].y) + (v[j].z * v[j].z + v[j].w * v[j].w);
#pragma unroll
                for (int j = 0; j < 8; ++j) o8[64 * j] = (unsigned long long)pk2(v[j].x, v[j].y) | ((unsigned long long)pk2(v[j].z, v[j].w) << 32);
                s = wave_sum(s);
                if (lane == 0) ss0[m] = pg8::ssq_of(s);
#pragma unroll
                for (int j = 0; j < 8; ++j) v[j] = w[j];
            }
        }
        float* cos_h = (float*)(ws + WS_TAB); float* sin_h = cos_h + SEQ * 64; float* cos_i = sin_h + SEQ * 64; float* sin_i = cos_i + SEQ * 32;
        for (int idx = gw * 64 + lane; idx < SEQ * 96; idx += NGW * 64) {
            const int t = idx / 96, j = idx - t * 96;
            if (j < 64) { const float inv = 1.0f / powf(10000.0f, (float)(2 * j) / 128.0f), ang = (float)t * inv; cos_h[t * 64 + j] = cosf(ang); sin_h[t * 64 + j] = sinf(ang); }
            else { const int jj = j - 64; const float inv = 1.0f / powf(10000.0f, (float)(2 * jj) / 64.0f), ang = (float)t * inv; cos_i[t * 32 + jj] = cosf(ang); sin_i[t * 32 + jj] = sinf(ang); }
        }
    }
}

__device__ __forceinline__ void unpack8(v4u w, float* f) { f[0] = __uint_as_float(w.x << 16); f[1] = __uint_as_float(w.x & 0xffff0000u); f[2] = __uint_as_float(w.y << 16); f[3] = __uint_as_float(w.y & 0xffff0000u);
    f[4] = __uint_as_float(w.z << 16); f[5] = __uint_as_float(w.z & 0xffff0000u); f[6] = __uint_as_float(w.w << 16); f[7] = __uint_as_float(w.w & 0xffff0000u); }
__device__ __forceinline__ v4u pack8f(const float* f) { v4u o; o.x = pk2(f[0], f[1]); o.y = pk2(f[2], f[3]); o.z = pk2(f[4], f[5]); o.w = pk2(f[6], f[7]); return o; }
template <bool ROPE>
__device__ __forceinline__ void norm_row128(bf16* rowp, int nheads, const float* g, const float* cs, const float* sn, int lane) {
    const int head = lane >> 3, j = lane & 7, hh = head < nheads ? head : 0;
    bf16* p = rowp + hh * 128 + j * 8;
    float x1[8], x2[8]; unpack8(*(const GAS v4u*)p, x1); unpack8(*(const GAS v4u*)(p + 64), x2);
    float s = 0.f;
#pragma unroll
    for (int e = 0; e < 8; ++e) s += x1[e] * x1[e] + x2[e] * x2[e];
    s += __shfl_xor(s, 1); s += __shfl_xor(s, 2); s += __shfl_xor(s, 4);
    const float rs = 1.0f / sqrtf(s * (1.0f / 128.0f) + NORM_EPS);
#pragma unroll
    for (int e = 0; e < 8; ++e) { x1[e] = x1[e] * rs * g[e]; x2[e] = x2[e] * rs * g[8 + e]; }
    if (ROPE) {
        float c[8], sv[8]; *(f32x4*)c = *(const GAS f32x4*)(cs + j * 8); *(f32x4*)(c + 4) = *(const GAS f32x4*)(cs + j * 8 + 4); *(f32x4*)sv = *(const GAS f32x4*)(sn + j * 8); *(f32x4*)(sv + 4) = *(const GAS f32x4*)(sn + j * 8 + 4);
#pragma unroll
        for (int e = 0; e < 8; ++e) { const float a1 = x1[e] * c[e] - x2[e] * sv[e], a2 = x2[e] * c[e] + x1[e] * sv[e]; x1[e] = a1; x2[e] = a2; }
    }
    if (head < nheads) { *(GAS v4u*)p = pack8f(x1); *(GAS v4u*)(p + 64) = pack8f(x2); }
}
__device__ __forceinline__ void p3b_quant(CArgs& a, int l, LAS unsigned char* lds, int vcu, int NGW, int wave) {
    int lane = lane_id(); asm volatile("" : "+v"(lane)); const int gw = vcu * NWAVES + wave;
    unsigned char* ws = a.ws;
    {   float* rsb = (float*)(ws + WS_RSB);
        auto rowsrc = [&](int rr) { const int g = rr >> 15, m = rr & (M - 1); return (const bf16*)(ws + WS_PROJ) + (size_t)g * 3 * pg8::SEG_ELEMS + (size_t)m * 1024 + lane * 16; };
        auto rowdst = [&](int rr) { const int g = rr >> 15, m = rr & (M - 1); return ws + (g == 2 ? WS_OB8_2 : WS_OB8 + (size_t)g * 32 * MiB) + (size_t)m * 1024 + lane * 16; };
        const int r0 = gw * 48;
        v4u ra[4][2], rb[4][2];
#pragma unroll
        for (int j = 0; j < 4; ++j) { const bf16* p = rowsrc(r0 + j); ra[j][0] = *(const GAS v4u*)p; ra[j][1] = *(const GAS v4u*)(p + 8); }
        auto emit = [&](const v4u (&r)[4][2], int rr0) {
#pragma unroll
            for (int j = 0; j < 4; ++j) { float x[2][8]; unpack8(r[j][0], x[0]); unpack8(r[j][1], x[1]); float mx = 0.f;
#pragma unroll
                for (int e = 0; e < 8; ++e) mx = fmaxf(mx, fmaxf(fabsf(x[0][e]), fabsf(x[1][e])));
                {   unsigned um = __float_as_uint(mx);
#define FR_DPPMAX(ctrl, rmask) do { const unsigned t_ = (unsigned)__builtin_amdgcn_update_dpp((int)um, (int)um, ctrl, rmask, 0xF, false); um = t_ > um ? t_ : um; } while (0)
                    FR_DPPMAX(0x121, 0xF); FR_DPPMAX(0x122, 0xF); FR_DPPMAX(0x124, 0xF); FR_DPPMAX(0x128, 0xF); FR_DPPMAX(0x142, 0xA); FR_DPPMAX(0x143, 0xC);
#undef FR_DPPMAX
                    mx = __uint_as_float((unsigned)__builtin_amdgcn_readlane((int)um, 63)); }
                const float sc = mx > 0.f ? 127.f / mx : 0.f;
                if (lane == 0) rsb[rr0 + j] = mx * (1.0f / 127.f);
                v4u o; o.x = pk4_i8(x[0][0], x[0][1], x[0][2], x[0][3], sc); o.y = pk4_i8(x[0][4], x[0][5], x[0][6], x[0][7], sc); o.z = pk4_i8(x[1][0], x[1][1], x[1][2], x[1][3], sc); o.w = pk4_i8(x[1][4], x[1][5], x[1][6], x[1][7], sc);
                *(GAS v4u*)rowdst(rr0 + j) = o; } };
#pragma unroll 1
        for (int tt = 0; tt < 48; tt += 8) {
#pragma unroll
            for (int j = 0; j < 4; ++j) { const bf16* p = rowsrc(r0 + tt + 4 + j); rb[j][0] = *(const GAS v4u*)p; rb[j][1] = *(const GAS v4u*)(p + 8); }
            emit(ra, r0 + tt);
            if (tt + 8 < 48) {
#pragma unroll
                for (int j = 0; j < 4; ++j) { const bf16* p = rowsrc(r0 + tt + 8 + j); ra[j][0] = *(const GAS v4u*)p; ra[j][1] = *(const GAS v4u*)(p + 8); } }
            emit(rb, r0 + tt + 4); } }
    {   LAS float* scr = (LAS float*)(lds + wave * 16384);
        constexpr int I2 = (6144 / 32) * (1024 / 64);
        for (int r = gw; r < I2; r += NGW) { const int nblk = 6144 / 32, kb = r / nblk, nb = r % nblk, n0 = nb * 32, g = n0 >> 11;
            cvt_item_i8(a.in[9] + (size_t)(l * 3 + g) * 1024 * DM, DM, (n0 & 2047) + (lane & 31), nullptr, (const unsigned*)(ws + WS_CMAXB) + (size_t)l * 6144 + n0, (float*)(ws + WS_CSB) + n0, ws + WS_WB + (size_t)n0 * 1024, 1024, kb * 64, scr, lane); }
        if (I8GATE) { constexpr int I1 = (6144 / 32) * (DM / 64); const float* g_mix = a.in[1] + (size_t)l * DM;
            for (int r = gw; r < I1; r += NGW) { const int nblk = 6144 / 32, kb = r / nblk, nb = r % nblk, n0 = nb * 32, g = n0 >> 11;
                cvt_item_i8(a.in[8] + (size_t)(l * 3 + g) * DM * DM, DM, (n0 & 2047) + (lane & 31), g_mix, (const unsigned*)(ws + WS_CMAXG) + (size_t)l * 6144 + n0, (float*)(ws + WS_CSG) + n0, ws + WS_WG + (size_t)n0 * DM, DM, kb * 64, scr, lane); } } }
}
__device__ __forceinline__ void p5b_quant(CArgs& a, int l, LAS unsigned char* lds, int vcu, int NGW, int wave) {
    int lane = lane_id(); asm volatile("" : "+v"(lane)); const int gw = vcu * NWAVES + wave;
    unsigned char* ws = a.ws;
    {   const bf16* xbp = (const bf16*)(ws + WS_XB); unsigned char* x8 = ws + WS_H8; float* rs8 = (float*)(ws + WS_RS8);
        const size_t m0 = (size_t)gw * 16;
        v4u ra[4], rb[4];
#pragma unroll
        for (int i = 0; i < 4; ++i) ra[i] = *(const GAS v4u*)(xbp + m0 * DM + i * 512 + lane * 8);
        auto emit = [&](const v4u (&r)[4], size_t m) {
            float x[4][8]; float mx = 0.f;
#pragma unroll
            for (int i = 0; i < 4; ++i) { unpack8(r[i], x[i]);
#pragma unroll
                for (int e = 0; e < 8; ++e) mx = fmaxf(mx, fabsf(x[i][e])); }
            {   unsigned um = __float_as_uint(mx);
#define FR_DPPMAX(ctrl, rmask) do { const unsigned t_ = (unsigned)__builtin_amdgcn_update_dpp((int)um, (int)um, ctrl, rmask, 0xF, false); um = t_ > um ? t_ : um; } while (0)
                FR_DPPMAX(0x121, 0xF); FR_DPPMAX(0x122, 0xF); FR_DPPMAX(0x124, 0xF); FR_DPPMAX(0x128, 0xF); FR_DPPMAX(0x142, 0xA); FR_DPPMAX(0x143, 0xC);
#undef FR_DPPMAX
                mx = __uint_as_float((unsigned)__builtin_amdgcn_readlane((int)um, 63)); }
            const float sc = mx > 0.f ? 127.f / mx : 0.f;
            if (lane == 0) rs8[m] = mx * (1.0f / 127.f);
#pragma unroll
            for (int i = 0; i < 4; ++i) { typedef unsigned v2u_ __attribute__((ext_vector_type(2)));
                const v2u_ o = {pk4_i8(x[i][0], x[i][1], x[i][2], x[i][3], sc), pk4_i8(x[i][4], x[i][5], x[i][6], x[i][7], sc)};
                *(GAS v2u_*)(x8 + m * DM + i * 512 + lane * 8) = o; } };
#pragma unroll 1
        for (int tt = 0; tt < 16; tt += 2) {
#pragma unroll
            for (int i = 0; i < 4; ++i) rb[i] = *(const GAS v4u*)(xbp + (m0 + tt + 1) * DM + i * 512 + lane * 8);
            emit(ra, m0 + tt);
            if (tt + 2 < 16) {
#pragma unroll
                for (int i = 0; i < 4; ++i) ra[i] = *(const GAS v4u*)(xbp + (m0 + tt + 2) * DM + i * 512 + lane * 8); }
            emit(rb, m0 + tt + 1); } }
    {   LAS float* scr = (LAS float*)(lds + wave * 16384); const float* g_ffn = a.in[11] + (size_t)l * DM;
        constexpr int I4 = (2 * DFF / 32) * (DM / 64);
        for (int r = gw; r < I4; r += NGW) { const int nblk = 2 * DFF / 32, kb = r / nblk, nb = r % nblk, n0 = nb * 32, pn = n0 >> 8, w = n0 & 255;
            const float* src = (w < 128 ? a.in[12] : a.in[13]) + (size_t)l * DM * DFF;
            cvt_item_i8(src, DFF, pn * 128 + (w & 127) + (lane & 31), g_ffn, (const unsigned*)(ws + WS_CMAX) + (size_t)l * 2 * DFF + n0, (float*)(ws + WS_CS8) + n0, ws + WS_WGU + (size_t)n0 * DM, DM, kb * 64, scr, lane); } }
}
__device__ __forceinline__ void p2_post(CArgs& a, int l, LAS unsigned char* lds, int wave) {
    int lane = lane_id(); asm volatile("" : "+v"(lane));
    unsigned char* ws = a.ws;
    const int chunk = blockIdx.x;
    bf16* proj = (bf16*)(ws + WS_PROJ); bf16* dsakv = (bf16*)(ws + WS_DSAKV); const float* small = (const float*)(ws + WS_SMALL);
    bf16* idxk = (bf16*)(ws + WS_IDXK); float* idxw = (float*)(ws + WS_IDXW);
    const float* cos_h = (const float*)(ws + WS_TAB); const float* sin_h = cos_h + SEQ * 64; const float* cos_i = sin_h + SEQ * 64; const float* sin_i = cos_i + SEQ * 32;
    LAS float* lf = (LAS float*)lds;
    const int j = lane & 7;
    float gfk[16], gdk[16];
#pragma unroll
    for (int e = 0; e < 8; ++e) { gfk[e] = a.in[5][l * 128 + j * 8 + e]; gfk[8 + e] = a.in[5][l * 128 + 64 + j * 8 + e]; gdk[e] = a.in[7][l * 128 + j * 8 + e]; gdk[8 + e] = a.in[7][l * 128 + 64 + j * 8 + e]; }
    const float fbias = a.in[3][l * 8 + (lane & 7)];
    struct P2Tok { v4u fk1, fk2, dk1, dk2; f32x4 dc0, dc1, ds0, ds1, ik1, ik2, ic, is; float w, g; };
    const int head = lane >> 3;
    auto tok_load = [&](P2Tok& T, int tt) {
        const size_t m = (size_t)chunk * 128 + wave * 16 + tt; const int t = (int)(m & (SEQ - 1));
        const bf16* pf = proj + 4 * SEG_BYTES / 2 + m * 1024 + head * 128 + j * 8; T.fk1 = *(const GAS v4u*)pf; T.fk2 = *(const GAS v4u*)(pf + 64);
        const bf16* pd = dsakv + m * 512 + (head < 2 ? head : 0) * 128 + j * 8; T.dk1 = *(const GAS v4u*)pd; T.dk2 = *(const GAS v4u*)(pd + 64);
        const float* cs = cos_h + t * 64 + j * 8; const float* sn = sin_h + t * 64 + j * 8; T.dc0 = *(const GAS f32x4*)cs; T.dc1 = *(const GAS f32x4*)(cs + 4); T.ds0 = *(const GAS f32x4*)sn; T.ds1 = *(const GAS f32x4*)(sn + 4);
        if (lane < 8) { const float* sp = small + m * 256 + j * 4; T.ik1 = *(const GAS f32x4*)sp; T.ik2 = *(const GAS f32x4*)(sp + 32); T.ic = *(const GAS f32x4*)(cos_i + t * 32 + j * 4); T.is = *(const GAS f32x4*)(sin_i + t * 32 + j * 4); }
        if (lane < 16) T.w = small[m * 256 + 64 + lane];
        if (lane < 8) T.g = small[m * 256 + 80 + lane];
    };
    auto row_norm = [&](v4u a1, v4u a2, const float* g, float* x1, float* x2) {
        unpack8(a1, x1); unpack8(a2, x2); float s = 0.f;
#pragma unroll
        for (int e = 0; e < 8; ++e) s += x1[e] * x1[e] + x2[e] * x2[e];
        s += __shfl_xor(s, 1); s += __shfl_xor(s, 2); s += __shfl_xor(s, 4);
        const float rs = 1.0f / sqrtf(s * (1.0f / 128.0f) + NORM_EPS);
#pragma unroll
        for (int e = 0; e < 8; ++e) { x1[e] = x1[e] * rs * g[e]; x2[e] = x2[e] * rs * g[8 + e]; }
    };
    auto tok_finish = [&](const P2Tok& T, int tt) {
        const int tokl = wave * 16 + tt; const size_t m = (size_t)chunk * 128 + tokl;
        {   float x1[8], x2[8]; row_norm(T.fk1, T.fk2, gfk, x1, x2);
            bf16* pf = proj + 4 * SEG_BYTES / 2 + m * 1024 + head * 128 + j * 8; *(GAS v4u*)pf = pack8f(x1); *(GAS v4u*)(pf + 64) = pack8f(x2); }
        {   float x1[8], x2[8], c[8], sv[8]; row_norm(T.dk1, T.dk2, gdk, x1, x2);
            *(f32x4*)c = T.dc0; *(f32x4*)(c + 4) = T.dc1; *(f32x4*)sv = T.ds0; *(f32x4*)(sv + 4) = T.ds1;
#pragma unroll
            for (int e = 0; e < 8; ++e) { const float a1 = x1[e] * c[e] - x2[e] * sv[e], a2 = x2[e] * c[e] + x1[e] * sv[e]; x1[e] = a1; x2[e] = a2; }
            if (head < 2) { bf16* pd = dsakv + m * 512 + head * 128 + j * 8; *(GAS v4u*)pd = pack8f(x1); *(GAS v4u*)(pd + 64) = pack8f(x2); } }
        if (lane < 8) {
            float a1[4], a2[4];
#pragma unroll
            for (int e = 0; e < 4; ++e) { a1[e] = T.ik1[e] * T.ic[e] - T.ik2[e] * T.is[e]; a2[e] = T.ik2[e] * T.ic[e] + T.ik1[e] * T.is[e]; }
            typedef unsigned v2u_ __attribute__((ext_vector_type(2)));
            const v2u_ o1 = {pk2(a1[0], a1[1]), pk2(a1[2], a1[3])}, o2 = {pk2(a2[0], a2[1]), pk2(a2[2], a2[3])};
            *(GAS v2u_*)(idxk + m * 64 + j * 4) = o1; *(GAS v2u_*)(idxk + m * 64 + 32 + j * 4) = o2;
        }
        if (lane < 16) idxw[m * 16 + lane] = T.w * 0.03125f;
        if (lane < 8) { const float v = T.g + fbias; lf[tokl * 8 + lane] = fminf(v, 0.f) - log1pf(expf(-fabsf(v))); }
    };
    {   P2Tok Ta, Tb; tok_load(Ta, 0);
#pragma unroll 1
        for (int tt = 0; tt < 16; tt += 2) { tok_load(Tb, tt + 1); tok_finish(Ta, tt); if (tt + 2 < 16) tok_load(Ta, tt + 2); tok_finish(Tb, tt + 1); } }
    {
        const bf16* xbp = (const bf16*)(ws + WS_XB); unsigned char* h8 = ws + WS_H8; const pg8::ssq_t* ssm = (const pg8::ssq_t*)(ws + WS_SS) + (size_t)(2 * l) * M;
        const size_t m0 = (size_t)chunk * 128 + wave * 16;
        v4u ra[4], rb[4]; float sa = (float)ssm[m0] * pg8::SSQI, sb = 0.f;
#pragma unroll
        for (int i = 0; i < 4; ++i) ra[i] = *(const GAS v4u*)(xbp + m0 * DM + i * 512 + lane * 8);
#if I8GATE
        auto emit = [&](const v4u (&r)[4], float ssv, size_t m) {
            float x[4][8]; float mx = 0.f;
#pragma unroll
            for (int i = 0; i < 4; ++i) { unpack8(r[i], x[i]);
#pragma unroll
                for (int e = 0; e < 8; ++e) mx = fmaxf(mx, fabsf(x[i][e])); }
            {   unsigned um = __float_as_uint(mx);
#define FR_DPPMAX(ctrl, rmask) do { const unsigned t_ = (unsigned)__builtin_amdgcn_update_dpp((int)um, (int)um, ctrl, rmask, 0xF, false); um = t_ > um ? t_ : um; } while (0)
                FR_DPPMAX(0x121, 0xF); FR_DPPMAX(0x122, 0xF); FR_DPPMAX(0x124, 0xF); FR_DPPMAX(0x128, 0xF); FR_DPPMAX(0x142, 0xA); FR_DPPMAX(0x143, 0xC);
#undef FR_DPPMAX
                mx = __uint_as_float((unsigned)__builtin_amdgcn_readlane((int)um, 63)); }
            const float sc = mx > 0.f ? 127.f / mx : 0.f;
            if (lane == 0) ((float*)(ws + WS_RSG))[m] = mx * (1.0f / 127.f) * __builtin_amdgcn_rsqf(ssv * (1.0f / DM) + 1e-6f);
#pragma unroll
            for (int i = 0; i < 4; ++i) { typedef unsigned v2u_ __attribute__((ext_vector_type(2)));
                const v2u_ o = {pk4_i8(x[i][0], x[i][1], x[i][2], x[i][3], sc), pk4_i8(x[i][4], x[i][5], x[i][6], x[i][7], sc)};
                *(GAS v2u_*)(h8 + m * DM + i * 512 + lane * 8) = o; } };
#else
        auto emit = [&](const v4u (&r)[4], float ssv, size_t m) {
            const float rs = __builtin_amdgcn_rsqf(ssv * (1.0f / DM) + 1e-6f) * 8.f;
#pragma unroll
            for (int i = 0; i < 4; ++i) { float x[8]; unpack8(r[i], x);
                typedef unsigned v2u_ __attribute__((ext_vector_type(2)));
                const v2u_ o = {pk4_fp8(x[0] * rs, x[1] * rs, x[2] * rs, x[3] * rs), pk4_fp8(x[4] * rs, x[5] * rs, x[6] * rs, x[7] * rs)};
                *(GAS v2u_*)(h8 + m * DM + i * 512 + lane * 8) = o; } };
#endif
#pragma unroll 1
        for (int tt = 0; tt < 16; tt += 2) {
#pragma unroll
            for (int i = 0; i < 4; ++i) rb[i] = *(const GAS v4u*)(xbp + (m0 + tt + 1) * DM + i * 512 + lane * 8);
            sb = (float)ssm[m0 + tt + 1] * pg8::SSQI;
            emit(ra, sa, m0 + tt);
            if (tt + 2 < 16) {
#pragma unroll
                for (int i = 0; i < 4; ++i) ra[i] = *(const GAS v4u*)(xbp + (m0 + tt + 2) * DM + i * 512 + lane * 8);
                sa = (float)ssm[m0 + tt + 2] * pg8::SSQI; }
            emit(rb, sb, m0 + tt + 1); }
    }
    LDS_WAIT(); __syncthreads();
    if (wave == 0) {
        const int head = lane & 7, sub = lane >> 3; float v[16]; float run = 0.f;
#pragma unroll
        for (int i = 0; i < 16; ++i) { run += lf[(sub * 16 + i) * 8 + head]; v[i] = run; }
        float inc = run;
        { const float u = __shfl_up(inc, 8); if (lane >= 8) inc += u; } { const float u = __shfl_up(inc, 16); if (lane >= 16) inc += u; } { const float u = __shfl_up(inc, 32); if (lane >= 32) inc += u; }
        const float excl = inc - run; const int b = chunk >> 6, ch = chunk & 63;
        float* cl = (float*)(ws + WS_CL) + (size_t)(b * 8 + head) * SEQ + ch * 128 + sub * 16;
#pragma unroll
        for (int i = 0; i < 16; ++i) cl[i] = v[i] + excl;
        if (sub == 7) ((float*)(ws + WS_CTOT))[(b * 8 + head) * 64 + ch] = inc;
    }
    __syncthreads();
}
#ifdef XMAPALL
#define DSA_ITEM_B (qi & 3)
#define DSA_ITEM_JT (255 - ((qi >> 2) * 8 + x))
#else
#define DSA_ITEM_B (x >> 1)
#define DSA_ITEM_JT (2 * (127 - qi) + (x & 1))
#endif
#if defined(XSTAG) || defined(ISTAG)
#ifndef XSTAG
#define XSTAG 0
#endif
#ifndef ISTAG
#define ISTAG 0
#endif
#define XSTAGGER() do { const unsigned long long t0_ = __builtin_amdgcn_s_memrealtime(); const unsigned long long d_ = (unsigned long long)(bar.x & 7u) * (XSTAG) + (unsigned long long)((bx >> 3) & 3) * (ISTAG); \
        while (__builtin_amdgcn_s_memrealtime() - t0_ < d_) __builtin_amdgcn_s_sleep(2); } while (0)
#else
#define XSTAGGER() do {} while (0)
#endif
#ifndef PH_MASK
#define PH_MASK 2047
#endif
#ifndef GEMM_ALIGN
#define GEMM_ALIGN true
#endif
#ifndef GEMM_SP2
#define GEMM_SP2 true
#endif
#ifndef DUPM
#define DUPM 0
#endif
#ifndef PREFIX_MASK
#define PREFIX_MASK 0
#endif
#ifndef REP0
#define REP0 1
#endif
#ifndef REP1
#define REP1 1
#endif
#ifndef REP4
#define REP4 1
#endif
#ifndef REP6
#define REP6 1
#endif
#if defined(__HIP_DEVICE_COMPILE__)
__device__ __forceinline__ CArgs& kargs() { CArgs* p = (CArgs*)__builtin_amdgcn_kernarg_segment_ptr(); asm volatile("" : "+s"(p)); return *p; }
#else
__device__ CArgs& kargs();
#endif
__global__ void __launch_bounds__(NWAVES * 64, 2) hybrid_fwd(Args args_unused) {
    extern __shared__ __attribute__((aligned(16))) unsigned char lds_raw[];
    LAS unsigned char* lds = (LAS unsigned char*)lds_raw;
    volatile LAS unsigned* MISC = (volatile LAS unsigned*)(lds + MISC_OFF);
    const int wave = __builtin_amdgcn_readfirstlane((int)(threadIdx.x >> 6));
    const int G = gridDim.x, bx = blockIdx.x;
    const int vcu = (bx & 7) * (G >> 3) + (bx >> 3);
    gu32* ctl = (gu32*)(kargs().ws + WS_CTL);
    for (int u = threadIdx.x; u < (LDS_BYTES - RING_BYTES) / 4; u += NWAVES * 64) ((LAS unsigned*)(lds + RING_BYTES))[u] = 0u;
    __syncthreads();
    XcdBarrier bar = xcd_barrier_post((unsigned*)(ctl + CW_BAR), MISC + 8);
#ifdef MFMABENCH
    {
        typedef float bf4 __attribute__((ext_vector_type(4))); typedef __bf16 bb8 __attribute__((ext_vector_type(8))); typedef int bi8 __attribute__((ext_vector_type(8)));
        bf4 q0 = {0.f, 0.f, 0.f, 0.f}, q1 = q0, q2 = q0, q3 = q0, q4 = q0, q5 = q0, q6 = q0, q7 = q0;
        long xl = 0x3838383838383838L, yl = 0x3838383838383838L; asm volatile("" : "+v"(xl), "+v"(yl));
        bi8 x8 = {0x38383838, 0x38383838, 0x38383838, 0x38383838, 0x38383838, 0x38383838, 0x38383838, 0x38383838}, y8 = x8; asm volatile("" : "+v"(x8), "+v"(y8));
        bb8 xb8, yb8; { bi8 t = x8; xb8 = *(bb8*)&t; yb8 = xb8; } asm volatile("" : "+v"(xb8), "+v"(yb8));
#pragma unroll 1
        for (int it = 0; it < 4096; ++it) {
#if MFMABENCH == 1
#define MB_(q) q = __builtin_amdgcn_mfma_f32_16x16x32_bf16(xb8, yb8, q, 0, 0, 0)
#elif MFMABENCH == 2
#define MB_(q) q = __builtin_amdgcn_mfma_f32_16x16x32_fp8_fp8(xl, yl, q, 0, 0, 0)
#else
#define MB_(q) q = __builtin_amdgcn_mfma_scale_f32_16x16x128_f8f6f4(x8, y8, q, 0, 0, 0, 127, 0, 127)
#endif
            MB_(q0); MB_(q1); MB_(q2); MB_(q3); MB_(q4); MB_(q5); MB_(q6); MB_(q7);
#undef MB_
        }
        asm volatile("" :: "v"(q0), "v"(q1), "v"(q2), "v"(q3), "v"(q4), "v"(q5), "v"(q6), "v"(q7));
    }
#endif

    constexpr size_t SEG_E = SEG_BYTES / 2;
#ifdef PROBE
    unsigned long long tprev = __builtin_amdgcn_s_memrealtime(); float tac0 = 0.f, tac1 = 0.f, tac2 = 0.f, tac3 = 0.f, tac4 = 0.f, tac5 = 0.f, tac6 = 0.f, tac7 = 0.f, tac8 = 0.f, tac9 = 0.f;
#define STAMP(v_) do { const unsigned long long now_ = __builtin_amdgcn_s_memrealtime(); v_ += (float)(now_ - tprev); tprev = now_; } while (0)
#else
#define STAMP(v_) do { } while (0)
#endif
#define PH_PTRS() CArgs& args = kargs(); unsigned char* ws = args.ws; bf16* xb = (bf16*)(ws + WS_XB); bf16* proj = (bf16*)(ws + WS_PROJ); bf16* dsakv = (bf16*)(ws + WS_DSAKV); float* small = (float*)(ws + WS_SMALL); \
        pg8::ssq_t* ssA = (pg8::ssq_t*)(ws + WS_SS) + (size_t)(2 * l) * M; pg8::ssq_t* ssB = ssA + M; pg8::ssq_t* ssN = ssB + M; (void)xb; (void)proj; (void)dsakv; (void)small; (void)ssA; (void)ssB; (void)ssN; (void)args
#pragma unroll 1
    for (int l = 0; l < DEPTH; ++l) {
#pragma unroll 1
        for (int rep = 0; rep < REP0; ++rep) {
#if PH_MASK & 1
        { PH_PTRS(); p0_prologue(args, l, lds, vcu, G * NWAVES, wave); }
#endif
        xcd_barrier(bar);
        }
        STAMP(tac0);
#ifdef REPB
        for (int rb = 0; rb < REPB; ++rb) xcd_barrier(bar);
#endif
#pragma unroll 1
        for (int pass = (PREFIX_MASK ? 0 : 1); pass < 2; ++pass) {
        const int mixmask = pass ? 7 : PREFIX_MASK;
#pragma unroll 1
        for (int rep = 0; rep < REP1; ++rep) {
#if PH_MASK & 2
        {   PH_PTRS(); pg8::Gemm g{xb, (const bf16*)(ws + WS_WIN), M, NIN, DM, 0, wave}; pg8::StaticOrder S; S.init(M, NIN, G, bx);
            pg8::EpiInProj E{proj, dsakv, small, ssA};
            XSTAGGER(); pg8::gemm_phase<pg8::EpiInProj, pg8::StaticOrder, GEMM_ALIGN, GEMM_SP2>(lds, g, S, E); }
#endif
        xcd_barrier(bar);
        }
        STAMP(tac1);
#if PH_MASK & 4
        { PH_PTRS(); p2_post(args, l, lds, wave); }
#endif
        xcd_barrier(bar);
        STAMP(tac2);
        {   PH_PTRS(); const float* cl = (const float*)(ws + WS_CL); const float* ctot = (const float*)(ws + WS_CTOT);
            att::lchar* al = (att::lchar*)lds;
            gu32* qh = (gu32*)(ws + WS_CTL) + CW_QUEUE + (l * 2 + pass) * 512;
            int x = (int)(bar.x & 7u), empties = 0;
            for (;;) {
                if (wave == 0 && lane_id() == 0) MISC[12] = __hip_atomic_fetch_add(qh + 64 * x, 1u, RLX_AGENT);
                __syncthreads();
                const int qi = (int)MISC[12];
                __syncthreads();
                if (qi >= 384) { if (++empties == 8) break; x = (x + 1) & 7; continue; }
                if (qi < 128) {
#if PH_MASK & 32
#if DUPM & 4
                    att::dsa_item(al, proj + 7 * SEG_E, (const bf16*)(ws + WS_IDXK), (const float*)(ws + WS_IDXW), proj + 6 * SEG_E, dsakv, (bf16*)(ws + WS_DUMMY), (unsigned*)(ws + WS_DMASK) + (size_t)bx * 8192, (unsigned*)(ws + WS_DSCR) + (size_t)bx * 16384, (bf16*)(ws + WS_DUMMY), (unsigned*)(ws + WS_CTL) + 64, args.in[6] + l * 128, args.in[7] + l * 128, (const float*)(ws + WS_TAB), DSA_ITEM_B, DSA_ITEM_JT, wave);
#endif
                    if (mixmask & 4) att::dsa_item(al, proj + 7 * SEG_E, (const bf16*)(ws + WS_IDXK), (const float*)(ws + WS_IDXW), proj + 6 * SEG_E, dsakv, proj + 6 * SEG_E, (unsigned*)(ws + WS_DMASK) + (size_t)bx * 8192, (unsigned*)(ws + WS_DSCR) + (size_t)bx * 16384, (bf16*)(ws + WS_DUMMY), (unsigned*)(ws + WS_CTL) + 64, args.in[6] + l * 128, args.in[7] + l * 128, (const float*)(ws + WS_TAB), DSA_ITEM_B, DSA_ITEM_JT, wave);
#endif
                } else if (qi < 256) {
#if PH_MASK & 16
                    const int u = qi - 128, bh = x + 8 * (u & 3);
#if DUPM & 2
                    att::dense_unit<1>(al, proj + 3 * SEG_E, proj + 4 * SEG_E, proj + 5 * SEG_E, (bf16*)(ws + WS_DUMMY), cl, ctot, args.in[4] + l * 128, args.in[5] + l * 128, bh >> 3, bh & 7, 31 - (u >> 2), wave);
#endif
                    if (mixmask & 2) att::dense_unit<1>(al, proj + 3 * SEG_E, proj + 4 * SEG_E, proj + 5 * SEG_E, proj + 3 * SEG_E, cl, ctot, args.in[4] + l * 128, args.in[5] + l * 128, bh >> 3, bh & 7, 31 - (u >> 2), wave);
#endif
                } else {
#if PH_MASK & 8
                    const int u = qi - 256, bh = x + 8 * (u & 3);
#if DUPM & 1
                    att::dense_unit<0>(al, proj + 0 * SEG_E, proj + 1 * SEG_E, proj + 2 * SEG_E, (bf16*)(ws + WS_DUMMY), cl, ctot, nullptr, nullptr, bh >> 3, bh & 7, 31 - (u >> 2), wave);
#endif
                    if (mixmask & 1) att::dense_unit<0>(al, proj + 0 * SEG_E, proj + 1 * SEG_E, proj + 2 * SEG_E, proj + 0 * SEG_E, cl, ctot, nullptr, nullptr, bh >> 3, bh & 7, 31 - (u >> 2), wave);
#endif
                }
            }
        }
        xcd_barrier(bar);
#if I8BR
        { PH_PTRS(); p3b_quant(args, l, lds, vcu, G * NWAVES, wave); }
        xcd_barrier(bar);
#endif
        STAMP(tac5);
        }
#pragma unroll 1
        for (int rep = 0; rep < REP4; ++rep) {
        {   PH_PTRS(); pg8::MergedOrder S{bx};
#if PH_MASK & 64
#if I8BR
            {   pg8::Gemm g{(const bf16*)(ws + WS_OB8), (const bf16*)(ws + WS_WB), M, 6144, 512, 32 * MiB, wave, WS_OB8_2 - WS_OB8, true};
                pg8::EpiBranch<true> E{proj + SEG_E, 3 * SEG_E, (const float*)(ws + WS_RSB), (const float*)(ws + WS_CSB)};
                XSTAGGER(); pg8::gemm_phase<pg8::EpiBranch<true>, pg8::MergedOrder, GEMM_ALIGN, GEMM_SP2, 2>(lds, g, S, E); }
#else
            {   pg8::Gemm g{proj, (const bf16*)(ws + WS_WB), M, 6144, 1024, 3 * SEG_BYTES, wave};
                pg8::EpiBranch<false> E{proj + SEG_E, 3 * SEG_E, nullptr, nullptr};
                XSTAGGER(); pg8::gemm_phase<pg8::EpiBranch<false>, pg8::MergedOrder, GEMM_ALIGN, GEMM_SP2>(lds, g, S, E); }
#endif
#endif
#ifdef REP4B
            {   pg8::Gemm g{proj, (const bf16*)(ws + WS_WB), M, 6144, 1024, 3 * SEG_BYTES, wave};
                pg8::EpiBranch<false> E{(bf16*)(ws + WS_DUMMY), 0, nullptr, nullptr};
                XSTAGGER(); pg8::gemm_phase<pg8::EpiBranch<false>, pg8::MergedOrder, GEMM_ALIGN, GEMM_SP2>(lds, g, S, E); }
#endif
#ifdef REP4G
            {   pg8::Gemm g{xb, (const bf16*)(ws + WS_WG), M, 6144, DM, 0, wave};
                pg8::EpiGate<false> E{(bf16*)(ws + WS_DUMMY), 0, ssA, 0.f, nullptr, nullptr};
                XSTAGGER(); pg8::gemm_phase<pg8::EpiGate<false>, pg8::MergedOrder, GEMM_ALIGN, GEMM_SP2>(lds, g, S, E); }
#endif
#if PH_MASK & 128
#if I8GATE
            {   pg8::Gemm g{(const bf16*)(ws + WS_H8), (const bf16*)(ws + WS_WG), M, 6144, DM / 2, 0, wave};
                pg8::EpiGate<true> E{proj + SEG_E, 3 * SEG_E, ssA, 0.f, (const float*)(ws + WS_RSG), (const float*)(ws + WS_CSG)};
                XSTAGGER(); pg8::gemm_phase<pg8::EpiGate<true>, pg8::MergedOrder, GEMM_ALIGN, GEMM_SP2, 2>(lds, g, S, E); }
#else
            {   pg8::Gemm g{(const bf16*)(ws + WS_H8), (const bf16*)(ws + WS_WG), M, 6144, DM / 2, 0, wave};
                pg8::EpiGate<false> E{proj + SEG_E, 3 * SEG_E, ssA, 1.0f / 2048.0f, nullptr, nullptr};
                XSTAGGER(); pg8::gemm_phase<pg8::EpiGate<false>, pg8::MergedOrder, GEMM_ALIGN, GEMM_SP2, 1>(lds, g, S, E); }
#endif
#endif
        }
        xcd_barrier(bar);
        }
        STAMP(tac6);
#if PH_MASK & 256
        {   PH_PTRS(); pg8::Gemm g{proj + SEG_E, (const bf16*)(ws + WS_WO), M, DM, DM, 0, wave}; pg8::StaticOrder S; S.init(M, DM, G, bx);
#ifdef REP5
            { pg8::EpiResid<false> E0{xb, nullptr, ssB + ((size_t)885 << 18), (bf16*)(ws + WS_DUMMY), 1.0f};
              XSTAGGER(); pg8::gemm_phase<pg8::EpiResid<false>, pg8::StaticOrder, GEMM_ALIGN, GEMM_SP2>(lds, g, S, E0); xcd_barrier(bar); }
#endif
            pg8::EpiResid<false> E{xb, nullptr, ssB, xb, 1.0f};
            XSTAGGER(); pg8::gemm_phase<pg8::EpiResid<false>, pg8::StaticOrder, GEMM_ALIGN, GEMM_SP2>(lds, g, S, E); }
#endif
        xcd_barrier(bar);
#if I8FFN
        { PH_PTRS(); p5b_quant(args, l, lds, vcu, G * NWAVES, wave); }
        xcd_barrier(bar);
#endif
        STAMP(tac7);
#pragma unroll 1
        for (int rep = 0; rep < REP6; ++rep) {
#if PH_MASK & 512
        {   PH_PTRS(); pg8::StaticOrder S; S.init(M, 2 * DFF, G, bx);
#if I8FFN
            pg8::Gemm g{(const bf16*)(ws + WS_H8), (const bf16*)(ws + WS_WGU), M, 2 * DFF, DM / 2, 0, wave};
            pg8::EpiSwiGLU<true> E{proj, ssB, F8DOWN(l) ? (unsigned char*)proj : nullptr, (const float*)(ws + WS_RS8), (const float*)(ws + WS_CS8)};
            XSTAGGER(); pg8::gemm_phase<pg8::EpiSwiGLU<true>, pg8::StaticOrder, GEMM_ALIGN, GEMM_SP2, 2>(lds, g, S, E); }
#else
            pg8::Gemm g{xb, (const bf16*)(ws + WS_WGU), M, 2 * DFF, DM, 0, wave};
            pg8::EpiSwiGLU<false> E{proj, ssB, F8DOWN(l) ? (unsigned char*)proj : nullptr, nullptr, nullptr};
            XSTAGGER(); pg8::gemm_phase<pg8::EpiSwiGLU<false>, pg8::StaticOrder, GEMM_ALIGN, GEMM_SP2>(lds, g, S, E); }
#endif
#endif
        xcd_barrier(bar);
        }
        STAMP(tac8);
#if PH_MASK & 1024
        {   PH_PTRS(); pg8::StaticOrder S; S.init(M, DM, G, bx);
            constexpr bool F8I = F8DOWN_INNER != 0, F8L = F8DOWN_LAST != 0;
            if (l + 1 < DEPTH) { pg8::Gemm g{proj, (const bf16*)(ws + WS_WD), M, DM, F8I ? DFF / 2 : DFF, 0, wave}; pg8::EpiResid<false> E{xb, nullptr, ssN, xb, F8I ? 1.0f / 4096.0f : 1.0f};
                XSTAGGER(); pg8::gemm_phase<pg8::EpiResid<false>, pg8::StaticOrder, GEMM_ALIGN, GEMM_SP2, F8I>(lds, g, S, E); }
            else { pg8::Gemm g{proj, (const bf16*)(ws + WS_WD), M, DM, F8L ? DFF / 2 : DFF, 0, wave}; pg8::EpiResid<true> E{xb, args.out, nullptr, nullptr, F8L ? 1.0f / 4096.0f : 1.0f};
                XSTAGGER(); pg8::gemm_phase<pg8::EpiResid<true>, pg8::StaticOrder, GEMM_ALIGN, GEMM_SP2, F8L>(lds, g, S, E); } }
#endif
        if (l + 1 < DEPTH) xcd_barrier(bar);
        STAMP(tac9);
    }
#if DSA_CHECK
    xcd_barrier(bar);
    if (bx == 0 && wave == 0 && lane_id() == 0 && __hip_atomic_load((unsigned*)(kargs().ws + WS_CTL) + 64, RLX_AGENT) != 0u) kargs().out[0] = 3.0e6f;
#endif
#ifdef PROBE
    xcd_barrier(bar);
    if (bx == 0) {
        const float tt[10] = {tac0, tac1, tac2, tac3, tac4, tac5, tac6, tac7, tac8, tac9};
        float ta = 0.f, tb = 0.f;
#pragma unroll
        for (int i = 0; i < 10; ++i) { if ((PROBE_A >> i) & 1) ta += tt[i]; if (PROBE_B >= 0 && ((PROBE_B >> i) & 1)) tb += tt[i]; }
        const float v = ta * 0.01f * 10.f; const int n = PROBE_B < 0 ? 1000000 : (int)(tb * 0.01f * 1000.f);
        float* o = kargs().out;
        for (int i = wave * 64 + lane_id(); i < n; i += NWAVES * 64) o[i] = v;
    }
#endif
}

extern "C" void kernel_launch(void* const* d_in, const int* in_sizes, int n_in, void* d_out, int out_size, void* d_ws, size_t ws_size, hipStream_t stream) {
    static int grid = 0;
    if (grid == 0) {
        if (n_in != 15 || in_sizes[0] != M * DM || out_size != M * DM || ws_size < WS_TOTAL) { fprintf(stderr, "kernel_launch: shape/workspace mismatch (n_in %d, ws %zu)\n", n_in, ws_size); grid = -1; return; }
        int dev = 0, cus = 0;
        if (hipGetDevice(&dev) != hipSuccess || hipDeviceGetAttribute(&cus, hipDeviceAttributeMultiprocessorCount, dev) != hipSuccess) { grid = -1; return; }
        if (hipFuncSetAttribute((const void*)hybrid_fwd, hipFuncAttributeMaxDynamicSharedMemorySize, LDS_BYTES) != hipSuccess) { fprintf(stderr, "kernel_launch: hipFuncSetAttribute failed\n"); grid = -1; return; }
        int per_cu = 0;
        if (hipOccupancyMaxActiveBlocksPerMultiprocessor(&per_cu, (const void*)hybrid_fwd, NWAVES * 64, LDS_BYTES) != hipSuccess || per_cu < 1) fprintf(stderr, "kernel_launch: occupancy query reports %d\n", per_cu);
        (void)hipGetLastError();
        if (cus < 256) { fprintf(stderr, "kernel_launch: needs 256 CUs, device has %d\n", cus); grid = -1; return; }
        grid = 256;
    }
    if (grid < 0) return;
    if (hipMemsetAsync((char*)d_ws + WS_CTL, 0, CTL_ZERO_BYTES, stream) != hipSuccess) return;
    Args a{};
    for (int i = 0; i < 15; ++i) a.in[i] = (const float*)d_in[i];
    a.out = (float*)d_out; a.ws = (unsigned char*)d_ws;
    hipLaunchKernelGGL(hybrid_fwd, dim3(grid), dim3(NWAVES * 64), LDS_BYTES, stream, a);
}
```

```cpp
#define I8GATE 0
#include <hip/hip_runtime.h>
#include <cstdio>
#include <cstdint>
#include <cmath>
namespace pg8 {
#define PG8_LAS __attribute__((address_space(3)))
typedef unsigned short bf16_t;
typedef short bf16x8 __attribute__((ext_vector_type(8)));
typedef float f32x4 __attribute__((ext_vector_type(4)));
typedef unsigned u32x4 __attribute__((ext_vector_type(4)));
constexpr int BM = 256, BK = 64, HALF = 128, HTB = HALF * BK * 2  , STAGE_BYTES = 8 * HTB, NXCD = 8, WGM = 8;

__host__ __device__ __forceinline__ int lds_byte(int r, int c) { const int st = (r >> 4) * 2 + (c >> 5), rr = r & 15, cc = c & 31, ob = rr * 64 + cc * 2; return st * 1024 + (ob ^ (((ob >> 9) & 1) << 5)); }
__host__ __device__ __forceinline__ void stage_rc(int b, int& R, int& C) { const int st = b / 1024, sb = b % 1024, swz = sb ^ (((sb >> 9) & 1) << 5); R = (st >> 1) * 16 + swz / 64; C = (st & 1) * 32 + (swz % 64) / 2; }
__host__ __device__ __forceinline__ int perm32(int rho) { const int n = rho >> 4, i = rho & 15; return 8 * (i >> 2) + 4 * n + (i & 3); }

struct Unit { int pm, pn, ag; };
struct Gemm { const bf16_t* A; const bf16_t* Bt; int M, N, K; size_t ag_stride; int wave; size_t ag2 = 0; bool ag2on = false;
    __device__ __forceinline__ size_t agoff(int ag) const { return (ag2on && ag == 2) ? ag2 : (size_t)ag * ag_stride; } };

struct StaticOrder {
    int nM, nN, nwg, G, c;
    __host__ __device__ void init(int M, int N, int G_, int c_) { nM = M / BM; nN = N / BM; nwg = nM * nN; G = G_; c = c_; }
    __host__ __device__ bool next(int i, Unit& u) const {
        const long L = (long)i * G + c; if (L >= nwg) return false;
        int wgid = (int)L; { const int q = nwg / NXCD, r = nwg % NXCD, xcd = wgid % NXCD, off = wgid / NXCD; wgid = (xcd < r ? xcd * (q + 1) : r * (q + 1) + (xcd - r) * q) + off; }
        const int nig = WGM * nN, gid = wgid / nig, fm = gid * WGM, gsz = (nM - fm) < WGM ? (nM - fm) : WGM;
        u.pm = fm + ((wgid % nig) % gsz); u.pn = (wgid % nig) / gsz; u.ag = 0; return true;
    }
    __device__ __forceinline__ void a_ready(const Unit&) const {}
    __device__ __forceinline__ void done(const Unit&) const {}
};

__device__ __forceinline__ unsigned cvt_pk_bf16(float lo, float hi) { unsigned r; asm volatile("v_cvt_pk_bf16_f32 %0, %1, %2" : "=v"(r) : "v"(lo), "v"(hi)); return r; }
typedef float f32x2 __attribute__((ext_vector_type(2)));
typedef int i32x4 __attribute__((ext_vector_type(4)));
typedef int i32x8 __attribute__((ext_vector_type(8)));
constexpr int EP_M = 32768, EP_D = 2048;
constexpr float EP_EPS = 1e-6f;
constexpr size_t SEG_ELEMS = (size_t)EP_M * 1024;
typedef unsigned long long ssq_t;
constexpr float SSQ = 1048576.0f, SSQI = 1.0f / 1048576.0f;
__device__ __forceinline__ ssq_t ssq_of(float s) { return (ssq_t)(s * SSQ + 0.5f); }
__device__ __forceinline__ float rstd_of(const ssq_t* ss, int row) { return __builtin_amdgcn_rsqf((float)ss[row] * (SSQI / EP_D) + EP_EPS); }
__device__ __forceinline__ float bf_lo(unsigned w) { return __uint_as_float(w << 16); }
__device__ __forceinline__ float bf_hi(unsigned w) { return __uint_as_float(w & 0xffff0000u); }
__device__ __forceinline__ float fp8rt(float v, float s) {
    v = fminf(fmaxf(v * s, -448.f), 448.f); const int w = __builtin_amdgcn_cvt_pk_fp8_f32(v, v, 0, false); return __builtin_amdgcn_cvt_f32_fp8(w, 0) / s; }
__device__ __forceinline__ unsigned pk4_fp8e(float a, float b, float c, float d) {
    a = fminf(fmaxf(a, -448.f), 448.f); b = fminf(fmaxf(b, -448.f), 448.f); c = fminf(fmaxf(c, -448.f), 448.f); d = fminf(fmaxf(d, -448.f), 448.f);
    int w = __builtin_amdgcn_cvt_pk_fp8_f32(a, b, 0, false); w = __builtin_amdgcn_cvt_pk_fp8_f32(c, d, w, true); return (unsigned)w; }
__device__ __forceinline__ float sigmoid_f(float x) { return __builtin_amdgcn_rcpf(1.0f + __builtin_amdgcn_exp2f(-1.4426950408889634f * x)); }

struct EpiInProj {
    static constexpr bool PERM = true, AFTER_DRAIN = false, IDEMPOTENT = true;
    bf16_t* proj; bf16_t* dsakv; float* small; const ssq_t* ss;
    __device__ __forceinline__ void operator()(const f32x4 (&acc)[2][2][4][2], const Unit& u, int wr, int wc, int fr, int fq) const {
        const int row0 = u.pm * BM + wr * 64 + fr, cb = wc * 32 + 8 * fq;
        float rsv[2][4]; ssq_t rq[2][4];
#pragma unroll
        for (int ai = 0; ai < 2; ++ai)
#pragma unroll
            for (int m = 0; m < 4; ++m) rq[ai][m] = ss[row0 + ai * HALF + m * 16];
        asm volatile("" : "+v"(rq[0][0]), "+v"(rq[0][1]), "+v"(rq[0][2]), "+v"(rq[0][3]), "+v"(rq[1][0]), "+v"(rq[1][1]), "+v"(rq[1][2]), "+v"(rq[1][3]));
#pragma unroll
        for (int ai = 0; ai < 2; ++ai)
#pragma unroll
            for (int m = 0; m < 4; ++m) rsv[ai][m] = (float)rq[ai][m] * SSQI;
        asm volatile("" : "+v"(rsv[0][0]), "+v"(rsv[0][1]), "+v"(rsv[0][2]), "+v"(rsv[0][3]), "+v"(rsv[1][0]), "+v"(rsv[1][1]), "+v"(rsv[1][2]), "+v"(rsv[1][3]));
#pragma unroll
        for (int ai = 0; ai < 2; ++ai)
#pragma unroll
            for (int m = 0; m < 4; ++m) rsv[ai][m] = __builtin_amdgcn_rsqf(rsv[ai][m] * (1.0f / EP_D) + EP_EPS);
        if (u.pn < 34) {
            bf16_t* base; int ld, colt;
            if (u.pn < 32) { base = proj + (size_t)(u.pn >> 2) * SEG_ELEMS; ld = 1024; colt = (u.pn & 3) * 256; }
            else { base = dsakv; ld = 512; colt = (u.pn - 32) * 256; }
#pragma unroll
            for (int ai = 0; ai < 2; ++ai)
#pragma unroll
                for (int m = 0; m < 4; ++m) { const int row = row0 + ai * HALF + m * 16; const float rs = rsv[ai][m]; bf16_t* rowp = base + (size_t)row * ld + colt + cb;
#pragma unroll
                    for (int bj = 0; bj < 2; ++bj) { const f32x4 v0 = acc[ai][bj][m][0] * rs, v1 = acc[ai][bj][m][1] * rs;
                        u32x4 w; w.x = cvt_pk_bf16(v0[0], v0[1]); w.y = cvt_pk_bf16(v0[2], v0[3]); w.z = cvt_pk_bf16(v1[0], v1[1]); w.w = cvt_pk_bf16(v1[2], v1[3]);
                        __builtin_nontemporal_store(w, (u32x4*)(rowp + bj * HALF)); } }
        } else {
#pragma unroll
            for (int ai = 0; ai < 2; ++ai)
#pragma unroll
                for (int m = 0; m < 4; ++m) { const int row = row0 + ai * HALF + m * 16; const float rs = rsv[ai][m]; float* rowp = small + (size_t)row * 256 + cb;
#pragma unroll
                    for (int bj = 0; bj < 2; ++bj) { *(f32x4*)(rowp + bj * HALF) = acc[ai][bj][m][0] * rs; *(f32x4*)(rowp + bj * HALF + 4) = acc[ai][bj][m][1] * rs; } }
        }
    }
};
template <bool I8>
struct EpiBranch {
    static constexpr bool PERM = true, AFTER_DRAIN = false, IDEMPOTENT = true;
    bf16_t* tb; size_t gstride; const float* rs8; const float* cs8;
    __device__ __forceinline__ void operator()(const f32x4 (&acc)[2][2][4][2], const Unit& u, int wr, int wc, int fr, int fq) const {
        const int row0 = u.pm * BM + wr * 64 + fr, col0 = (u.pn & 7) * BM + wc * 32 + 8 * fq; bf16_t* base = tb + (size_t)u.ag * gstride;
        float rsc[2][4]; f32x4 cs[2][2];
        if constexpr (I8) {
            const float* cp = cs8 + u.pn * BM + wc * 32 + 8 * fq;
#pragma unroll
            for (int bj = 0; bj < 2; ++bj) { cs[bj][0] = *(const f32x4*)(cp + bj * HALF); cs[bj][1] = *(const f32x4*)(cp + bj * HALF + 4); }
#pragma unroll
            for (int ai = 0; ai < 2; ++ai)
#pragma unroll
                for (int m = 0; m < 4; ++m) rsc[ai][m] = rs8[(size_t)u.ag * EP_M + row0 + ai * HALF + m * 16]; }
#pragma unroll
        for (int ai = 0; ai < 2; ++ai)
#pragma unroll
            for (int m = 0; m < 4; ++m) { bf16_t* rowp = base + (size_t)(row0 + ai * HALF + m * 16) * EP_D + col0;
#pragma unroll
                for (int bj = 0; bj < 2; ++bj) { f32x4 v0 = acc[ai][bj][m][0], v1 = acc[ai][bj][m][1];
                    if constexpr (I8) { const float r = rsc[ai][m];
                        const float a0 = v0[0], a1 = v0[1], a2 = v0[2], a3 = v0[3], b0 = v1[0], b1 = v1[1], b2 = v1[2], b3 = v1[3];
                        v0 = (f32x4){(float)__float_as_int(a0), (float)__float_as_int(a1), (float)__float_as_int(a2), (float)__float_as_int(a3)} * (cs[bj][0] * r);
                        v1 = (f32x4){(float)__float_as_int(b0), (float)__float_as_int(b1), (float)__float_as_int(b2), (float)__float_as_int(b3)} * (cs[bj][1] * r); }
                    u32x4 w; w.x = cvt_pk_bf16(v0[0], v0[1]); w.y = cvt_pk_bf16(v0[2], v0[3]); w.z = cvt_pk_bf16(v1[0], v1[1]); w.w = cvt_pk_bf16(v1[2], v1[3]);
                    *(u32x4*)(rowp + bj * HALF) = w; } }
    }
};
template <bool I8>
struct EpiGate {
    static constexpr bool PERM = true, AFTER_DRAIN = false, IDEMPOTENT = false;
    bf16_t* tb; size_t gstride; const ssq_t* ss; float fscale; const float* rs8; const float* cs8;
    __device__ __forceinline__ void operator()(const f32x4 (&acc)[2][2][4][2], const Unit& u, int wr, int wc, int fr, int fq) const {
        const int row0 = u.pm * BM + wr * 64 + fr, col0 = (u.pn & 7) * BM + wc * 32 + 8 * fq; const int g = u.ag;
        const bf16_t* tg = tb + (size_t)g * gstride;
        float rsv[2][4]; ssq_t rq[2][4];
        if constexpr (I8) {
#pragma unroll
            for (int ai = 0; ai < 2; ++ai)
#pragma unroll
                for (int m = 0; m < 4; ++m) rsv[ai][m] = rs8[row0 + ai * HALF + m * 16]; }
        else {
#pragma unroll
        for (int ai = 0; ai < 2; ++ai)
#pragma unroll
            for (int m = 0; m < 4; ++m) rq[ai][m] = ss[row0 + ai * HALF + m * 16];
        asm volatile("" : "+v"(rq[0][0]), "+v"(rq[0][1]), "+v"(rq[0][2]), "+v"(rq[0][3]), "+v"(rq[1][0]), "+v"(rq[1][1]), "+v"(rq[1][2]), "+v"(rq[1][3]));
#pragma unroll
        for (int ai = 0; ai < 2; ++ai)
#pragma unroll
            for (int m = 0; m < 4; ++m) rsv[ai][m] = (float)rq[ai][m] * SSQI;
        asm volatile("" : "+v"(rsv[0][0]), "+v"(rsv[0][1]), "+v"(rsv[0][2]), "+v"(rsv[0][3]), "+v"(rsv[1][0]), "+v"(rsv[1][1]), "+v"(rsv[1][2]), "+v"(rsv[1][3]));
#pragma unroll
        for (int ai = 0; ai < 2; ++ai)
#pragma unroll
            for (int m = 0; m < 4; ++m) rsv[ai][m] = __builtin_amdgcn_rsqf(rsv[ai][m] * (1.0f / EP_D) + EP_EPS);
        }
#pragma unroll
        for (int ai = 0; ai < 2; ++ai)
#pragma unroll
          for (int bh = 0; bh < (I8 ? 2 : 1); ++bh) { const int bj0 = I8 ? bh : 0, bj1 = I8 ? bh + 1 : 2;
            f32x4 cs[2][2];
            if constexpr (I8) { const float* cp = cs8 + u.pn * BM + wc * 32 + 8 * fq + bh * HALF; cs[bh][0] = *(const f32x4*)cp; cs[bh][1] = *(const f32x4*)(cp + 4); }
            u32x4 tv[4][2], pv[4][2];
#pragma unroll
            for (int m = 0; m < 4; ++m)
#pragma unroll
                for (int bj = bj0; bj < bj1; ++bj) { const size_t off = (size_t)(row0 + ai * HALF + m * 16) * EP_D + col0 + bj * HALF;
                    tv[m][bj] = *(const u32x4*)(tg + off); pv[m][bj] = (u32x4){0u, 0u, 0u, 0u}; if (g > 0) pv[m][bj] = *(const u32x4*)(tb + off); }
#pragma unroll
            for (int m = 0; m < 4; ++m) { const float nrs = -1.4426950408889634f * ((!I8 && fscale != 0.f) ? fscale : rsv[ai][m]); const size_t off = (size_t)(row0 + ai * HALF + m * 16) * EP_D + col0;
#pragma unroll
                for (int bj = bj0; bj < bj1; ++bj) { const u32x4 t = tv[m][bj], p = pv[m][bj]; u32x4 w;
#pragma unroll
                    for (int q = 0; q < 4; ++q) {
                        f32x2 x = {acc[ai][bj][m][q >> 1][2 * (q & 1)], acc[ai][bj][m][q >> 1][2 * (q & 1) + 1]};
                        if constexpr (I8) { const float x0_ = x[0], x1_ = x[1];
                            x = (f32x2){(float)__float_as_int(x0_) * cs[bj][q >> 1][2 * (q & 1)], (float)__float_as_int(x1_) * cs[bj][q >> 1][2 * (q & 1) + 1]}; }
                        const f32x2 a = x * nrs; const f32x2 d = (f32x2){__builtin_amdgcn_exp2f(a[0]), __builtin_amdgcn_exp2f(a[1])} + 1.0f;
                        const f32x2 r = {__builtin_amdgcn_rcpf(d[0]), __builtin_amdgcn_rcpf(d[1])};
                        const f32x2 o = r * (f32x2){bf_lo(t[q]), bf_hi(t[q])} + (f32x2){bf_lo(p[q]), bf_hi(p[q])};
                        w[q] = cvt_pk_bf16(o[0], o[1]); }
                    *(u32x4*)(tb + off + bj * HALF) = w; } }
        }
    }
};
template <bool LAST> struct EpiResid {
    static constexpr bool PERM = true, AFTER_DRAIN = false, IDEMPOTENT = false;
    bf16_t* xb; float* xout; ssq_t* ssn; bf16_t* xbo; float ascale;
    __device__ __forceinline__ void operator()(const f32x4 (&acc)[2][2][4][2], const Unit& u, int wr, int wc, int fr, int fq) const {
        const int row0 = u.pm * BM + wr * 64 + fr, col0 = u.pn * BM + wc * 32 + 8 * fq;
#pragma unroll
        for (int ai = 0; ai < 2; ++ai) {
            u32x4 xv[4][2];
#pragma unroll
            for (int m = 0; m < 4; ++m)
#pragma unroll
                for (int bj = 0; bj < 2; ++bj) xv[m][bj] = *(const u32x4*)(xb + (size_t)(row0 + ai * HALF + m * 16) * EP_D + col0 + bj * HALF);
#pragma unroll
            for (int m = 0; m < 4; ++m) { const int row = row0 + ai * HALF + m * 16; const size_t off = (size_t)row * EP_D + col0; float sq = 0.f;
#pragma unroll
                for (int bj = 0; bj < 2; ++bj) { const u32x4 xw = xv[m][bj];
                    f32x4 v0 = acc[ai][bj][m][0] * ascale, v1 = acc[ai][bj][m][1] * ascale;
                    v0[0] += bf_lo(xw.x); v0[1] += bf_hi(xw.x); v0[2] += bf_lo(xw.y); v0[3] += bf_hi(xw.y); v1[0] += bf_lo(xw.z); v1[1] += bf_hi(xw.z); v1[2] += bf_lo(xw.w); v1[3] += bf_hi(xw.w);
                    if (LAST) { *(f32x4*)(xout + off + bj * HALF) = v0; *(f32x4*)(xout + off + bj * HALF + 4) = v1; }
                    else { u32x4 w; w.x = cvt_pk_bf16(v0[0], v0[1]); w.y = cvt_pk_bf16(v0[2], v0[3]); w.z = cvt_pk_bf16(v1[0], v1[1]); w.w = cvt_pk_bf16(v1[2], v1[3]);
                        *(u32x4*)(xbo + off + bj * HALF) = w;
                        sq += (v0[0] * v0[0] + v0[1] * v0[1]) + (v0[2] * v0[2] + v0[3] * v0[3]) + (v1[0] * v1[0] + v1[1] * v1[1]) + (v1[2] * v1[2] + v1[3] * v1[3]); } }
                if (!LAST) { sq += __shfl_xor(sq, 16); sq += __shfl_xor(sq, 32); if (fq == 0) atomicAdd(ssn + row, ssq_of(sq)); } }
        }
    }
};
template <bool I8>
struct EpiSwiGLU {
    static constexpr bool PERM = true, AFTER_DRAIN = false, IDEMPOTENT = true;
    bf16_t* act; const ssq_t* ss; unsigned char* act8;
    const float* rs8; const float* cs8;
    __device__ __forceinline__ void operator()(const f32x4 (&acc)[2][2][4][2], const Unit& u, int wr, int wc, int fr, int fq) const {
        const int row0 = u.pm * BM + wr * 64 + fr, col0 = u.pn * HALF + wc * 32 + 8 * fq;
        float rsv[2][4]; ssq_t rq[2][4];
        float rsc[2][4]; f32x4 cg[2], cu[2];
        if constexpr (I8) {
            const float* cp = cs8 + u.pn * BM + wc * 32 + 8 * fq;
            cg[0] = *(const f32x4*)cp; cg[1] = *(const f32x4*)(cp + 4); cu[0] = *(const f32x4*)(cp + HALF); cu[1] = *(const f32x4*)(cp + HALF + 4);
#pragma unroll
            for (int ai = 0; ai < 2; ++ai)
#pragma unroll
                for (int m = 0; m < 4; ++m) rsc[ai][m] = rs8[row0 + ai * HALF + m * 16]; }
#pragma unroll
        for (int ai = 0; ai < 2; ++ai)
#pragma unroll
            for (int m = 0; m < 4; ++m) rq[ai][m] = ss[row0 + ai * HALF + m * 16];
        asm volatile("" : "+v"(rq[0][0]), "+v"(rq[0][1]), "+v"(rq[0][2]), "+v"(rq[0][3]), "+v"(rq[1][0]), "+v"(rq[1][1]), "+v"(rq[1][2]), "+v"(rq[1][3]));
#pragma unroll
        for (int ai = 0; ai < 2; ++ai)
#pragma unroll
            for (int m = 0; m < 4; ++m) rsv[ai][m] = (float)rq[ai][m] * SSQI;
        asm volatile("" : "+v"(rsv[0][0]), "+v"(rsv[0][1]), "+v"(rsv[0][2]), "+v"(rsv[0][3]), "+v"(rsv[1][0]), "+v"(rsv[1][1]), "+v"(rsv[1][2]), "+v"(rsv[1][3]));
#pragma unroll
        for (int ai = 0; ai < 2; ++ai)
#pragma unroll
            for (int m = 0; m < 4; ++m) { rsv[ai][m] = rsv[ai][m] * (1.0f / EP_D) + EP_EPS;
                if constexpr (I8) { const float r = rsc[ai][m]; rsv[ai][m] *= __builtin_amdgcn_rcpf(r * r); } }
#pragma unroll
        for (int ai = 0; ai < 2; ++ai)
#pragma unroll
            for (int m = 0; m < 4; ++m) { const int row = row0 + ai * HALF + m * 16; const float v = rsv[ai][m], nrs = -1.4426950408889634f * __builtin_amdgcn_rsqf(v);
                u32x4 w; float of[8];
#pragma unroll
                for (int q = 0; q < 4; ++q) {
                    f32x2 gt = {acc[ai][0][m][q >> 1][2 * (q & 1)], acc[ai][0][m][q >> 1][2 * (q & 1) + 1]}, up = {acc[ai][1][m][q >> 1][2 * (q & 1)], acc[ai][1][m][q >> 1][2 * (q & 1) + 1]};
                    if constexpr (I8) {
                        const float g0_ = gt[0], g1_ = gt[1], u0_ = up[0], u1_ = up[1];
                        gt = (f32x2){(float)__float_as_int(g0_) * cg[q >> 1][2 * (q & 1)], (float)__float_as_int(g1_) * cg[q >> 1][2 * (q & 1) + 1]};
                        up = (f32x2){(float)__float_as_int(u0_) * cu[q >> 1][2 * (q & 1)], (float)__float_as_int(u1_) * cu[q >> 1][2 * (q & 1) + 1]}; }
                    const f32x2 a = gt * nrs; const f32x2 d = (f32x2){__builtin_amdgcn_exp2f(a[0]), __builtin_amdgcn_exp2f(a[1])} * v + v;
                    const f32x2 o = (gt * up) * (f32x2){__builtin_amdgcn_rcpf(d[0]), __builtin_amdgcn_rcpf(d[1])};
                    of[2 * q] = o[0]; of[2 * q + 1] = o[1];
                    w[q] = cvt_pk_bf16(o[0], o[1]); }
                if (act8 != nullptr) { typedef unsigned v2u_ __attribute__((ext_vector_type(2)));
                    const v2u_ w8 = {pk4_fp8e(of[0] * 16.f, of[1] * 16.f, of[2] * 16.f, of[3] * 16.f), pk4_fp8e(of[4] * 16.f, of[5] * 16.f, of[6] * 16.f, of[7] * 16.f)};
                    __builtin_nontemporal_store(w8, (v2u_*)(act8 + (size_t)row * 5632 + col0)); }
                else __builtin_nontemporal_store(w, (u32x4*)(act + (size_t)row * 5632 + col0)); }
    }
};
struct MergedOrder {
    int c;
    __device__ __forceinline__ bool next(int i, Unit& u) const {
        if (i >= 12) return false;
        const int k = i / 3, grp = i - 3 * k, x = c & 7, y = c >> 3;
        u.pm = (k * 8 + x) * 4 + (y >> 3); u.pn = grp * 8 + (y & 7); u.ag = grp; return true;
    }
    __device__ __forceinline__ void a_ready(const Unit&) const {}
    __device__ __forceinline__ void done(const Unit&) const {}
};
template <class Epi, class Sched, bool ALIGN_EPI = false, bool SP2 = false, int F8 = 0>
__device__ __forceinline__ void gemm_phase(PG8_LAS unsigned char* lds, const Gemm g, const Sched& S, const Epi& E) {
    int tid_ = g.wave * 64 + (int)__builtin_amdgcn_mbcnt_hi(~0u, __builtin_amdgcn_mbcnt_lo(~0u, 0u)); asm volatile("" : "+v"(tid_));
    const int tid = tid_, wid = __builtin_amdgcn_readfirstlane(tid >> 6), lane = tid & 63, wr = wid >> 2, wc = wid & 3, fr = lane & 15, fq = lane >> 4;
    const int K = g.K, nt = K / BK;
    unsigned voffA[2], voffB[2];
#pragma unroll
    for (int i = 0; i < 2; ++i) { int R, C; stage_rc(tid * 16 + i * 8192, R, C); const int Rb = Epi::PERM ? ((R & ~31) + perm32(R & 31)) : R;
        voffA[i] = (unsigned)(R * K + C) * 2u; voffB[i] = (unsigned)(Rb * K + C) * 2u; }
    const size_t kstep = (size_t)(BK * 2);
    const size_t hstep = (size_t)HALF * K * 2;
    const size_t tstep = 2 * hstep;
    const unsigned ldsw = (unsigned)wid * 1024u;
    const int aoff = lds_byte(wr * 64 + fr, fq * 8), boff = lds_byte(wc * 32 + fr, fq * 8);
#define PG8_SA(b, h) (((b) * 2 + (h)) * HTB)
#define PG8_SB(b, h) ((4 + (b) * 2 + (h)) * HTB)
#define PG8_STAGE(bufoff, gbase, voff) do { _Pragma("unroll") for (int _i = 0; _i < 2; ++_i) \
        __builtin_amdgcn_global_load_lds((const unsigned*)((const char*)(gbase) + (voff)[_i]), (PG8_LAS unsigned*)(lds + (bufoff) + ldsw + _i * 8192), 16, 0, 0); } while (0)
#define PG8_LDA(dst, b, h) do { _Pragma("unroll") for (int m = 0; m < 4; ++m) _Pragma("unroll") for (int k = 0; k < 2; ++k) dst[m][k] = *(const PG8_LAS bf16x8*)(lds + PG8_SA(b, h) + aoff + m * 2048 + k * 1024); } while (0)
#define PG8_LDB(dst, b, h) do { _Pragma("unroll") for (int n = 0; n < 2; ++n) _Pragma("unroll") for (int k = 0; k < 2; ++k) dst[n][k] = *(const PG8_LAS bf16x8*)(lds + PG8_SB(b, h) + boff + n * 2048 + k * 1024); } while (0)
#define PG8_MMA(ai, bj, At, Bt) do { __builtin_amdgcn_s_setprio(1); _Pragma("unroll") for (int m = 0; m < 4; ++m) _Pragma("unroll") for (int n = 0; n < 2; ++n) _Pragma("unroll") for (int k = 0; k < 2; ++k) \
        acc[ai][bj][m][n] = __builtin_amdgcn_mfma_f32_16x16x32_bf16(Bt[n][k], At[m][k], acc[ai][bj][m][n], 0, 0, 0); __builtin_amdgcn_s_setprio(0); } while (0)
#define PG8_MMA8(ai, bj, At, Bt) do { __builtin_amdgcn_s_setprio(1); _Pragma("unroll") for (int m = 0; m < 4; ++m) _Pragma("unroll") for (int n = 0; n < 2; ++n) { \
        const i32x8 a8_ = __builtin_shufflevector(*(const i32x4*)&At[m][0], *(const i32x4*)&At[m][1], 0, 1, 2, 3, 4, 5, 6, 7), b8_ = __builtin_shufflevector(*(const i32x4*)&Bt[n][0], *(const i32x4*)&Bt[n][1], 0, 1, 2, 3, 4, 5, 6, 7); \
        asm volatile("v_mfma_f32_16x16x128_f8f6f4 %0, %1, %2, %0" : "+v"(acc[ai][bj][m][n]) : "v"(b8_), "v"(a8_)); } __builtin_amdgcn_s_setprio(0); } while (0)
#define PG8_MMAI(ai, bj, At, Bt) do { __builtin_amdgcn_s_setprio(1); _Pragma("unroll") for (int k = 0; k < 2; ++k) _Pragma("unroll") for (int m = 0; m < 4; ++m) _Pragma("unroll") for (int n = 0; n < 2; ++n) \
        asm volatile("v_mfma_i32_16x16x64_i8 %0, %1, %2, %0" : "+v"(acc[ai][bj][m][n]) : "v"(*(const i32x4*)&Bt[n][k]), "v"(*(const i32x4*)&At[m][k])); __builtin_amdgcn_s_setprio(0); } while (0)
#define PG8_MMAX(ai, bj, At, Bt) do { if constexpr (F8 == 2) PG8_MMAI(ai, bj, At, Bt); else if constexpr (F8 == 1) PG8_MMA8(ai, bj, At, Bt); else PG8_MMA(ai, bj, At, Bt); } while (0)
#define PG8_WAIT_V(n) asm volatile("s_waitcnt vmcnt(" #n ")" ::: "memory")
#define PG8_WAIT_L(n) asm volatile("s_waitcnt lgkmcnt(" #n ")" ::: "memory")
#define PG8_BAR __builtin_amdgcn_s_barrier()
#define PG8_SCHED __builtin_amdgcn_sched_barrier(0)
    Unit cur, nxt; int ui = 0;
    if (!S.next(0, cur)) return;
    f32x4 acc[2][2][4][2];
#pragma unroll
    for (int a = 0; a < 2; ++a)
#pragma unroll
        for (int b = 0; b < 2; ++b)
#pragma unroll
            for (int m = 0; m < 4; ++m)
#pragma unroll
                for (int n = 0; n < 2; ++n) acc[a][b][m][n] = (f32x4){0.f, 0.f, 0.f, 0.f};
    bf16x8 At[4][2], B0[2][2], B1[2][2];
    const char* cA = (const char*)g.A + (size_t)cur.pm * tstep + g.agoff(cur.ag); const char* cB = (const char*)g.Bt + (size_t)cur.pn * tstep;
    S.a_ready(cur);
    if constexpr (SP2) {
        PG8_STAGE(PG8_SB(0, 0), cB, voffB); PG8_STAGE(PG8_SB(0, 1), cB + hstep, voffB); PG8_STAGE(PG8_SA(0, 0), cA, voffA); PG8_STAGE(PG8_SA(0, 1), cA + hstep, voffA);
        if (wr == 1) PG8_BAR;
        PG8_WAIT_V(2); PG8_BAR;
        PG8_STAGE(PG8_SB(1, 0), cB + kstep, voffB); PG8_STAGE(PG8_SA(1, 0), cA + kstep, voffA); PG8_STAGE(PG8_SB(1, 1), cB + hstep + kstep, voffB);
        PG8_WAIT_V(6); PG8_BAR;
    } else {
        PG8_STAGE(PG8_SB(0, 0), cB, voffB); PG8_STAGE(PG8_SA(0, 0), cA, voffA); PG8_STAGE(PG8_SB(0, 1), cB + hstep, voffB); PG8_STAGE(PG8_SA(0, 1), cA + hstep, voffA);
        if (wr == 1) PG8_BAR;
        PG8_WAIT_V(4); PG8_BAR;
        PG8_STAGE(PG8_SB(1, 0), cB + kstep, voffB); PG8_STAGE(PG8_SA(1, 0), cA + kstep, voffA); PG8_STAGE(PG8_SB(1, 1), cB + hstep + kstep, voffB);
        PG8_WAIT_V(6); PG8_BAR;
    }
    for (;;) {
        const bool has_next = S.next(ui + 1, nxt);
        const char* nA = has_next ? (const char*)g.A + (size_t)nxt.pm * tstep + g.agoff(nxt.ag) : cA; const char* nB = has_next ? (const char*)g.Bt + (size_t)nxt.pn * tstep : cB;
        for (int t = 0; t < nt; t += 2) {
            const bool last = (t == nt - 2);
            const char* a1 = cA + (size_t)(t + 1) * kstep;
            const char* a2 = last ? nA : cA + (size_t)(t + 2) * kstep; const char* b2 = last ? nB : cB + (size_t)(t + 2) * kstep;
            const char* a3 = a2 + kstep; const char* b3 = b2 + kstep;
            if (last && has_next) S.a_ready(nxt);
            if constexpr (SP2) {
            PG8_LDB(B0, 0, 0); PG8_LDB(B1, 0, 1); PG8_SCHED; PG8_LDA(At, 0, 0); PG8_STAGE(PG8_SA(1, 1), a1 + hstep, voffA);
            PG8_WAIT_V(8); PG8_WAIT_L(0); PG8_BAR; PG8_MMAX(0, 0, At, B0); PG8_MMAX(0, 1, At, B1); PG8_BAR; PG8_SCHED;
            PG8_LDA(At, 0, 1); PG8_STAGE(PG8_SB(0, 0), b2, voffB); PG8_STAGE(PG8_SB(0, 1), b2 + hstep, voffB); PG8_STAGE(PG8_SA(0, 0), a2, voffA);
            PG8_WAIT_V(8); PG8_WAIT_L(0); PG8_BAR; PG8_MMAX(1, 0, At, B0); PG8_MMAX(1, 1, At, B1); PG8_BAR; PG8_SCHED;
            PG8_LDB(B0, 1, 0); PG8_LDB(B1, 1, 1); PG8_SCHED; PG8_LDA(At, 1, 0); PG8_STAGE(PG8_SA(0, 1), a2 + hstep, voffA);
            PG8_WAIT_V(8); PG8_WAIT_L(0); PG8_BAR; PG8_MMAX(0, 0, At, B0); PG8_MMAX(0, 1, At, B1); PG8_BAR; PG8_SCHED;
            PG8_LDA(At, 1, 1); PG8_STAGE(PG8_SB(1, 0), b3, voffB); PG8_STAGE(PG8_SB(1, 1), b3 + hstep, voffB); PG8_STAGE(PG8_SA(1, 0), a3, voffA);
            PG8_WAIT_V(8); PG8_WAIT_L(0); PG8_BAR; PG8_MMAX(1, 0, At, B0); PG8_MMAX(1, 1, At, B1); PG8_BAR; PG8_SCHED;
            } else {
            PG8_LDB(B0, 0, 0); PG8_SCHED; PG8_LDA(At, 0, 0); PG8_STAGE(PG8_SA(1, 1), a1 + hstep, voffA);
            PG8_WAIT_L(8); PG8_BAR; PG8_WAIT_L(0); PG8_MMA(0, 0, At, B0); PG8_BAR; PG8_SCHED;
            PG8_LDB(B1, 0, 1); PG8_STAGE(PG8_SB(0, 0), b2, voffB);
            PG8_BAR; PG8_WAIT_L(0); PG8_MMA(0, 1, At, B1); PG8_BAR;
            PG8_LDA(At, 0, 1); PG8_STAGE(PG8_SA(0, 0), a2, voffA);
            PG8_BAR; PG8_WAIT_L(0); PG8_MMA(1, 0, At, B0); PG8_BAR; PG8_SCHED;
            PG8_STAGE(PG8_SB(0, 1), b2 + hstep, voffB);
            PG8_WAIT_V(6); PG8_BAR; PG8_MMA(1, 1, At, B1); PG8_BAR;
            PG8_LDB(B0, 1, 0); PG8_SCHED; PG8_LDA(At, 1, 0); PG8_STAGE(PG8_SA(0, 1), a2 + hstep, voffA);
            PG8_WAIT_L(8); PG8_BAR; PG8_WAIT_L(0); PG8_MMA(0, 0, At, B0); PG8_BAR; PG8_SCHED;
            PG8_LDB(B1, 1, 1); PG8_STAGE(PG8_SB(1, 0), b3, voffB);
            PG8_BAR; PG8_WAIT_L(0); PG8_MMA(0, 1, At, B1); PG8_BAR;
            PG8_LDA(At, 1, 1); PG8_STAGE(PG8_SA(1, 0), a3, voffA);
            PG8_BAR; PG8_WAIT_L(0); PG8_MMA(1, 0, At, B0); PG8_BAR; PG8_SCHED;
            PG8_STAGE(PG8_SB(1, 1), b3 + hstep, voffB);
            PG8_WAIT_V(6); PG8_BAR; PG8_MMA(1, 1, At, B1); PG8_BAR;
            }
        }
        if constexpr (F8 != 0) asm volatile("s_nop 15\n\ts_nop 15" ::: "memory");
        if constexpr (ALIGN_EPI) { if (wr == 0) PG8_BAR; }
        if constexpr (!Epi::AFTER_DRAIN) { E(acc, cur, wr, wc, fr, fq);
#if defined(DUPE)
            if constexpr (Epi::IDEMPOTENT) { asm volatile("" ::: "memory"); E(acc, cur, wr, wc, fr, fq); }
#endif
            S.done(cur); }
        if (!has_next) break;
#pragma unroll
        for (int a = 0; a < 2; ++a)
#pragma unroll
            for (int b = 0; b < 2; ++b)
#pragma unroll
                for (int m = 0; m < 4; ++m)
#pragma unroll
                    for (int n = 0; n < 2; ++n) acc[a][b][m][n] = (f32x4){0.f, 0.f, 0.f, 0.f};
        cur = nxt; cA = nA; cB = nB; ++ui;
        if constexpr (ALIGN_EPI) { if (wr == 1) PG8_BAR; }
    }
    PG8_WAIT_V(0);
    if constexpr (!ALIGN_EPI) { if (wr == 0) PG8_BAR; }
    PG8_BAR;
    if constexpr (Epi::AFTER_DRAIN) { E.fused(acc, cur, wr, wc, fr, fq, lds, wid, lane); S.done(cur); }
#undef PG8_SA
#undef PG8_SB
#undef PG8_STAGE
#undef PG8_LDA
#undef PG8_LDB
#undef PG8_MMA
#undef PG8_WAIT_V
#undef PG8_WAIT_L
#undef PG8_BAR
#undef PG8_SCHED
}
}
#define GAS __attribute__((address_space(1)))
#define LAS __attribute__((address_space(3)))
typedef unsigned short bf16;
typedef unsigned v4u __attribute__((ext_vector_type(4)));
typedef float f32x4 __attribute__((ext_vector_type(4)));
typedef short bf16x8 __attribute__((ext_vector_type(8)));
typedef GAS unsigned gu32;
typedef GAS unsigned long long gu64;
#define RLX_AGENT __ATOMIC_RELAXED, __HIP_MEMORY_SCOPE_AGENT
#define LDS_WAIT() asm volatile("s_waitcnt lgkmcnt(0)" ::: "memory")
#define VM_WAIT() asm volatile("s_waitcnt vmcnt(0)" ::: "memory")
__device__ __forceinline__ unsigned long long rt() { return __builtin_amdgcn_s_memrealtime(); }
__device__ __forceinline__ unsigned f2bf(float f) { unsigned u = __builtin_bit_cast(unsigned, f); return (u + 0x7fffu + ((u >> 16) & 1u)) >> 16; }
__device__ __forceinline__ unsigned pk2(float lo, float hi) { return f2bf(lo) | (f2bf(hi) << 16); }
__device__ __forceinline__ int lane_id() { return (int)__builtin_amdgcn_mbcnt_hi(~0u, __builtin_amdgcn_mbcnt_lo(~0u, 0u)); }
#define XB_TMO      128
#define XB_XCNT(j)  (256  + 64 * (j))
#define XB_XSUB(j)  (1280 + 64 * (j))
#define XB_XGEN(j)  (2304 + 64 * (j))
#define XB_TOP      3328
#define XB_TOPGEN   3392
#define XCD_BAR_WORDS 3456
#define XB_SPIN_CAP (1u << 18)

__device__ __forceinline__ unsigned xb_ld(unsigned* p)              { return __hip_atomic_load(p, __ATOMIC_RELAXED, __HIP_MEMORY_SCOPE_AGENT); }
__device__ __forceinline__ unsigned xb_add(unsigned* p, unsigned v) { return __hip_atomic_fetch_add(p, v, __ATOMIC_RELAXED, __HIP_MEMORY_SCOPE_AGENT); }
__device__ __forceinline__ unsigned xb_xcc_id() { return (unsigned)__builtin_amdgcn_s_getreg((3 << 11) | 20) & 0xFu; }
#define XB_SPIN(cond, bar) do { unsigned _sp = 0; while (cond) { __builtin_amdgcn_s_sleep(1); \
    if ((++_sp & 255u) == 0u) { if (xb_ld(&(bar)[XB_TMO])) break; if (_sp > XB_SPIN_CAP) { atomicAdd(&(bar)[XB_TMO], 1u); break; } } } } while (0)

struct XcdBarrier {
    unsigned* bar; unsigned x; unsigned w;
    volatile LAS unsigned* st;
};

__device__ __forceinline__ XcdBarrier xcd_barrier_post(unsigned* bar, volatile LAS unsigned* st) {
    XcdBarrier b; b.bar = bar; b.x = xb_xcc_id(); b.st = st; b.w = (unsigned)__builtin_amdgcn_readfirstlane((int)(threadIdx.x >> 6));
    if (threadIdx.x == 0) (void)xb_add(&bar[XB_XCNT(b.x)], 1u);
    return b;
}
__device__ __forceinline__ void xcd_barrier_complete(unsigned* bar, unsigned x, unsigned& nloc, unsigned& nx) {
    const unsigned G = gridDim.x * gridDim.y * gridDim.z;
    unsigned sum, cnt, mine, sp = 0u;
    for (;;) {
        sum = 0u; cnt = 0u; mine = 0u;
#pragma unroll
        for (unsigned j = 0; j < 16; ++j) { const unsigned c = xb_ld(&bar[XB_XCNT(j)]); sum += c; cnt += (c > 0u) ? 1u : 0u; mine = (j == x) ? c : mine; }
        if (sum == G) break;
        __builtin_amdgcn_s_sleep(1);
        if ((++sp & 255u) == 0u) { if (xb_ld(&bar[XB_TMO])) break; if (sp > XB_SPIN_CAP) { atomicAdd(&bar[XB_TMO], 1u); break; } }
    }
    nloc = mine > 0u ? mine : 1u; nx = cnt > 0u ? cnt : 1u;
}

__device__ __forceinline__ void xcd_barrier(const XcdBarrier& b) {
    asm volatile("s_waitcnt vmcnt(0)" ::: "memory");
    __syncthreads();
    if (b.w == 0u && lane_id() == 0) {
        unsigned* bar = b.bar;
        __builtin_amdgcn_s_waitcnt(0);
        unsigned nloc = b.st[0], nx = b.st[1];
        if (nloc == 0u) { xcd_barrier_complete(bar, b.x, nloc, nx); b.st[0] = nloc; b.st[1] = nx; }
        const unsigned old = xb_add(&bar[XB_XSUB(b.x)], 1u);
        const unsigned gen = old / nloc;
        if (old + 1u == (gen + 1u) * nloc) {
            __builtin_amdgcn_fence(__ATOMIC_RELEASE, "agent");
            asm volatile("s_waitcnt vmcnt(0)" ::: "memory");
            const unsigned og = xb_add(&bar[XB_TOP], 1u);
            const unsigned tg = og / nx;
            if (og + 1u == (tg + 1u) * nx) xb_add(&bar[XB_TOPGEN], 1u);
            else XB_SPIN(xb_ld(&bar[XB_TOPGEN]) == tg, bar);
            __builtin_amdgcn_fence(__ATOMIC_ACQUIRE, "agent");
            xb_add(&bar[XB_XGEN(b.x)], 1u);
            asm volatile("s_waitcnt vmcnt(0)" ::: "memory");
        } else {
            XB_SPIN(xb_ld(&bar[XB_XGEN(b.x)]) == gen, bar);
            __builtin_amdgcn_fence(__ATOMIC_ACQUIRE, "agent");
            asm volatile("s_waitcnt vmcnt(0)" ::: "memory");
        }
    }
    __syncthreads();
}
namespace att {
#ifndef FOX_HORIZON
#define FOX_HORIZON 30.f
#endif
#ifndef DSA_UNION
#define DSA_UNION 1
#endif
#ifndef DSA_CHECK
#define DSA_CHECK 0
#endif
#define DSA_DENSE_HOOK
#ifndef PRUNE_AT
#define PRUNE_AT 480
#endif
#ifndef DUPX
#define DUPX 0
#endif
#define ALAS __attribute__((address_space(3)))
typedef unsigned short bf16_t;
typedef short bf16x8 __attribute__((ext_vector_type(8)));
typedef short s16x4 __attribute__((ext_vector_type(4)));
typedef float f32x16 __attribute__((ext_vector_type(16)));
typedef float f32x4 __attribute__((ext_vector_type(4)));
typedef unsigned u32x4 __attribute__((ext_vector_type(4)));
typedef ALAS unsigned char lchar;
constexpr int S = 8192, NB = 4, LD = 1024, HD = 128;
constexpr int SHM_K = 16384, SHM_V = 16384;
constexpr float SCALE = 0.08838834764831845f, L2E = 1.4426950408889634f, LN2 = 0.6931471805599453f;
#define KSWZ(row, colB) ((row) * 256 + ((colB) ^ (((row) & 7) << 4)))
#define SBAR() __builtin_amdgcn_sched_barrier(0)
__device__ __forceinline__ int v_st(int k, int c) { const int kk = (k & ~0xC) | ((k & 4) << 1) | ((k & 8) >> 1); return ((kk >> 3) * 4 + (c >> 5)) * 512 + ((kk & 7) * 32 + (c & 31)) * 2; }
__device__ __forceinline__ int v_rd_base(int lane) { return ((lane & 3) << 3) | (((lane >> 2) & 3) << 6) | (((lane >> 4) & 1) << 5) | (((lane >> 5) & 1) << 8); }
constexpr int v_rd_off(int d0, int ks, int half) { return d0 * 512 + ks * 4096 + half * 2048; }
__device__ __forceinline__ int crow(int r, int hi) { return (r & 3) + 8 * (r >> 2) + 4 * hi; }
__device__ __forceinline__ unsigned cvtpk(float lo, float hi) { unsigned r; asm volatile("v_cvt_pk_bf16_f32 %0, %1, %2" : "=v"(r) : "v"(lo), "v"(hi)); return r; }
__device__ __forceinline__ float pair_sum(float v) { auto rr = __builtin_amdgcn_permlane32_swap(__float_as_uint(v), __float_as_uint(v), false, false); return __uint_as_float(rr[0]) + __uint_as_float(rr[1]); }
__device__ __forceinline__ float pair_max(float v) { auto rr = __builtin_amdgcn_permlane32_swap(__float_as_uint(v), __float_as_uint(v), false, false); return fmaxf(__uint_as_float(rr[0]), __uint_as_float(rr[1])); }
__device__ __forceinline__ void pair_sum_other(float v, int hi, float& sum, float& other) {
    auto rr = __builtin_amdgcn_permlane32_swap(__float_as_uint(v), __float_as_uint(v), false, false);
    const float a = __uint_as_float(rr[0]), b = __uint_as_float(rr[1]); sum = a + b; other = hi ? a : b;
}
#define ATT_PK4(P, B_, OUT) do { unsigned a0 = cvtpk(P[B_+0], P[B_+1]), a1 = cvtpk(P[B_+2], P[B_+3]);                          \
        unsigned b0 = cvtpk(P[B_+4], P[B_+5]), b1 = cvtpk(P[B_+6], P[B_+7]);                                             \
        auto r0 = __builtin_amdgcn_permlane32_swap(a0, b0, false, false); auto r1 = __builtin_amdgcn_permlane32_swap(a1, b1, false, false); \
        u32x4 w = {r0[0], r1[0], r0[1], r1[1]}; OUT = *reinterpret_cast<bf16x8*>(&w); } while (0)

__device__ __forceinline__ void qkt(f32x16& p0, f32x16& p1, const lchar* kt, int r32, int hi, const bf16x8* qr) {
    p0 = f32x16{}; p1 = f32x16{};
    const lchar* kb[4];
#pragma unroll
    for (int dd = 0; dd < 4; ++dd) kb[dd] = kt + KSWZ(r32, (dd * 16 + hi * 8) * 2);
    bf16x8 ka[2], kc[2];
    ka[0] = *reinterpret_cast<const ALAS bf16x8*>(kb[0]); ka[1] = *reinterpret_cast<const ALAS bf16x8*>(kb[0] + 32 * 256);
#pragma unroll
    for (int d0 = 0; d0 < 8; ++d0) {
        if (d0 < 7) { const lchar* a = kb[(d0 + 1) & 3] + ((d0 + 1) >> 2) * 128; kc[0] = *reinterpret_cast<const ALAS bf16x8*>(a); kc[1] = *reinterpret_cast<const ALAS bf16x8*>(a + 32 * 256); }
        SBAR();
        p0 = __builtin_amdgcn_mfma_f32_32x32x16_bf16(ka[0], qr[d0], p0, 0, 0, 0);
        p1 = __builtin_amdgcn_mfma_f32_32x32x16_bf16(ka[1], qr[d0], p1, 0, 0, 0);
        SBAR();
        ka[0] = kc[0]; ka[1] = kc[1]; }
}
#define ATT_TRRD(dst, off) asm volatile("ds_read_b64_tr_b16 %0, %1 offset:%2" : "=&v"(dst) : "v"(vb), "i"(off) : "memory")
__device__ __forceinline__ void pv64(f32x16* o, int vb, bf16x8 pa0, bf16x8 pa1, bf16x8 pa2, bf16x8 pa3) {
#define ATT_RD8(S, d0) do { constexpr int b_ = v_rd_off(d0, 0, 0); ATT_TRRD(S##l0, b_); ATT_TRRD(S##h0, b_ + 2048); ATT_TRRD(S##l1, b_ + 4096); ATT_TRRD(S##h1, b_ + 6144); \
        ATT_TRRD(S##l2, b_ + 8192); ATT_TRRD(S##h2, b_ + 10240); ATT_TRRD(S##l3, b_ + 12288); ATT_TRRD(S##h3, b_ + 14336); } while (0)
#define ATT_MM4(S, d0) do { \
        o[d0] = __builtin_amdgcn_mfma_f32_32x32x16_bf16(pa0, (bf16x8){S##l0[0], S##l0[1], S##l0[2], S##l0[3], S##h0[0], S##h0[1], S##h0[2], S##h0[3]}, o[d0], 0, 0, 0);   \
        o[d0] = __builtin_amdgcn_mfma_f32_32x32x16_bf16(pa1, (bf16x8){S##l1[0], S##l1[1], S##l1[2], S##l1[3], S##h1[0], S##h1[1], S##h1[2], S##h1[3]}, o[d0], 0, 0, 0);   \
        o[d0] = __builtin_amdgcn_mfma_f32_32x32x16_bf16(pa2, (bf16x8){S##l2[0], S##l2[1], S##l2[2], S##l2[3], S##h2[0], S##h2[1], S##h2[2], S##h2[3]}, o[d0], 0, 0, 0);   \
        o[d0] = __builtin_amdgcn_mfma_f32_32x32x16_bf16(pa3, (bf16x8){S##l3[0], S##l3[1], S##l3[2], S##l3[3], S##h3[0], S##h3[1], S##h3[2], S##h3[3]}, o[d0], 0, 0, 0); } while (0)
    s16x4 al0, al1, al2, al3, ah0, ah1, ah2, ah3, bl0, bl1, bl2, bl3, bh0, bh1, bh2, bh3, cl0, cl1, cl2, cl3, ch0, ch1, ch2, ch3, dl0, dl1, dl2, dl3, dh0, dh1, dh2, dh3;
    SBAR();
    ATT_RD8(a, 0); ATT_RD8(b, 1);
    asm volatile("s_waitcnt lgkmcnt(8)" ::: "memory"); SBAR(); ATT_MM4(a, 0); SBAR();
    ATT_RD8(c, 2);
    asm volatile("s_waitcnt lgkmcnt(8)" ::: "memory"); SBAR(); ATT_MM4(b, 1); SBAR();
    ATT_RD8(d, 3);
    asm volatile("s_waitcnt lgkmcnt(8)" ::: "memory"); SBAR(); ATT_MM4(c, 2); SBAR();
    asm volatile("s_waitcnt lgkmcnt(0)" ::: "memory"); SBAR(); ATT_MM4(d, 3);
#undef ATT_RD8
#undef ATT_MM4
}
__device__ __forceinline__ void pv32(f32x16* o, int vb, bf16x8 pa0, bf16x8 pa1) {
#define ATT_PV_D0(d0) do { s16x4 l0, l1, h0, h1; constexpr int b_ = v_rd_off(d0, 0, 0); \
        ATT_TRRD(l0, b_); ATT_TRRD(h0, b_ + 2048); ATT_TRRD(l1, b_ + 4096); ATT_TRRD(h1, b_ + 6144); \
        asm volatile("s_waitcnt lgkmcnt(0)" ::: "memory"); SBAR();   \
        o[d0] = __builtin_amdgcn_mfma_f32_32x32x16_bf16(pa0, (bf16x8){l0[0], l0[1], l0[2], l0[3], h0[0], h0[1], h0[2], h0[3]}, o[d0], 0, 0, 0);   \
        o[d0] = __builtin_amdgcn_mfma_f32_32x32x16_bf16(pa1, (bf16x8){l1[0], l1[1], l1[2], l1[3], h1[0], h1[1], h1[2], h1[3]}, o[d0], 0, 0, 0); } while (0)
    ATT_PV_D0(0); ATT_PV_D0(1); ATT_PV_D0(2); ATT_PV_D0(3);
#undef ATT_PV_D0
}

__device__ __forceinline__ float bfl(unsigned w) { return __uint_as_float(w << 16); }
__device__ __forceinline__ float bfh(unsigned w) { return __uint_as_float(w & 0xffff0000u); }
template <bool ROPE>
__device__ __forceinline__ void q_row_norm(bf16x8 (&q)[8], const float* g, const float* cs, const float* sn, int hi) {
    float x[8][8]; float s = 0.f;
#pragma unroll
    for (int d0 = 0; d0 < 8; ++d0) { const u32x4 w = *reinterpret_cast<const u32x4*>(&q[d0]);
        x[d0][0] = bfl(w[0]); x[d0][1] = bfh(w[0]); x[d0][2] = bfl(w[1]); x[d0][3] = bfh(w[1]); x[d0][4] = bfl(w[2]); x[d0][5] = bfh(w[2]); x[d0][6] = bfl(w[3]); x[d0][7] = bfh(w[3]);
#pragma unroll
        for (int j = 0; j < 8; ++j) s += x[d0][j] * x[d0][j]; }
    s = pair_sum(s);
    const float rs = 1.0f / sqrtf(s * (1.0f / 128.0f) + 1e-6f);
#pragma unroll
    for (int d0 = 0; d0 < 8; ++d0) { const float* gp = g + d0 * 16 + hi * 8; const f32x4 g0 = *(const f32x4*)gp, g1 = *(const f32x4*)(gp + 4);
#pragma unroll
        for (int j = 0; j < 4; ++j) { x[d0][j] = x[d0][j] * rs * g0[j]; x[d0][4 + j] = x[d0][4 + j] * rs * g1[j]; } }
    if (ROPE) {
#pragma unroll
        for (int d0 = 0; d0 < 4; ++d0) { const int i0 = d0 * 16 + hi * 8; const f32x4 c0 = *(const f32x4*)(cs + i0), c1 = *(const f32x4*)(cs + i0 + 4), s0 = *(const f32x4*)(sn + i0), s1 = *(const f32x4*)(sn + i0 + 4);
#pragma unroll
            for (int j = 0; j < 8; ++j) { const float cc = j < 4 ? c0[j & 3] : c1[j & 3], ss = j < 4 ? s0[j & 3] : s1[j & 3];
                const float a1 = x[d0][j] * cc - x[d0 + 4][j] * ss, a2 = x[d0 + 4][j] * cc + x[d0][j] * ss; x[d0][j] = a1; x[d0 + 4][j] = a2; } }
    }
#pragma unroll
    for (int d0 = 0; d0 < 8; ++d0) { u32x4 w = {cvtpk(x[d0][0], x[d0][1]), cvtpk(x[d0][2], x[d0][3]), cvtpk(x[d0][4], x[d0][5]), cvtpk(x[d0][6], x[d0][7])}; q[d0] = *reinterpret_cast<bf16x8*>(&w); }
}
__device__ __forceinline__ void idxq_rope(bf16x8 (&a)[4], const float* cs, const float* sn, int hi) {
#pragma unroll
    for (int ks = 0; ks < 2; ++ks) { const int i0 = ks * 16 + hi * 8; const f32x4 c0 = *(const f32x4*)(cs + i0), c1 = *(const f32x4*)(cs + i0 + 4), s0 = *(const f32x4*)(sn + i0), s1 = *(const f32x4*)(sn + i0 + 4);
        const u32x4 w1 = *reinterpret_cast<const u32x4*>(&a[ks]), w2 = *reinterpret_cast<const u32x4*>(&a[ks + 2]); float y1[8], y2[8];
#pragma unroll
        for (int j = 0; j < 8; ++j) { const float cc = j < 4 ? c0[j & 3] : c1[j & 3], ss = j < 4 ? s0[j & 3] : s1[j & 3];
            const float x1 = (j & 1) ? bfh(w1[j >> 1]) : bfl(w1[j >> 1]), x2 = (j & 1) ? bfh(w2[j >> 1]) : bfl(w2[j >> 1]);
            y1[j] = x1 * cc - x2 * ss; y2[j] = x2 * cc + x1 * ss; }
        u32x4 o1 = {cvtpk(y1[0], y1[1]), cvtpk(y1[2], y1[3]), cvtpk(y1[4], y1[5]), cvtpk(y1[6], y1[7])}, o2 = {cvtpk(y2[0], y2[1]), cvtpk(y2[2], y2[3]), cvtpk(y2[4], y2[5]), cvtpk(y2[6], y2[7])};
        a[ks] = *reinterpret_cast<bf16x8*>(&o1); a[ks + 2] = *reinterpret_cast<bf16x8*>(&o2); }
}

constexpr int A_OFF_V = 0, A_OFF_K = 32768, A_OFF_BIAS = 65536, A_OFF_WS = 66048, A_OFF_FLAG = 68096;
constexpr float SB_DONE = -40.0f;
template <int MODE>
__device__ __forceinline__ void dense_unit(lchar* lds, const bf16_t* Qb, const bf16_t* Kb, const bf16_t* Vb, bf16_t* Ob, const float* cl, const float* ctot, const float* gq, const float* gk, int b, int h, int qb, int wave_) {
    int tid_ = wave_ * 64 + (int)__builtin_amdgcn_mbcnt_hi(~0u, __builtin_amdgcn_mbcnt_lo(~0u, 0u)); asm volatile("" : "+v"(tid_));
    const int tid = tid_, wid = __builtin_amdgcn_readfirstlane(tid >> 6), lane = tid & 63, r32 = lane & 31, hi = lane >> 5;
    const int q0 = qb * 256, qlo = q0 + wid * 32;
    const size_t rowbase = (size_t)b * S;
    const int hc = h * HD;
    bf16x8 qr[8];
#pragma unroll
    for (int d0 = 0; d0 < 8; ++d0) qr[d0] = *(const bf16x8*)(Qb + (rowbase + qlo + r32) * LD + hc + d0 * 16 + hi * 8);
    if (MODE == 1) q_row_norm<false>(qr, gq, nullptr, nullptr, hi);
    const int sr = tid >> 4, sc = (tid & 15) * 8, vst0 = v_st(sr, sc), vst1 = v_st(32 + sr, sc), kws = KSWZ(sr, sc * 2);
    lchar* V_lds = lds + A_OFF_V; lchar* K_lds = lds + A_OFF_K;
    ALAS float* bias_l = (ALAS float*)(lds + A_OFF_BIAS);
    ALAS float* wsf = (ALAS float*)(lds + A_OFF_WS) + wid * 64;
    ALAS int* flags = (ALAS int*)(lds + A_OFF_FLAG);
    const int vb0 = (int)(unsigned)(size_t)V_lds + v_rd_base(lane);
    const float* clh = cl + (size_t)(b * 8 + h) * S; const float* cth = ctot + (b * 8 + h) * 64;
    const int jd = qb * 4 + 3;
    float dsum = 0.f, skip_thr = 0.f, mrow = 0.f, zh2 = 0.f, zrow = 0.f, xrow = -__builtin_inff(), vpost = -__builtin_inff(); int nact = 0;
    if (MODE == 1) { dsum = -cth[qb * 2];
        float a_ = fmaxf(fabsf(gq[lane]), fabsf(gq[lane + 64])), b_ = fmaxf(fabsf(gk[lane]), fabsf(gk[lane + 64]));
#pragma unroll
        for (int o_ = 32; o_ >= 1; o_ >>= 1) { a_ = fmaxf(a_, __shfl_xor(a_, o_)); b_ = fmaxf(b_, __shfl_xor(b_, o_)); }
        skip_thr = -(2.f * 11.3138f * a_ * b_ + FOX_HORIZON) * L2E;
        zh2 = FOX_HORIZON * L2E;
        {   float q2 = 0.f;
#pragma unroll
            for (int d0 = 0; d0 < 8; ++d0) { const u32x4 w = *reinterpret_cast<const u32x4*>(&qr[d0]);
#pragma unroll
                for (int j = 0; j < 4; ++j) { const float lo = bfl(w[j]), hh = bfh(w[j]); q2 += lo * lo + hh * hh; } }
            zrow = sqrtf(pair_sum(q2)) * b_ * L2E * 1.004f; }
        mrow = fminf(11.3138f * a_ * b_ * L2E, 50.f) + ((wid >= 4 ? -cth[qb * 2] : 0.f) - clh[qlo + r32]) * L2E; }
    bf16x8 st_k0, st_k1, st_v0, st_v1; float st_b = 0.f;
#define STAGE_LOAD(t_) do { const size_t r0_ = (rowbase + (size_t)(t_) * 64 + sr) * LD + hc + sc; \
        st_k0 = *(const bf16x8*)(Kb + r0_); st_k1 = *(const bf16x8*)(Kb + r0_ + (size_t)32 * LD); st_v0 = *(const bf16x8*)(Vb + r0_); st_v1 = *(const bf16x8*)(Vb + r0_ + (size_t)32 * LD); \
        if (MODE == 1 && tid < 64) st_b = (dsum - clh[(t_) * 64 + tid]) * L2E; } while (0)
#define STAGE_WRITE(bf_) do { *(ALAS bf16x8*)(K_lds + (bf_) * SHM_K + kws) = st_k0; *(ALAS bf16x8*)(K_lds + (bf_) * SHM_K + kws + 32 * 256) = st_k1; \
        *(ALAS bf16x8*)(V_lds + (bf_) * SHM_V + vst0) = st_v0; *(ALAS bf16x8*)(V_lds + (bf_) * SHM_V + vst1) = st_v1; \
        if (MODE == 1 && tid < 64) bias_l[(bf_) * 64 + tid] = st_b; } while (0)
    STAGE_LOAD(jd); STAGE_WRITE(0);
    { int z_ = 0; asm volatile("" : "+v"(z_));
      if (MODE == 1 && tid == 0) { flags[16] = z_; flags[17] = z_; }
      if (MODE == 0 && lane == 0) { flags[wid] = z_; flags[8 + wid] = z_; } }
    __syncthreads();
    float l_reg = 0.f, carry = 0.f; f32x16 o[4] = {};
    bool wdone = false;
    for (int t = jd, it = 0; ; --t, ++it) {
        const int buf = it & 1, k0 = t * 64;
        if (MODE == 0 && it > 0) { int alld = 1;
#pragma unroll
            for (int w = 0; w < 8; ++w) alld &= flags[((it - 1) & 1) * 8 + w];
            if (alld) break; }
        if (MODE == 1 && it > 0 && flags[16 + ((it - 1) & 1)]) break;
        const bool more = t > 0;
        if (more) { if (MODE == 1 && ((t - 1) & 1)) dsum += cth[(t - 1) >> 1]; STAGE_LOAD(t - 1); }
        const bool act = (MODE == 0) ? (k0 <= qlo + 30 && !wdone) : (k0 <= qlo + 31);
        if (act) {
            f32x16 p0, p1; bf16x8 pa0, pa1, pa2, pa3;
            qkt(p0, p1, K_lds + buf * SHM_K, r32, hi, qr);
            const int dq = qlo + r32 - k0 - 4 * hi;
            if (MODE == 0) {
                const bool nm = k0 + 63 >= qlo;
                f32x16 z0, z1;
#pragma unroll
                for (int r = 0; r < 16; ++r) { const int c = (r & 3) + 8 * (r >> 2);
                    float z = p0[r] * SCALE; float e = __builtin_amdgcn_exp2f(-fabsf(z) * L2E); float lk = -(fmaxf(z, 0.f) + LN2 * __builtin_amdgcn_logf(1.f + e));
                    if (nm && !(c < dq)) { lk = 0.f; z = -__builtin_inff(); } z0[r] = z; p0[r] = lk;
                    z = p1[r] * SCALE; e = __builtin_amdgcn_exp2f(-fabsf(z) * L2E); lk = -(fmaxf(z, 0.f) + LN2 * __builtin_amdgcn_logf(1.f + e));
                    if (nm && !(c + 32 < dq)) { lk = 0.f; z = -__builtin_inff(); } z1[r] = z; p1[r] = lk; }
                float U0[4], U1[4], O0[4], O1[4];
#pragma unroll
                for (int c4 = 0; c4 < 4; ++c4) { const int bq = 4 * c4;
                    p0[bq + 2] += p0[bq + 3]; p0[bq + 1] += p0[bq + 2]; p0[bq] += p0[bq + 1];
                    p1[bq + 2] += p1[bq + 3]; p1[bq + 1] += p1[bq + 2]; p1[bq] += p1[bq + 1];
                    pair_sum_other(p0[bq], hi, U0[c4], O0[c4]); pair_sum_other(p1[bq], hi, U1[c4], O1[c4]); }
                float W1[4], W0[4];
                W1[3] = carry; W1[2] = W1[3] + U1[3]; W1[1] = W1[2] + U1[2]; W1[0] = W1[1] + U1[1];
                W0[3] = W1[0] + U1[0]; W0[2] = W0[3] + U0[3]; W0[1] = W0[2] + U0[2]; W0[0] = W0[1] + U0[1];
                const float carry_new = W0[0] + U0[0];
#pragma unroll
                for (int c4 = 0; c4 < 4; ++c4) { const float f0 = W0[c4] + (hi ? 0.f : O0[c4]), f1 = W1[c4] + (hi ? 0.f : O1[c4]);
#pragma unroll
                    for (int e = 0; e < 4; ++e) { const int r = 4 * c4 + e;
                        p0[r] = __builtin_amdgcn_exp2f((z0[r] + (p0[r] + f0)) * L2E);
                        p1[r] = __builtin_amdgcn_exp2f((z1[r] + (p1[r] + f1)) * L2E); } }
                carry = carry_new;
                ATT_PK4(p0, 0, pa0); ATT_PK4(p0, 8, pa1); ATT_PK4(p1, 0, pa2); ATT_PK4(p1, 8, pa3);
                pv64(o, vb0 + buf * SHM_V, pa0, pa1, pa2, pa3);
                if (__all(carry < SB_DONE)) wdone = true;
            } else {
                constexpr float C2 = SCALE * L2E;
                const bool nm = k0 + 63 > qlo;
                const ALAS float* bl = bias_l + buf * 64 + 4 * hi;
#pragma unroll
                for (int c4 = 0; c4 < 4; ++c4) { const f32x4 b0 = *(const ALAS f32x4*)(bl + 8 * c4), b1 = *(const ALAS f32x4*)(bl + 32 + 8 * c4);
#pragma unroll
                    for (int e = 0; e < 4; ++e) { const int r = 4 * c4 + e, c = e + 8 * c4;
                        float x0 = fmaf(p0[r], C2, b0[e]) - mrow, x1 = fmaf(p1[r], C2, b1[e]) - mrow;
                        if (nm && !(c <= dq)) x0 = -__builtin_inff();
                        if (nm && !(c + 32 <= dq)) x1 = -__builtin_inff();
                        p0[r] = x0; p1[r] = x1; } }
                if (nact < 2) { float xm = -__builtin_inff();
#pragma unroll
                    for (int r = 0; r < 16; ++r) xm = fmaxf(xm, fmaxf(p0[r], p1[r]));
                    xrow = fmaxf(xrow, xm); ++nact;
                    if (nact == 2 || t == 0) { float v = pair_max(xrow) + mrow - zrow;
#pragma unroll
                        for (int o_ = 16; o_ >= 1; o_ >>= 1) v = fminf(v, __shfl_xor(v, o_));
                        vpost = v; } }
                float ps = 0.f;
#pragma unroll
                for (int r = 0; r < 16; ++r) { p0[r] = __builtin_amdgcn_exp2f(p0[r]); p1[r] = __builtin_amdgcn_exp2f(p1[r]); ps += p0[r] + p1[r]; }
                l_reg += pair_sum(ps);
                ATT_PK4(p0, 0, pa0); ATT_PK4(p0, 8, pa1); ATT_PK4(p1, 0, pa2); ATT_PK4(p1, 8, pa3);
                pv64(o, vb0 + buf * SHM_V, pa0, pa1, pa2, pa3);
            }
        }
        if (more) STAGE_WRITE(buf ^ 1);
        if (MODE == 0 && lane == 0) flags[(it & 1) * 8 + wid] = wdone ? 1 : 0;
        if (MODE == 1 && lane == 0) ((ALAS float*)flags)[20 + (it & 1) * 8 + wid] = vpost;
        if (MODE == 1 && tid == 63) { float gm = -__builtin_inff();
            if (it > 0) { gm = ((ALAS float*)flags)[20 + ((it - 1) & 1) * 8];
#pragma unroll
                for (int w = 1; w < 8; ++w) gm = fminf(gm, ((ALAS float*)flags)[20 + ((it - 1) & 1) * 8 + w]); }
            flags[16 + (it & 1)] = (more && st_b < fmaxf(skip_thr, gm - zh2)) ? 1 : 0; }
        __syncthreads();
        if (!more) break;
    }
#undef STAGE_LOAD
#undef STAGE_WRITE
    float rli[16];
    if (MODE == 1) { if (hi == 0) wsf[32 + r32] = l_reg; asm volatile("s_waitcnt lgkmcnt(0)" ::: "memory");
#pragma unroll
        for (int r = 0; r < 16; ++r) rli[r] = __builtin_amdgcn_rcpf(wsf[32 + crow(r, hi)]); }
    bf16_t* Ow = Ob + (rowbase + qlo) * LD + hc;
#pragma unroll
    for (int r = 0; r < 16; ++r) { const int orow = crow(r, hi);
#pragma unroll
        for (int d0 = 0; d0 < 4; ++d0) { float v = o[d0][r]; if (MODE == 1) v *= rli[r];
            const float vn = __shfl_xor(v, 1);
            if ((r32 & 1) == 0) *(unsigned*)(Ow + (size_t)orow * LD + d0 * 32 + r32) = cvtpk(v, vn); } }
    __syncthreads();
}

constexpr int D_OFF_CAND = 0, D_OFF_IK = 65536, D_IK_STAGE = 32768, D_OFF_WS = 132096;
__device__ __forceinline__ float relu_raw(float x) { const int b = __builtin_bit_cast(int, x); return __builtin_bit_cast(float, b > 0 ? b : 0); }
template <bool FULL>
__device__ __forceinline__ void topk_prune(ALAS unsigned* cand, int& cnt, unsigned& thr, int lane) {
    unsigned k[8]; unsigned mx = 0u;
#pragma unroll
    for (int j = 0; j < 8; ++j) { const int idx = lane + 64 * j; k[j] = idx < cnt ? cand[idx] : 0u; mx = k[j] > mx ? k[j] : mx; }
#define ATT_DPPMAX(ctrl, rmask) do { const unsigned t_ = (unsigned)__builtin_amdgcn_update_dpp((int)mx, (int)mx, ctrl, rmask, 0xF, false); mx = t_ > mx ? t_ : mx; } while (0)
    ATT_DPPMAX(0x121, 0xF); ATT_DPPMAX(0x122, 0xF); ATT_DPPMAX(0x124, 0xF); ATT_DPPMAX(0x128, 0xF);
    ATT_DPPMAX(0x142, 0xA); ATT_DPPMAX(0x143, 0xC);
#undef ATT_DPPMAX
    mx = (unsigned)__builtin_amdgcn_readlane((int)mx, 63);
    const int hb = 31 - __builtin_clz(mx ^ thr);
    unsigned T = hb == 31 ? 0u : ((thr >> (hb + 1)) << (hb + 1)); int cT = cnt;
    for (int bit = hb; bit >= 0; --bit) {
        if (FULL ? cT == 256 : cT <= 288) break;
        const unsigned Tc = T | (1u << bit); int c = 0;
#pragma unroll
        for (int j = 0; j < 8; ++j) c += __builtin_popcountll(__ballot(k[j] >= Tc));
        if (c >= 256) { T = Tc; cT = c; } }
    int base = 0;
#pragma unroll
    for (int j = 0; j < 8; ++j) { const bool keep = (lane + 64 * j < cnt) && k[j] >= T; const unsigned long long mk = __ballot(keep);
        const int pos = base + (int)__builtin_amdgcn_mbcnt_hi((unsigned)(mk >> 32), __builtin_amdgcn_mbcnt_lo((unsigned)mk, 0u));
        if (keep) cand[pos] = k[j]; base += __builtin_popcountll(mk); }
    cnt = base; thr = T ? T - 1u : 0u;
}
__device__ __forceinline__ void dsa_item(lchar* lds, const bf16_t* idxq, const bf16_t* idxk, const float* idxw, const bf16_t* dsaq, const bf16_t* dsakv, bf16_t* odsa, unsigned* dmask, unsigned* dscr, bf16_t* ochk, unsigned* chkflag, const float* gq, const float* gk, const float* tab, int b, int jt, int wave_) {
    int tid_ = wave_ * 64 + (int)__builtin_amdgcn_mbcnt_hi(~0u, __builtin_amdgcn_mbcnt_lo(~0u, 0u)); asm volatile("" : "+v"(tid_));
    const int tid = tid_, wid = __builtin_amdgcn_readfirstlane(tid >> 6), lane = tid & 63, c = lane & 31, hi = lane >> 5;
    const int t0 = jt * 32, qw = 4 * wid; const size_t tok0 = (size_t)b * S + t0;
    ALAS unsigned* candw = (ALAS unsigned*)(lds + D_OFF_CAND) + qw * 512;
    const int skk = tid >> 1, shalf = tid & 1;
    bf16x8 sg[4];
#define IK_LOAD(s_) do { const bf16_t* src_ = idxk + ((size_t)b * S + 256 * (s_) + skk) * 64 + shalf * 32; \
        _Pragma("unroll") for (int i_ = 0; i_ < 4; ++i_) sg[i_] = *(const bf16x8*)(src_ + 8 * i_); } while (0)
#define IK_WRITE(bf_) do { lchar* dst_ = lds + D_OFF_IK + (bf_) * D_IK_STAGE + skk * 128; \
        _Pragma("unroll") for (int i_ = 0; i_ < 4; ++i_) *(ALAS bf16x8*)(dst_ + (((shalf * 4 + i_) * 16) ^ ((skk & 7) << 4))) = sg[i_]; } while (0)
    IK_LOAD(0);
    bf16x8 A[2][4]; float wv[2][16];
#pragma unroll
    for (int mt = 0; mt < 2; ++mt) {
#pragma unroll
        for (int ks = 0; ks < 4; ++ks) A[mt][ks] = *(const bf16x8*)(idxq + (tok0 + qw + 2 * mt + (c >> 4)) * 1024 + (c & 15) * 64 + ks * 16 + hi * 8);
#pragma unroll
        for (int r = 0; r < 16; ++r) wv[mt][r] = idxw[(tok0 + qw + 2 * mt + (r >> 3)) * 16 + ((r & 3) + 8 * ((r >> 2) & 1) + 4 * hi)];
    }
#pragma unroll
    for (int mt = 0; mt < 2; ++mt) { const size_t tq_ = (size_t)(t0 + qw + 2 * mt + (c >> 4)); idxq_rope(A[mt], tab + (size_t)S * 128 + tq_ * 32, tab + (size_t)S * 160 + tq_ * 32, hi); }
    int cnt[4]; unsigned thr[4];
#ifndef REPI
#define REPI 1
#endif
#pragma unroll 1
    for (int repi = 0; repi < REPI; ++repi) {
    cnt[0] = cnt[1] = cnt[2] = cnt[3] = 0; thr[0] = thr[1] = thr[2] = thr[3] = 0u;
    const unsigned him = hi ? 0xFFFFFFFFu : 0u; const int cbase[2] = {(int)(unsigned)(size_t)(candw + hi * 512), (int)(unsigned)(size_t)(candw + (2 + hi) * 512)};
    unsigned thv[2] = {0u, 0u};
    const int nst = (t0 + 32 + 255) >> 8;
#pragma unroll
    for (int mt = 0; mt < 2; ++mt) {
#pragma unroll
        for (int ks = 0; ks < 4; ++ks) asm volatile("" :: "v"(A[mt][ks]));
#pragma unroll
        for (int r = 0; r < 16; ++r) asm volatile("" :: "v"(wv[mt][r])); }
    IK_WRITE(0);
    __syncthreads();
    for (int s = 0; s < nst; ++s) {
        const int buf = s & 1;
        if (s + 1 < nst) IK_LOAD(s + 1);
        const lchar* kb = lds + D_OFF_IK + buf * D_IK_STAGE;
        int jmax = ((t0 + qw + 3 - 256 * s) >> 5) + 1; jmax = jmax > 8 ? 8 : jmax;
#define IDX_LOADB(BX, j_) do { const int jj_ = (j_) < 7 ? (j_) : 7; _Pragma("unroll") for (int ks = 0; ks < 4; ++ks) BX[ks] = *(const ALAS bf16x8*)(kb + (32 * jj_ + c) * 128 + ((ks * 32 + hi * 16) ^ ((c & 7) << 4))); } while (0)
#define IDX_MMA(ACC, MT, BX) do { ACC = f32x16{}; _Pragma("unroll") for (int ks = 0; ks < 4; ++ks) ACC = __builtin_amdgcn_mfma_f32_32x32x16_bf16(A[MT][ks], BX[ks], ACC, 0, 0, 0); } while (0)
#define IDX_STEP(ACCN, MTN, BX, ACC, MT, key0_) do { const int key = (key0_) + c; const unsigned kinv = (unsigned)(8191 - key); \
            float sA = 0.f, sB = 0.f; \
            _Pragma("unroll") for (int ks = 0; ks < 4; ++ks) { SBAR(); \
                if (ks == 0) ACCN = __builtin_amdgcn_mfma_f32_32x32x16_bf16(A[MTN][0], BX[0], f32x16{}, 0, 0, 0); else ACCN = __builtin_amdgcn_mfma_f32_32x32x16_bf16(A[MTN][ks], BX[ks], ACCN, 0, 0, 0); \
                SBAR(); \
                _Pragma("unroll") for (int r = 2 * ks; r < 2 * ks + 2; ++r) { sA = fmaf(wv[MT][r], relu_raw(ACC[r]), sA); sB = fmaf(wv[MT][8 + r], relu_raw(ACC[8 + r]), sB); } } \
            SBAR(); \
            auto rr = __builtin_amdgcn_permlane32_swap(__float_as_uint(sA), __float_as_uint(sB), false, false); \
            const float score = __uint_as_float(rr[0]) + __uint_as_float(rr[1]);       \
            const int tq = t0 + qw + 2 * MT + hi; \
            unsigned u = __float_as_uint(score); u ^= (unsigned)((int)u >> 31) | 0x80000000u; \
            const unsigned pk = (u & 0xFFFFE000u) | kinv; \
            unsigned long long mk;                                                           \
            asm volatile("v_cmp_le_i32_e64 %0, %1, %2\n\tv_cmp_gt_u32_e64 vcc, %3, %4\n\ts_and_b64 %0, %0, vcc" : "=&s"(mk) : "v"(key), "v"(tq), "v"(pk), "v"(thv[MT]) : "vcc"); \
            const unsigned mlo = (unsigned)mk, mhi = (unsigned)(mk >> 32); \
            const int nlo = __builtin_popcount(mlo), nhi = __builtin_popcount(mhi); \
            const int below = (int)__builtin_amdgcn_mbcnt_hi(mhi, __builtin_amdgcn_mbcnt_lo(mlo, 0u));       \
            const int sdiff_ = cnt[2 * MT + 1] - nlo - cnt[2 * MT];                            \
            const int pos = (int)(him & (unsigned)sdiff_) + cnt[2 * MT] + below; \
            {   const int slot_ = cbase[MT] + 4 * pos; unsigned long long sv_;                   \
                asm volatile("s_and_saveexec_b64 %0, %1\n\tds_write_b32 %2, %3\n\ts_mov_b64 exec, %0" : "=&s"(sv_) : "s"(mk), "v"(slot_), "v"(pk) : "memory"); } \
            cnt[2 * MT] += nlo; cnt[2 * MT + 1] += nhi; } while (0)
#define IDX_PRUNE() do { if ((cnt[0] | cnt[1] | cnt[2] | cnt[3]) > 255) {             \
            _Pragma("unroll") for (int q = 0; q < 4; ++q) if (cnt[q] > PRUNE_AT) topk_prune<false>(candw + q * 512, cnt[q], thr[q], lane); \
            thv[0] = hi ? thr[1] : thr[0]; thv[1] = hi ? thr[3] : thr[2]; } } while (0)
        if (jmax > 0) {
            bf16x8 B0[4], B1[4]; f32x16 acc0, acc1;
            IDX_LOADB(B0, 0);
            IDX_MMA(acc0, 0, B0);
            for (int j = 0; j < jmax; j += 2) {
                IDX_PRUNE();
                IDX_LOADB(B1, j + 1);
                IDX_STEP(acc1, 1, B0, acc0, 0, 256 * s + 32 * j);
                IDX_STEP(acc0, 0, B1, acc1, 1, 256 * s + 32 * j);
                if (j + 1 >= jmax) break;
                IDX_PRUNE();
                IDX_LOADB(B0, j + 2);
                IDX_STEP(acc1, 1, B1, acc0, 0, 256 * s + 32 * (j + 1));
                IDX_STEP(acc0, 0, B0, acc1, 1, 256 * s + 32 * (j + 1));
            }
        }
#undef IDX_LOADB
#undef IDX_MMA
#undef IDX_STEP
#undef IDX_PRUNE
        if (s + 1 < nst) IK_WRITE(buf ^ 1);
        __syncthreads();
    }
    }
#undef IK_LOAD
#undef IK_WRITE
#pragma unroll
    for (int q = 0; q < 4; ++q) {
        if (cnt[q] > 256) topk_prune<true>(candw + q * 512, cnt[q], thr[q], lane);
        ALAS unsigned* cq = candw + q * 512; ALAS unsigned* mq = cq + 256;
        unsigned kk[4];
#pragma unroll
        for (int j = 0; j < 4; ++j) { const int idx = lane + 64 * j; kk[j] = idx < cnt[q] ? cq[idx] : 0xFFFFFFFFu; }
#pragma unroll
        for (int j = 0; j < 4; ++j) mq[lane + 64 * j] = 0u;
#pragma unroll
        for (int j = 0; j < 4; ++j) if (kk[j] != 0xFFFFFFFFu) { const unsigned key = 8191u - (kk[j] & 8191u); __hip_atomic_fetch_or(mq + (key >> 5), 1u << (key & 31u), __ATOMIC_RELAXED, __HIP_MEMORY_SCOPE_WORKGROUP); }
        asm volatile("s_waitcnt lgkmcnt(0)" ::: "memory");
#if !DSA_UNION || DSA_CHECK
#pragma unroll
        for (int j = 0; j < 4; ++j) dmask[(qw + q) * 256 + lane + 64 * j] = mq[lane + 64 * j];
#endif
    }
    asm volatile("s_waitcnt vmcnt(0) lgkmcnt(0)" ::: "memory");
    __syncthreads();
#if !DSA_UNION
    { bf16_t* odense = odsa;
    {
        const int g = wid >> 2, wq = wid & 3, qrow = wq * 8 + (c >> 2), head = g * 4 + (c & 3);
        float za_ = fmaxf(fabsf(gq[lane]), fabsf(gq[lane + 64])), zb_ = fmaxf(fabsf(gk[lane]), fabsf(gk[lane + 64]));
#pragma unroll
        for (int o_ = 32; o_ >= 1; o_ >>= 1) { za_ = fmaxf(za_, __shfl_xor(za_, o_)); zb_ = fmaxf(zb_, __shfl_xor(zb_, o_)); }
        const float nshift = -fminf(11.3138f * za_ * zb_ * L2E, 50.f);
        bf16x8 qr[8];
#pragma unroll
        for (int d0 = 0; d0 < 8; ++d0) qr[d0] = *(const bf16x8*)(dsaq + (tok0 + qrow) * 1024 + head * 128 + d0 * 16 + hi * 8);
        q_row_norm<true>(qr, gq, tab + (size_t)(t0 + qrow) * 64, tab + (size_t)S * 64 + (size_t)(t0 + qrow) * 64, hi);
        const unsigned long long* mrow = (const unsigned long long*)(dmask + qrow * 256);
        lchar* st0 = lds;
        const int sr = tid >> 4, sc = (tid & 15) * 8, vst0 = v_st(sr, sc), vst1 = v_st(32 + sr, sc), kws = KSWZ(sr, sc * 2);
        const int vb0 = (int)(unsigned)(size_t)(st0 + 32768 + g * 16384) + v_rd_base(lane);
        ALAS float* wsf = (ALAS float*)(lds + D_OFF_WS) + wid * 128;
        bf16x8 sg2[8];
#define KV_LOAD(t_) do { const bf16_t* src_ = dsakv + ((size_t)b * S + (size_t)(t_) * 64 + sr) * 512 + sc; \
        _Pragma("unroll") for (int i_ = 0; i_ < 4; ++i_) { sg2[2 * i_] = *(const bf16x8*)(src_ + i_ * 128); sg2[2 * i_ + 1] = *(const bf16x8*)(src_ + i_ * 128 + (size_t)32 * 512); } } while (0)
#define KV_WRITE(bf_) do { lchar* st = st0 + (bf_) * 65536; *(ALAS bf16x8*)(st + kws) = sg2[0]; *(ALAS bf16x8*)(st + kws + 32 * 256) = sg2[1]; *(ALAS bf16x8*)(st + 16384 + kws) = sg2[2]; *(ALAS bf16x8*)(st + 16384 + kws + 32 * 256) = sg2[3]; \
        *(ALAS bf16x8*)(st + 32768 + vst0) = sg2[4]; *(ALAS bf16x8*)(st + 32768 + vst1) = sg2[5]; *(ALAS bf16x8*)(st + 49152 + vst0) = sg2[6]; *(ALAS bf16x8*)(st + 49152 + vst1) = sg2[7]; } while (0)
        const int nt = (t0 + 32 + 63) >> 6;
        KV_LOAD(0); KV_WRITE(0);
        unsigned long long mw = __hip_atomic_load(mrow, __ATOMIC_RELAXED, __HIP_MEMORY_SCOPE_AGENT);
        __syncthreads();
        float l_reg = 0.f; f32x16 o[4] = {};
        constexpr float C2 = SCALE * L2E;
        for (int t = 0; t < nt; ++t) {
            const int buf = t & 1;
            const unsigned w0 = (unsigned)mw >> (4 * hi), w1 = (unsigned)(mw >> 32) >> (4 * hi);
            if (t + 1 < nt) { KV_LOAD(t + 1); mw = __hip_atomic_load(mrow + t + 1, __ATOMIC_RELAXED, __HIP_MEMORY_SCOPE_AGENT); }
            if (__any((w0 | w1) != 0u)) {
                f32x16 p0, p1; bf16x8 pa0, pa1, pa2, pa3;
                qkt(p0, p1, st0 + buf * 65536 + g * 16384, c, hi, qr);
                float ps = 0.f;
#pragma unroll
                for (int r = 0; r < 16; ++r) { const int bp = (r & 3) + 8 * (r >> 2);
                    const unsigned m0 = (unsigned)__builtin_amdgcn_sbfe((int)w0, bp, 1), m1 = (unsigned)__builtin_amdgcn_sbfe((int)w1, bp, 1);
                    const float x0 = __uint_as_float((__float_as_uint(fmaf(p0[r], C2, nshift)) & m0) | (0xFF800000u & ~m0)), x1 = __uint_as_float((__float_as_uint(fmaf(p1[r], C2, nshift)) & m1) | (0xFF800000u & ~m1));
                    p0[r] = __builtin_amdgcn_exp2f(x0); p1[r] = __builtin_amdgcn_exp2f(x1); ps += p0[r] + p1[r]; }
                l_reg += pair_sum(ps);
                ATT_PK4(p0, 0, pa0); ATT_PK4(p0, 8, pa1); ATT_PK4(p1, 0, pa2); ATT_PK4(p1, 8, pa3);
                pv64(o, vb0 + buf * 65536, pa0, pa1, pa2, pa3);
            }
            if (t + 1 < nt) KV_WRITE(buf ^ 1);
            __syncthreads();
        }
#undef KV_LOAD
#undef KV_WRITE
        if (hi == 0) wsf[32 + c] = l_reg;
        asm volatile("s_waitcnt lgkmcnt(0)" ::: "memory");
#pragma unroll
        for (int r = 0; r < 16; ++r) { const int orow = crow(r, hi); const float rl = __builtin_amdgcn_rcpf(wsf[32 + orow]);
            bf16_t* op = odense + (tok0 + wq * 8 + (orow >> 2)) * 1024 + (g * 4 + (orow & 3)) * 128;
#pragma unroll
            for (int d0 = 0; d0 < 4; ++d0) { const float v = o[d0][r] * rl; const float vn = __shfl_xor(v, 1);
                if ((c & 1) == 0) *(unsigned*)(op + d0 * 32 + c) = cvtpk(v, vn); } }
    }
    }
#endif

#if DSA_UNION
    {
        const int g = wid >> 2, wq = wid & 3, qrow = wq * 8 + (c >> 2), head = g * 4 + (c & 3);
        unsigned short* ul = (unsigned short*)(dscr + wid * 2048);
        unsigned* cm = dscr + wid * 2048 + 1152;
        ALAS unsigned short* ull = (ALAS unsigned short*)(lds + D_OFF_IK) + wid * 2176;
        const ALAS unsigned* mb = (const ALAS unsigned*)(lds + D_OFF_CAND) + (wq * 8) * 512 + 256;
        int nch;
        {
            unsigned U[4];
#pragma unroll
            for (int i = 0; i < 4; ++i) { unsigned u = 0u;
#pragma unroll
                for (int qq = 0; qq < 8; ++qq) u |= mb[qq * 512 + 4 * lane + i];
                U[i] = u; }
            const int n = __builtin_popcount(U[0]) + __builtin_popcount(U[1]) + __builtin_popcount(U[2]) + __builtin_popcount(U[3]);
            int incl = n;
#pragma unroll
            for (int d = 1; d < 64; d <<= 1) { const int t = __shfl_up(incl, d); if (lane >= d) incl += t; }
            int pos = incl - n; const int nU = __builtin_amdgcn_readlane(incl, 63);
#pragma unroll
            for (int i = 0; i < 4; ++i) { unsigned u = U[i];
                while (u) { const int bp = __builtin_ctz(u); const unsigned short kv = (unsigned short)((4 * lane + i) * 32 + bp); ul[pos] = kv; ull[pos] = kv; ++pos; u &= u - 1u; } }
            nch = (nU + 31) >> 5;
            if (lane < 32 && nU + lane < nch * 32) ul[nU + lane] = 0;
            asm volatile("s_waitcnt lgkmcnt(0)" ::: "memory");
            for (int c0 = 0; c0 < nch; c0 += 2) {
                const int ch = c0 + hi, j = ch * 32 + c; const bool valid = ch < nch && j < nU;
                const unsigned k = valid ? (unsigned)ull[valid ? j : 0] : 0u;
                unsigned mine = 0u;
#pragma unroll
                for (int qq = 0; qq < 8; ++qq) { const bool bit = valid && ((mb[qq * 512 + (k >> 5)] >> (k & 31u)) & 1u);
                    const unsigned long long mk = __ballot(bit);
                    const unsigned mv = hi ? (unsigned)(mk >> 32) : (unsigned)mk;
                    mine = (c == qq) ? mv : mine; }
                if (c < 8) cm[(c0 + hi) * 8 + c] = mine;
            }
        }
        asm volatile("s_waitcnt vmcnt(0) lgkmcnt(0)" ::: "memory");
        __syncthreads();
#if DSA_CHECK
        { bf16_t* odense = ochk;
    {
        const int g = wid >> 2, wq = wid & 3, qrow = wq * 8 + (c >> 2), head = g * 4 + (c & 3);
        float za_ = fmaxf(fabsf(gq[lane]), fabsf(gq[lane + 64])), zb_ = fmaxf(fabsf(gk[lane]), fabsf(gk[lane + 64]));
#pragma unroll
        for (int o_ = 32; o_ >= 1; o_ >>= 1) { za_ = fmaxf(za_, __shfl_xor(za_, o_)); zb_ = fmaxf(zb_, __shfl_xor(zb_, o_)); }
        const float nshift = -fminf(11.3138f * za_ * zb_ * L2E, 50.f);
        bf16x8 qr[8];
#pragma unroll
        for (int d0 = 0; d0 < 8; ++d0) qr[d0] = *(const bf16x8*)(dsaq + (tok0 + qrow) * 1024 + head * 128 + d0 * 16 + hi * 8);
        q_row_norm<true>(qr, gq, tab + (size_t)(t0 + qrow) * 64, tab + (size_t)S * 64 + (size_t)(t0 + qrow) * 64, hi);
        const unsigned long long* mrow = (const unsigned long long*)(dmask + qrow * 256);
        lchar* st0 = lds;
        const int sr = tid >> 4, sc = (tid & 15) * 8, vst0 = v_st(sr, sc), vst1 = v_st(32 + sr, sc), kws = KSWZ(sr, sc * 2);
        const int vb0 = (int)(unsigned)(size_t)(st0 + 32768 + g * 16384) + v_rd_base(lane);
        ALAS float* wsf = (ALAS float*)(lds + D_OFF_WS) + wid * 128;
        bf16x8 sg2[8];
#define KV_LOAD(t_) do { const bf16_t* src_ = dsakv + ((size_t)b * S + (size_t)(t_) * 64 + sr) * 512 + sc; \
        _Pragma("unroll") for (int i_ = 0; i_ < 4; ++i_) { sg2[2 * i_] = *(const bf16x8*)(src_ + i_ * 128); sg2[2 * i_ + 1] = *(const bf16x8*)(src_ + i_ * 128 + (size_t)32 * 512); } } while (0)
#define KV_WRITE(bf_) do { lchar* st = st0 + (bf_) * 65536; *(ALAS bf16x8*)(st + kws) = sg2[0]; *(ALAS bf16x8*)(st + kws + 32 * 256) = sg2[1]; *(ALAS bf16x8*)(st + 16384 + kws) = sg2[2]; *(ALAS bf16x8*)(st + 16384 + kws + 32 * 256) = sg2[3]; \
        *(ALAS bf16x8*)(st + 32768 + vst0) = sg2[4]; *(ALAS bf16x8*)(st + 32768 + vst1) = sg2[5]; *(ALAS bf16x8*)(st + 49152 + vst0) = sg2[6]; *(ALAS bf16x8*)(st + 49152 + vst1) = sg2[7]; } while (0)
        const int nt = (t0 + 32 + 63) >> 6;
        KV_LOAD(0); KV_WRITE(0);
        unsigned long long mw = __hip_atomic_load(mrow, __ATOMIC_RELAXED, __HIP_MEMORY_SCOPE_AGENT);
        __syncthreads();
        float l_reg = 0.f; f32x16 o[4] = {};
        constexpr float C2 = SCALE * L2E;
        for (int t = 0; t < nt; ++t) {
            const int buf = t & 1;
            const unsigned w0 = (unsigned)mw >> (4 * hi), w1 = (unsigned)(mw >> 32) >> (4 * hi);
            if (t + 1 < nt) { KV_LOAD(t + 1); mw = __hip_atomic_load(mrow + t + 1, __ATOMIC_RELAXED, __HIP_MEMORY_SCOPE_AGENT); }
            if (__any((w0 | w1) != 0u)) {
                f32x16 p0, p1; bf16x8 pa0, pa1, pa2, pa3;
                qkt(p0, p1, st0 + buf * 65536 + g * 16384, c, hi, qr);
                float ps = 0.f;
#pragma unroll
                for (int r = 0; r < 16; ++r) { const int bp = (r & 3) + 8 * (r >> 2);
                    const unsigned m0 = (unsigned)__builtin_amdgcn_sbfe((int)w0, bp, 1), m1 = (unsigned)__builtin_amdgcn_sbfe((int)w1, bp, 1);
                    const float x0 = __uint_as_float((__float_as_uint(fmaf(p0[r], C2, nshift)) & m0) | (0xFF800000u & ~m0)), x1 = __uint_as_float((__float_as_uint(fmaf(p1[r], C2, nshift)) & m1) | (0xFF800000u & ~m1));
                    p0[r] = __builtin_amdgcn_exp2f(x0); p1[r] = __builtin_amdgcn_exp2f(x1); ps += p0[r] + p1[r]; }
                l_reg += pair_sum(ps);
                ATT_PK4(p0, 0, pa0); ATT_PK4(p0, 8, pa1); ATT_PK4(p1, 0, pa2); ATT_PK4(p1, 8, pa3);
                pv64(o, vb0 + buf * 65536, pa0, pa1, pa2, pa3);
            }
            if (t + 1 < nt) KV_WRITE(buf ^ 1);
            __syncthreads();
        }
#undef KV_LOAD
#undef KV_WRITE
        if (hi == 0) wsf[32 + c] = l_reg;
        asm volatile("s_waitcnt lgkmcnt(0)" ::: "memory");
#pragma unroll
        for (int r = 0; r < 16; ++r) { const int orow = crow(r, hi); const float rl = __builtin_amdgcn_rcpf(wsf[32 + orow]);
            bf16_t* op = odense + (tok0 + wq * 8 + (orow >> 2)) * 1024 + (g * 4 + (orow & 3)) * 128;
#pragma unroll
            for (int d0 = 0; d0 < 4; ++d0) { const float v = o[d0][r] * rl; const float vn = __shfl_xor(v, 1);
                if ((c & 1) == 0) *(unsigned*)(op + d0 * 32 + c) = cvtpk(v, vn); } }
    }
        }
        __syncthreads();
#endif
#ifdef DUPU
#define UN_KMASK(x_) ((x_) & kmask_)
#pragma unroll 1
        for (int rep_ = 0; rep_ < 2; ++rep_) {
        const int kmask_ = rep_ == 0 ? (DUPU) : 0xFFFF; bf16_t* const oout_ = rep_ == 0 ? ochk : odsa;
#else
#define UN_KMASK(x_) (x_)
        { bf16_t* const oout_ = odsa;
#endif
        float za_ = fmaxf(fabsf(gq[lane]), fabsf(gq[lane + 64])), zb_ = fmaxf(fabsf(gk[lane]), fabsf(gk[lane + 64]));
#pragma unroll
        for (int o_ = 32; o_ >= 1; o_ >>= 1) { za_ = fmaxf(za_, __shfl_xor(za_, o_)); zb_ = fmaxf(zb_, __shfl_xor(zb_, o_)); }
        const float nshift = -fminf(11.3138f * za_ * zb_ * L2E, 50.f);
        bf16x8 qr[8];
#pragma unroll
        for (int d0 = 0; d0 < 8; ++d0) qr[d0] = *(const bf16x8*)(dsaq + (tok0 + qrow) * 1024 + head * 128 + d0 * 16 + hi * 8);
        q_row_norm<true>(qr, gq, tab + (size_t)(t0 + qrow) * 64, tab + (size_t)S * 64 + (size_t)(t0 + qrow) * 64, hi);
        lchar* kt = lds + wid * 16384; lchar* vt = kt + 8192;
        const int vb = (int)(unsigned)(size_t)vt + v_rd_base(lane);
        ALAS float* wsf = (ALAS float*)(lds + D_OFF_WS) + wid * 128;
        const int grow = lane >> 4, gpc = lane & 15;
        const bf16_t* kvb = dsakv + (size_t)b * S * 512 + g * 128 + gpc * 8;
        bf16x8 kx[8], vx[8];
        int idxv = __hip_atomic_load(ul + c, __ATOMIC_RELAXED, __HIP_MEMORY_SCOPE_AGENT);
#define UN_GATHER() do { _Pragma("unroll") for (int i_ = 0; i_ < 8; ++i_) { const int kr_ = UN_KMASK(__shfl(idxv, grow + 4 * i_)); const bf16_t* rp_ = kvb + (size_t)kr_ * 512; kx[i_] = *(const bf16x8*)rp_; vx[i_] = *(const bf16x8*)(rp_ + 256); } } while (0)
        UN_GATHER();
        if (nch > 1) idxv = __hip_atomic_load(ul + 32 + c, __ATOMIC_RELAXED, __HIP_MEMORY_SCOPE_AGENT);
        unsigned cw = __hip_atomic_load(cm + (c >> 2), __ATOMIC_RELAXED, __HIP_MEMORY_SCOPE_AGENT);
        float l_reg = 0.f; f32x16 o[4] = {};
        constexpr float C2 = SCALE * L2E;
#ifdef DSA_BREAK
        if (nch > 3) nch -= 1;
#endif
        for (int ch = 0; ch < nch; ++ch) {
#pragma unroll
            for (int i = 0; i < 8; ++i) { const int r = grow + 4 * i; *(ALAS bf16x8*)(kt + KSWZ(r, gpc * 16)) = kx[i]; *(ALAS bf16x8*)(vt + v_st(r, gpc * 8)) = vx[i]; }
            const unsigned w0 = cw >> (4 * hi);
            if (ch + 1 < nch) { UN_GATHER(); cw = __hip_atomic_load(cm + (ch + 1) * 8 + (c >> 2), __ATOMIC_RELAXED, __HIP_MEMORY_SCOPE_AGENT); if (ch + 2 < nch) idxv = __hip_atomic_load(ul + (ch + 2) * 32 + c, __ATOMIC_RELAXED, __HIP_MEMORY_SCOPE_AGENT); }
            asm volatile("s_waitcnt lgkmcnt(0)" ::: "memory");
            f32x16 p = {};
            {   const lchar* kb4[4];
#pragma unroll
                for (int dd = 0; dd < 4; ++dd) kb4[dd] = kt + KSWZ(c, (dd * 16 + hi * 8) * 2);
                bf16x8 ka = *reinterpret_cast<const ALAS bf16x8*>(kb4[0]), kc;
#pragma unroll
                for (int d0 = 0; d0 < 8; ++d0) {
                    if (d0 < 7) kc = *reinterpret_cast<const ALAS bf16x8*>(kb4[(d0 + 1) & 3] + ((d0 + 1) >> 2) * 128);
                    SBAR(); p = __builtin_amdgcn_mfma_f32_32x32x16_bf16(ka, qr[d0], p, 0, 0, 0); SBAR(); ka = kc; } }
            float ps = 0.f;
#pragma unroll
            for (int r = 0; r < 16; ++r) { const unsigned m0 = (unsigned)__builtin_amdgcn_sbfe((int)w0, (r & 3) + 8 * (r >> 2), 1);
                const float x0 = __uint_as_float((__float_as_uint(fmaf(p[r], C2, nshift)) & m0) | (0xFF800000u & ~m0));
                p[r] = __builtin_amdgcn_exp2f(x0); ps += p[r]; }
            l_reg += pair_sum(ps);
            bf16x8 pa0, pa1; ATT_PK4(p, 0, pa0); ATT_PK4(p, 8, pa1);
            pv32(o, vb, pa0, pa1);
        }
#undef UN_GATHER
#undef UN_KMASK
        if (hi == 0) wsf[32 + c] = l_reg;
        asm volatile("s_waitcnt lgkmcnt(0)" ::: "memory");
#pragma unroll
        for (int r = 0; r < 16; ++r) { const int orow = crow(r, hi); const float rl = __builtin_amdgcn_rcpf(wsf[32 + orow]);
            bf16_t* op = oout_ + (tok0 + wq * 8 + (orow >> 2)) * 1024 + (g * 4 + (orow & 3)) * 128;
#pragma unroll
            for (int d0 = 0; d0 < 4; ++d0) { const float v = o[d0][r] * rl; const float vn = __shfl_xor(v, 1);
                if ((c & 1) == 0) *(unsigned*)(op + d0 * 32 + c) = cvtpk(v, vn); } }
        }
#if DSA_CHECK
        asm volatile("s_waitcnt vmcnt(0)" ::: "memory");
        {
            float worst = 0.f;
            for (int e = lane; e < 8 * 512; e += 64) { const size_t off = (tok0 + wq * 8 + (e >> 9)) * 1024 + g * 512 + (e & 511);
                const unsigned short ua = __hip_atomic_load((unsigned short*)odsa + off, __ATOMIC_RELAXED, __HIP_MEMORY_SCOPE_AGENT), ub = __hip_atomic_load((unsigned short*)ochk + off, __ATOMIC_RELAXED, __HIP_MEMORY_SCOPE_AGENT);
                const float fa = __uint_as_float((unsigned)ua << 16), fb = __uint_as_float((unsigned)ub << 16); worst = fmaxf(worst, fabsf(fa - fb) - 0.02f * fabsf(fb)); }
            if (worst > 0.004f || !(worst == worst)) __hip_atomic_fetch_or(chkflag, 1u, __ATOMIC_RELAXED, __HIP_MEMORY_SCOPE_AGENT);
        }
#endif
    }
#endif
    __syncthreads();
}
#undef ALAS
}
#ifndef F8DOWN_INNER
#define F8DOWN_INNER 0
#endif
#ifndef F8DOWN_LAST
#define F8DOWN_LAST 1
#endif
#define F8DOWN(l) (((l) + 1 < DEPTH) ? (F8DOWN_INNER != 0) : (F8DOWN_LAST != 0))
#ifndef I8FFN
#define I8FFN 1
#endif
#ifndef I8BR
#define I8BR 1
#endif
#ifndef I8GATE
#define I8GATE 1
#endif
constexpr int NWAVES = 8;
constexpr int BATCH = 4, SEQ = 8192, DM = 2048, DEPTH = 2, M = BATCH * SEQ, DFF = 5632, NIN = 8960  ;
constexpr float NORM_EPS = 1e-6f;
constexpr size_t MiB = 1u << 20;
constexpr size_t WS_CTL = 0, CTL_ZERO_BYTES = 2 * MiB;
constexpr int CW_BAR = 4096, CW_QUEUE = 8192;
constexpr size_t WS_SS = 128 * 1024;
constexpr size_t WS_CMAX = 1536 * 1024;
constexpr size_t WS_CS8 = 1664 * 1024, WS_RS8 = 1792 * 1024;
constexpr size_t WS_CMAXG = 1408 * 1024, WS_CSG = 1472 * 1024;
constexpr size_t WS_CMAXB = 1920 * 1024, WS_CSB = 1968 * 1024;
constexpr size_t WS_TAB = 2 * MiB;
constexpr size_t WS_CL = 8 * MiB, WS_CTOT = 9 * MiB, WS_IDXK = 10 * MiB, WS_IDXW = 14 * MiB;
constexpr size_t WS_WIN = 16 * MiB, WS_WG = 51 * MiB, WS_WB = 75 * MiB, WS_WO = 87 * MiB, WS_WGU = 95 * MiB, WS_WD = 139 * MiB;
constexpr size_t WS_XB = 161 * MiB;
constexpr size_t WS_PROJ = 289 * MiB, SEG_BYTES = 64 * MiB;
constexpr size_t WS_DSAKV = WS_PROJ + 8 * SEG_BYTES, WS_SMALL = WS_DSAKV + 32 * MiB, WS_END = WS_SMALL + 32 * MiB;
constexpr size_t WS_DMASK = WS_SMALL + 32 * MiB;
static_assert(WS_END == 865 * MiB && WS_DMASK == WS_END, "d_ws map");
constexpr size_t WS_DSCR = WS_DMASK + 8 * MiB;
constexpr size_t WS_H8 = WS_DSCR + 16 * MiB;
constexpr size_t WS_TOTAL = WS_H8 + 64 * MiB;
constexpr size_t WS_OB8 = WS_TOTAL, WS_OB8_2 = WS_WIN, WS_RSB = 8 * MiB;
constexpr size_t WS_RSG = WS_TOTAL + 64 * MiB;
constexpr size_t WS_DUMMY = WS_TOTAL;
constexpr int LDS_BYTES = 147456, RING_BYTES = 131072, MISC_OFF = RING_BYTES + 320;

__device__ __forceinline__ float wave_sum(float v) {
#pragma unroll
    for (int o = 1; o < 64; o <<= 1) v += __shfl_xor(v, o);
    return v;
}
__device__ __forceinline__ void cvt_item(const float* W, int ldw, int srccol, const float* gain, bf16* dstrow0, int K, int k0, LAS float* scr, int lane, float emu8 = 0.f) {
    const float* wp = W + (size_t)(k0 + (lane >> 5)) * ldw + (srccol >= 0 ? srccol : 0);
#pragma unroll
    for (int h = 0; h < 2; ++h) { float v[16];
#pragma unroll
        for (int i = 0; i < 16; ++i) v[i] = wp[(size_t)(2 * (16 * h + i)) * ldw];
#pragma unroll
        for (int i = 0; i < 16; ++i) scr[(2 * (16 * h + i) + (lane >> 5)) * 33 + (lane & 31)] = (srccol >= 0) ? v[i] : 0.f; }
    LDS_WAIT(); asm volatile("" ::: "memory");
    const int c = lane & 7;
    f32x4 g0 = {1.f, 1.f, 1.f, 1.f}, g1 = g0;
    if (gain) { g0 = *(const GAS f32x4*)(gain + k0 + 8 * c); g1 = *(const GAS f32x4*)(gain + k0 + 8 * c + 4); }
#pragma unroll
    for (int j = 0; j < 4; ++j) { const int n = (lane >> 3) + 8 * j; const LAS float* s = scr + (8 * c) * 33 + n;
        float q_[8] = {s[0 * 33] * g0.x, s[1 * 33] * g0.y, s[2 * 33] * g0.z, s[3 * 33] * g0.w, s[4 * 33] * g1.x, s[5 * 33] * g1.y, s[6 * 33] * g1.z, s[7 * 33] * g1.w};
        if (emu8 != 0.f) {
#pragma unroll
            for (int i_ = 0; i_ < 8; ++i_) { const float v_ = fminf(fmaxf(q_[i_] * emu8, -448.f), 448.f); const int w_ = __builtin_amdgcn_cvt_pk_fp8_f32(v_, v_, 0, false); q_[i_] = __builtin_amdgcn_cvt_f32_fp8(w_, 0) / emu8; } }
        v4u o; o.x = pk2(q_[0], q_[1]); o.y = pk2(q_[2], q_[3]); o.z = pk2(q_[4], q_[5]); o.w = pk2(q_[6], q_[7]);
        *(GAS v4u*)(dstrow0 + (size_t)n * K + k0 + 8 * c) = o; }
    LDS_WAIT(); asm volatile("" ::: "memory");
}
__device__ __forceinline__ unsigned pk4_fp8(float a, float b, float c, float d) {
    a = fminf(fmaxf(a, -448.f), 448.f); b = fminf(fmaxf(b, -448.f), 448.f); c = fminf(fmaxf(c, -448.f), 448.f); d = fminf(fmaxf(d, -448.f), 448.f);
    int w = __builtin_amdgcn_cvt_pk_fp8_f32(a, b, 0, false); w = __builtin_amdgcn_cvt_pk_fp8_f32(c, d, w, true); return (unsigned)w;
}
__device__ __forceinline__ void cvt_item8(const float* W, int ldw, int srccol, const float* gain, unsigned char* dstrow0, int K, int k0, LAS float* scr, int lane) {
    const float* wp = W + (size_t)(k0 + (lane >> 5)) * ldw + srccol;
#pragma unroll
    for (int h = 0; h < 2; ++h) { float v[16];
#pragma unroll
        for (int i = 0; i < 16; ++i) v[i] = wp[(size_t)(2 * (16 * h + i)) * ldw];
#pragma unroll
        for (int i = 0; i < 16; ++i) scr[(2 * (16 * h + i) + (lane >> 5)) * 33 + (lane & 31)] = v[i]; }
    LDS_WAIT(); asm volatile("" ::: "memory");
    const int c = lane & 7;
    f32x4 g0 = {256.f, 256.f, 256.f, 256.f}, g1 = g0;
    if (gain) { g0 = *(const GAS f32x4*)(gain + k0 + 8 * c) * 256.f; g1 = *(const GAS f32x4*)(gain + k0 + 8 * c + 4) * 256.f; }
#pragma unroll
    for (int j = 0; j < 4; ++j) { const int n = (lane >> 3) + 8 * j; const LAS float* s = scr + (8 * c) * 33 + n;
        typedef unsigned v2u_ __attribute__((ext_vector_type(2)));
        const v2u_ o = {pk4_fp8(s[0 * 33] * g0.x, s[1 * 33] * g0.y, s[2 * 33] * g0.z, s[3 * 33] * g0.w), pk4_fp8(s[4 * 33] * g1.x, s[5 * 33] * g1.y, s[6 * 33] * g1.z, s[7 * 33] * g1.w)};
        *(GAS v2u_*)(dstrow0 + (size_t)n * K + k0 + 8 * c) = o; }
    LDS_WAIT(); asm volatile("" ::: "memory");
}
__device__ __forceinline__ void colmax_item(const float* W, int ldw, int srccol, const float* gain, unsigned* cmaxrow0, int k0, int lane) {
    const int hi = lane >> 5; const float* wp = W + (size_t)(k0 + hi) * ldw + srccol; float m = 0.f;
#pragma unroll
    for (int h = 0; h < 2; ++h) { float v[16], g[16];
#pragma unroll
        for (int i = 0; i < 16; ++i) { v[i] = wp[(size_t)(2 * (16 * h + i)) * ldw]; g[i] = gain ? gain[k0 + 2 * (16 * h + i) + hi] : 1.0f; }
#pragma unroll
        for (int i = 0; i < 16; ++i) m = fmaxf(m, fabsf(v[i] * g[i])); }
    { auto rr = __builtin_amdgcn_permlane32_swap(__float_as_uint(m), __float_as_uint(m), false, false); m = fmaxf(__uint_as_float(rr[0]), __uint_as_float(rr[1])); }
    if (hi == 0) atomicMax(cmaxrow0 + (lane & 31), __float_as_uint(m));
}
__device__ __forceinline__ unsigned q8byte(float x, float scale) { return __float_as_uint(fmaf(x, scale, 12582912.f)) & 255u; }
__device__ __forceinline__ unsigned pk4_i8(float a, float b, float c, float d, float s) { return q8byte(a, s) | (q8byte(b, s) << 8) | (q8byte(c, s) << 16) | (q8byte(d, s) << 24); }
__device__ __forceinline__ void cvt_item_i8(const float* W, int ldw, int srccol, const float* gain, const unsigned* cmaxrow0, float* cs8row0, unsigned char* dstrow0, int K, int k0, LAS float* scr, int lane) {
    const float* wp = W + (size_t)(k0 + (lane >> 5)) * ldw + srccol;
#pragma unroll
    for (int h = 0; h < 2; ++h) { float v[16];
#pragma unroll
        for (int i = 0; i < 16; ++i) v[i] = wp[(size_t)(2 * (16 * h + i)) * ldw];
#pragma unroll
        for (int i = 0; i < 16; ++i) scr[(2 * (16 * h + i) + (lane >> 5)) * 33 + (lane & 31)] = v[i]; }
    LDS_WAIT(); asm volatile("" ::: "memory");
    const int c = lane & 7;
    f32x4 g0 = {1.f, 1.f, 1.f, 1.f}, g1 = g0;
    if (gain) { g0 = *(const GAS f32x4*)(gain + k0 + 8 * c); g1 = *(const GAS f32x4*)(gain + k0 + 8 * c + 4); }
#pragma unroll
    for (int j = 0; j < 4; ++j) { const int n = (lane >> 3) + 8 * j; const LAS float* s = scr + (8 * c) * 33 + n;
        const float mx = __uint_as_float(cmaxrow0[n]), sc = mx > 0.f ? 127.f / mx : 0.f;
        if (k0 == 0 && c == 0) cs8row0[n] = mx * (1.0f / 127.f);
        typedef unsigned v2u_ __attribute__((ext_vector_type(2)));
        const v2u_ o = {pk4_i8(s[0 * 33] * g0.x, s[1 * 33] * g0.y, s[2 * 33] * g0.z, s[3 * 33] * g0.w, sc), pk4_i8(s[4 * 33] * g1.x, s[5 * 33] * g1.y, s[6 * 33] * g1.z, s[7 * 33] * g1.w, sc)};
        *(GAS v2u_*)(dstrow0 + (size_t)n * K + k0 + 8 * c) = o; }
    LDS_WAIT(); asm volatile("" ::: "memory");
}
__device__ __forceinline__ int win_srccol(int n) {
    if (n < 6144) return n;
    if (n < 7168) return 6152 + (n - 6144);
    if (n < 8192) return 7688 + (n - 7168);
    if (n < 8704) return 7176 + (n - 8192);
    if (n < 8768) return 8712 + (n - 8704);
    if (n < 8784) return 8776 + (n - 8768);
    if (n < 8792) return 6144 + (n - 8784);
    return -1;
}
struct Args { const float* in[15]; float* out; unsigned char* ws; };
typedef __attribute__((address_space(4))) const Args CArgs;

__device__ __forceinline__ void p0_prologue(CArgs& a, int l, LAS unsigned char* lds, int vcu, int NGW, int wave) {
    int lane = lane_id(); asm volatile("" : "+v"(lane)); const int gw = vcu * NWAVES + wave;
    unsigned char* ws = a.ws;
    LAS float* scr = (LAS float*)(lds + wave * 16384);
    const float* g_mix = a.in[1] + (size_t)l * DM; const float* g_ffn = a.in[11] + (size_t)l * DM;
    constexpr int I0 = (NIN / 32) * (DM / 64), I1 = (6144 / 32) * (DM / 64), I2 = (6144 / 32) * (1024 / 64), I3 = (DM / 32) * (DM / 64), I4 = (2 * DFF / 32) * (DM / 64), I5 = (DM / 32) * (DFF / 64);
    constexpr int NITEMS = I0 + I1 + I2 + I3 + I4 + I5;
    for (int it = gw; it < NITEMS; it += NGW) {
        int r = it;
        if (r < I0) { const int nblk = NIN / 32, kb = r / nblk, nb = r % nblk, n0 = nb * 32;
            cvt_item(a.in[2] + (size_t)l * DM * 8792, 8792, win_srccol(n0 + (lane & 31)), g_mix, (bf16*)(ws + WS_WIN) + (size_t)n0 * DM, DM, kb * 64, scr, lane); continue; } r -= I0;
        if (r < I1) { const int nblk = 6144 / 32, kb = r / nblk, nb = r % nblk, n0 = nb * 32, g = n0 >> 11;
            if (I8GATE) colmax_item(a.in[8] + (size_t)(l * 3 + g) * DM * DM, DM, (n0 & 2047) + (lane & 31), g_mix, (unsigned*)(ws + WS_CMAXG) + (size_t)l * 6144 + n0, kb * 64, lane);
            else cvt_item8(a.in[8] + (size_t)(l * 3 + g) * DM * DM, DM, (n0 & 2047) + (lane & 31), g_mix, ws + WS_WG + (size_t)n0 * DM, DM, kb * 64, scr, lane);
            continue; } r -= I1;
        if (r < I2) { const int nblk = 6144 / 32, kb = r / nblk, nb = r % nblk, n0 = nb * 32, g = n0 >> 11;
            if (I8BR) colmax_item(a.in[9] + (size_t)(l * 3 + g) * 1024 * DM, DM, (n0 & 2047) + (lane & 31), nullptr, (unsigned*)(ws + WS_CMAXB) + (size_t)l * 6144 + n0, kb * 64, lane);
            else cvt_item(a.in[9] + (size_t)(l * 3 + g) * 1024 * DM, DM, (n0 & 2047) + (lane & 31), nullptr, (bf16*)(ws + WS_WB) + (size_t)n0 * 1024, 1024, kb * 64, scr, lane);
            continue; } r -= I2;
        if (r < I3) { const int nblk = DM / 32, kb = r / nblk, nb = r % nblk, n0 = nb * 32;
            cvt_item(a.in[10] + (size_t)l * DM * DM, DM, n0 + (lane & 31), nullptr, (bf16*)(ws + WS_WO) + (size_t)n0 * DM, DM, kb * 64, scr, lane); continue; } r -= I3;
        if (r < I4) { const int nblk = 2 * DFF / 32, kb = r / nblk, nb = r % nblk, n0 = nb * 32, pn = n0 >> 8, w = n0 & 255;
            const float* src = (w < 128 ? a.in[12] : a.in[13]) + (size_t)l * DM * DFF;
            if (I8FFN) colmax_item(src, DFF, pn * 128 + (w & 127) + (lane & 31), g_ffn, (unsigned*)(ws + WS_CMAX) + (size_t)l * 2 * DFF + n0, kb * 64, lane);
            else cvt_item(src, DFF, pn * 128 + (w & 127) + (lane & 31), g_ffn, (bf16*)(ws + WS_WGU) + (size_t)n0 * DM, DM, kb * 64, scr, lane);
            continue; } r -= I4;
        { const int nblk = DM / 32, kb = r / nblk, nb = r % nblk, n0 = nb * 32;
            if (F8DOWN(l)) cvt_item8(a.in[14] + (size_t)l * DFF * DM, DM, n0 + (lane & 31), nullptr, ws + WS_WD + (size_t)n0 * DFF, DFF, kb * 64, scr, lane);
            else cvt_item(a.in[14] + (size_t)l * DFF * DM, DM, n0 + (lane & 31), nullptr, (bf16*)(ws + WS_WD) + (size_t)n0 * DFF, DFF, kb * 64, scr, lane); }
    }
    if (l == 0) {
        const float* x = a.in[0]; bf16* xb = (bf16*)(ws + WS_XB); pg8::ssq_t* ss0 = (pg8::ssq_t*)(ws + WS_SS);
        if (gw < M) {
            f32x4 v[8], w[8];
            { const GAS f32x4* xr = (const GAS f32x4*)(x + (size_t)gw * DM) + lane;
#pragma unroll
              for (int j = 0; j < 8; ++j) v[j] = xr[64 * j]; }
#pragma unroll 1
            for (int m = gw; m < M; m += NGW) {
                const bool more = m + NGW < M;
                if (more) { const GAS f32x4* xn = (const GAS f32x4*)(x + (size_t)(m + NGW) * DM) + lane;
#pragma unroll
                    for (int j = 0; j < 8; ++j) w[j] = xn[64 * j]; }
                GAS unsigned long long* o8 = (GAS unsigned long long*)(xb + (size_t)m * DM) + lane; float s = 0.f;
#pragma unroll
                for (int j = 0; j < 8; ++j) s += (v[j].x * v[j].x + v[j].y * v[j].y) + (v[j].z * v[j].z + v[j].w * v[j].w);
#pragma unroll
                for (int j = 0; j < 8; ++j) o8[64 * j] = (unsigned long long)pk2(v[j].x, v[j].y) | ((unsigned long long)pk2(v[j].z, v[j].w) << 32);
                s = wave_sum(s);
                if (lane == 0) ss0[m] = pg8::ssq_of(s);
#pragma unroll
                for (int j = 0; j < 8; ++j) v[j] = w[j];
            }
        }
        float* cos_h = (float*)(ws + WS_TAB); float* sin_h = cos_h + SEQ * 64; float* cos_i = sin_h + SEQ * 64; float* sin_i = cos_i + SEQ * 32;
        for (int idx = gw * 64 + lane; idx < SEQ * 96; idx += NGW * 64) {
            const int t = idx / 96, j = idx - t * 96;
            if (j < 64) { const float inv = 1.0f / powf(10000.0f, (float)(2 * j) / 128.0f), ang = (float)t * inv; cos_h[t * 64 + j] = cosf(ang); sin_h[t * 64 + j] = sinf(ang); }
            else { const int jj = j - 64; const float inv = 1.0f / powf(10000.0f, (float)(2 * jj) / 64.0f), ang = (float)t * inv; cos_i[t * 32 + jj] = cosf(ang); sin_i[t * 32 + jj] = sinf(ang); }
        }
    }
}

__device__ __forceinline__ void unpack8(v4u w, float* f) { f[0] = __uint_as_float(w.x << 16); f[1] = __uint_as_float(w.x & 0xffff0000u); f[2] = __uint_as_float(w.y << 16); f[3] = __uint_as_float(w.y & 0xffff0000u);
    f[4] = __uint_as_float(w.z << 16); f[5] = __uint_as_float(w.z & 0xffff0000u); f[6] = __uint_as_float(w.w << 16); f[7] = __uint_as_float(w.w & 0xffff0000u); }
__device__ __forceinline__ v4u pack8f(const float* f) { v4u o; o.x = pk2(f[0], f[1]); o.y = pk2(f[2], f[3]); o.z = pk2(f[4], f[5]); o.w = pk2(f[6], f[7]); return o; }
template <bool ROPE>
__device__ __forceinline__ void norm_row128(bf16* rowp, int nheads, const float* g, const float* cs, const float* sn, int lane) {
    const int head = lane >> 3, j = lane & 7, hh = head < nheads ? head : 0;
    bf16* p = rowp + hh * 128 + j * 8;
    float x1[8], x2[8]; unpack8(*(const GAS v4u*)p, x1); unpack8(*(const GAS v4u*)(p + 64), x2);
    float s = 0.f;
#pragma unroll
    for (int e = 0; e < 8; ++e) s += x1[e] * x1[e] + x2[e] * x2[e];
    s += __shfl_xor(s, 1); s += __shfl_xor(s, 2); s += __shfl_xor(s, 4);
    const float rs = 1.0f / sqrtf(s * (1.0f / 128.0f) + NORM_EPS);
#pragma unroll
    for (int e = 0; e < 8; ++e) { x1[e] = x1[e] * rs * g[e]; x2[e] = x2[e] * rs * g[8 + e]; }
    if (ROPE) {
        float c[8], sv[8]; *(f32x4*)c = *(const GAS f32x4*)(cs + j * 8); *(f32x4*)(c + 4) = *(const GAS f32x4*)(cs + j * 8 + 4); *(f32x4*)sv = *(const GAS f32x4*)(sn + j * 8); *(f32x4*)(sv + 4) = *(const GAS f32x4*)(sn + j * 8 + 4);
#pragma unroll
        for (int e = 0; e < 8; ++e) { const float a1 = x1[e] * c[e] - x2[e] * sv[e], a2 = x2[e] * c[e] + x1[e] * sv[e]; x1[e] = a1; x2[e] = a2; }
    }
    if (head < nheads) { *(GAS v4u*)p = pack8f(x1); *(GAS v4u*)(p + 64) = pack8f(x2); }
}
__device__ __forceinline__ void p3b_quant(CArgs& a, int l, LAS unsigned char* lds, int vcu, int NGW, int wave) {
    int lane = lane_id(); asm volatile("" : "+v"(lane)); const int gw = vcu * NWAVES + wave;
    unsigned char* ws = a.ws;
    {   float* rsb = (float*)(ws + WS_RSB);
        auto rowsrc = [&](int rr) { const int g = rr >> 15, m = rr & (M - 1); return (const bf16*)(ws + WS_PROJ) + (size_t)g * 3 * pg8::SEG_ELEMS + (size_t)m * 1024 + lane * 16; };
        auto rowdst = [&](int rr) { const int g = rr >> 15, m = rr & (M - 1); return ws + (g == 2 ? WS_OB8_2 : WS_OB8 + (size_t)g * 32 * MiB) + (size_t)m * 1024 + lane * 16; };
        const int r0 = gw * 48;
        v4u ra[4][2], rb[4][2];
#pragma unroll
        for (int j = 0; j < 4; ++j) { const bf16* p = rowsrc(r0 + j); ra[j][0] = *(const GAS v4u*)p; ra[j][1] = *(const GAS v4u*)(p + 8); }
        auto emit = [&](const v4u (&r)[4][2], int rr0) {
#pragma unroll
            for (int j = 0; j < 4; ++j) { float x[2][8]; unpack8(r[j][0], x[0]); unpack8(r[j][1], x[1]); float mx = 0.f;
#pragma unroll
                for (int e = 0; e < 8; ++e) mx = fmaxf(mx, fmaxf(fabsf(x[0][e]), fabsf(x[1][e])));
                {   unsigned um = __float_as_uint(mx);
#define FR_DPPMAX(ctrl, rmask) do { const unsigned t_ = (unsigned)__builtin_amdgcn_update_dpp((int)um, (int)um, ctrl, rmask, 0xF, false); um = t_ > um ? t_ : um; } while (0)
                    FR_DPPMAX(0x121, 0xF); FR_DPPMAX(0x122, 0xF); FR_DPPMAX(0x124, 0xF); FR_DPPMAX(0x128, 0xF); FR_DPPMAX(0x142, 0xA); FR_DPPMAX(0x143, 0xC);
#undef FR_DPPMAX
                    mx = __uint_as_float((unsigned)__builtin_amdgcn_readlane((int)um, 63)); }
                const float sc = mx > 0.f ? 127.f / mx : 0.f;
                if (lane == 0) rsb[rr0 + j] = mx * (1.0f / 127.f);
                v4u o; o.x = pk4_i8(x[0][0], x[0][1], x[0][2], x[0][3], sc); o.y = pk4_i8(x[0][4], x[0][5], x[0][6], x[0][7], sc); o.z = pk4_i8(x[1][0], x[1][1], x[1][2], x[1][3], sc); o.w = pk4_i8(x[1][4], x[1][5], x[1][6], x[1][7], sc);
                *(GAS v4u*)rowdst(rr0 + j) = o; } };
#pragma unroll 1
        for (int tt = 0; tt < 48; tt += 8) {
#pragma unroll
            for (int j = 0; j < 4; ++j) { const bf16* p = rowsrc(r0 + tt + 4 + j); rb[j][0] = *(const GAS v4u*)p; rb[j][1] = *(const GAS v4u*)(p + 8); }
            emit(ra, r0 + tt);
            if (tt + 8 < 48) {
#pragma unroll
                for (int j = 0; j < 4; ++j) { const bf16* p = rowsrc(r0 + tt + 8 + j); ra[j][0] = *(const GAS v4u*)p; ra[j][1] = *(const GAS v4u*)(p + 8); } }
            emit(rb, r0 + tt + 4); } }
}
__device__ __forceinline__ void p5b_quant(CArgs& a, int l, LAS unsigned char* lds, int vcu, int NGW, int wave) {
    int lane = lane_id(); asm volatile("" : "+v"(lane)); const int gw = vcu * NWAVES + wave;
    unsigned char* ws = a.ws;
    {   const bf16* xbp = (const bf16*)(ws + WS_XB); unsigned char* x8 = ws + WS_H8; float* rs8 = (float*)(ws + WS_RS8);
        const size_t m0 = (size_t)gw * 16;
        v4u ra[4], rb[4];
#pragma unroll
        for (int i = 0; i < 4; ++i) ra[i] = *(const GAS v4u*)(xbp + m0 * DM + i * 512 + lane * 8);
        auto emit = [&](const v4u (&r)[4], size_t m) {
            float x[4][8]; float mx = 0.f;
#pragma unroll
            for (int i = 0; i < 4; ++i) { unpack8(r[i], x[i]);
#pragma unroll
                for (int e = 0; e < 8; ++e) mx = fmaxf(mx, fabsf(x[i][e])); }
            {   unsigned um = __float_as_uint(mx);
#define FR_DPPMAX(ctrl, rmask) do { const unsigned t_ = (unsigned)__builtin_amdgcn_update_dpp((int)um, (int)um, ctrl, rmask, 0xF, false); um = t_ > um ? t_ : um; } while (0)
                FR_DPPMAX(0x121, 0xF); FR_DPPMAX(0x122, 0xF); FR_DPPMAX(0x124, 0xF); FR_DPPMAX(0x128, 0xF); FR_DPPMAX(0x142, 0xA); FR_DPPMAX(0x143, 0xC);
#undef FR_DPPMAX
                mx = __uint_as_float((unsigned)__builtin_amdgcn_readlane((int)um, 63)); }
            const float sc = mx > 0.f ? 127.f / mx : 0.f;
            if (lane == 0) rs8[m] = mx * (1.0f / 127.f);
#pragma unroll
            for (int i = 0; i < 4; ++i) { typedef unsigned v2u_ __attribute__((ext_vector_type(2)));
                const v2u_ o = {pk4_i8(x[i][0], x[i][1], x[i][2], x[i][3], sc), pk4_i8(x[i][4], x[i][5], x[i][6], x[i][7], sc)};
                *(GAS v2u_*)(x8 + m * DM + i * 512 + lane * 8) = o; } };
#pragma unroll 1
        for (int tt = 0; tt < 16; tt += 2) {
#pragma unroll
            for (int i = 0; i < 4; ++i) rb[i] = *(const GAS v4u*)(xbp + (m0 + tt + 1) * DM + i * 512 + lane * 8);
            emit(ra, m0 + tt);
            if (tt + 2 < 16) {
#pragma unroll
                for (int i = 0; i < 4; ++i) ra[i] = *(const GAS v4u*)(xbp + (m0 + tt + 2) * DM + i * 512 + lane * 8); }
            emit(rb, m0 + tt + 1); } }
}
__device__ __forceinline__ void p2_post(CArgs& a, int l, LAS unsigned char* lds, int wave) {
    int lane = lane_id(); asm volatile("" : "+v"(lane));
    unsigned char* ws = a.ws;
    const int chunk = blockIdx.x;
    bf16* proj = (bf16*)(ws + WS_PROJ); bf16* dsakv = (bf16*)(ws + WS_DSAKV); const float* small = (const float*)(ws + WS_SMALL);
    bf16* idxk = (bf16*)(ws + WS_IDXK); float* idxw = (float*)(ws + WS_IDXW);
    const float* cos_h = (const float*)(ws + WS_TAB); const float* sin_h = cos_h + SEQ * 64; const float* cos_i = sin_h + SEQ * 64; const float* sin_i = cos_i + SEQ * 32;
    LAS float* lf = (LAS float*)lds;
    const int j = lane & 7;
    float gfk[16], gdk[16];
#pragma unroll
    for (int e = 0; e < 8; ++e) { gfk[e] = a.in[5][l * 128 + j * 8 + e]; gfk[8 + e] = a.in[5][l * 128 + 64 + j * 8 + e]; gdk[e] = a.in[7][l * 128 + j * 8 + e]; gdk[8 + e] = a.in[7][l * 128 + 64 + j * 8 + e]; }
    const float fbias = a.in[3][l * 8 + (lane & 7)];
    struct P2Tok { v4u fk1, fk2, dk1, dk2; f32x4 dc0, dc1, ds0, ds1, ik1, ik2, ic, is; float w, g; };
    const int head = lane >> 3;
    auto tok_load = [&](P2Tok& T, int tt) {
        const size_t m = (size_t)chunk * 128 + wave * 16 + tt; const int t = (int)(m & (SEQ - 1));
        const bf16* pf = proj + 4 * SEG_BYTES / 2 + m * 1024 + head * 128 + j * 8; T.fk1 = *(const GAS v4u*)pf; T.fk2 = *(const GAS v4u*)(pf + 64);
        const bf16* pd = dsakv + m * 512 + (head < 2 ? head : 0) * 128 + j * 8; T.dk1 = *(const GAS v4u*)pd; T.dk2 = *(const GAS v4u*)(pd + 64);
        const float* cs = cos_h + t * 64 + j * 8; const float* sn = sin_h + t * 64 + j * 8; T.dc0 = *(const GAS f32x4*)cs; T.dc1 = *(const GAS f32x4*)(cs + 4); T.ds0 = *(const GAS f32x4*)sn; T.ds1 = *(const GAS f32x4*)(sn + 4);
        if (lane < 8) { const float* sp = small + m * 256 + j * 4; T.ik1 = *(const GAS f32x4*)sp; T.ik2 = *(const GAS f32x4*)(sp + 32); T.ic = *(const GAS f32x4*)(cos_i + t * 32 + j * 4); T.is = *(const GAS f32x4*)(sin_i + t * 32 + j * 4); }
        if (lane < 16) T.w = small[m * 256 + 64 + lane];
        if (lane < 8) T.g = small[m * 256 + 80 + lane];
    };
    auto row_norm = [&](v4u a1, v4u a2, const float* g, float* x1, float* x2) {
        unpack8(a1, x1); unpack8(a2, x2); float s = 0.f;
#pragma unroll
        for (int e = 0; e < 8; ++e) s += x1[e] * x1[e] + x2[e] * x2[e];
        s += __shfl_xor(s, 1); s += __shfl_xor(s, 2); s += __shfl_xor(s, 4);
        const float rs = 1.0f / sqrtf(s * (1.0f / 128.0f) + NORM_EPS);
#pragma unroll
        for (int e = 0; e < 8; ++e) { x1[e] = x1[e] * rs * g[e]; x2[e] = x2[e] * rs * g[8 + e]; }
    };
    auto tok_finish = [&](const P2Tok& T, int tt) {
        const int tokl = wave * 16 + tt; const size_t m = (size_t)chunk * 128 + tokl;
        {   float x1[8], x2[8]; row_norm(T.fk1, T.fk2, gfk, x1, x2);
            bf16* pf = proj + 4 * SEG_BYTES / 2 + m * 1024 + head * 128 + j * 8; *(GAS v4u*)pf = pack8f(x1); *(GAS v4u*)(pf + 64) = pack8f(x2); }
        {   float x1[8], x2[8], c[8], sv[8]; row_norm(T.dk1, T.dk2, gdk, x1, x2);
            *(f32x4*)c = T.dc0; *(f32x4*)(c + 4) = T.dc1; *(f32x4*)sv = T.ds0; *(f32x4*)(sv + 4) = T.ds1;
#pragma unroll
            for (int e = 0; e < 8; ++e) { const float a1 = x1[e] * c[e] - x2[e] * sv[e], a2 = x2[e] * c[e] + x1[e] * sv[e]; x1[e] = a1; x2[e] = a2; }
            if (head < 2) { bf16* pd = dsakv + m * 512 + head * 128 + j * 8; *(GAS v4u*)pd = pack8f(x1); *(GAS v4u*)(pd + 64) = pack8f(x2); } }
        if (lane < 8) {
            float a1[4], a2[4];
#pragma unroll
            for (int e = 0; e < 4; ++e) { a1[e] = T.ik1[e] * T.ic[e] - T.ik2[e] * T.is[e]; a2[e] = T.ik2[e] * T.ic[e] + T.ik1[e] * T.is[e]; }
            typedef unsigned v2u_ __attribute__((ext_vector_type(2)));
            const v2u_ o1 = {pk2(a1[0], a1[1]), pk2(a1[2], a1[3])}, o2 = {pk2(a2[0], a2[1]), pk2(a2[2], a2[3])};
            *(GAS v2u_*)(idxk + m * 64 + j * 4) = o1; *(GAS v2u_*)(idxk + m * 64 + 32 + j * 4) = o2;
        }
        if (lane < 16) idxw[m * 16 + lane] = T.w * 0.03125f;
        if (lane < 8) { const float v = T.g + fbias; lf[tokl * 8 + lane] = fminf(v, 0.f) - log1pf(expf(-fabsf(v))); }
    };
    {   P2Tok Ta, Tb; tok_load(Ta, 0);
#pragma unroll 1
        for (int tt = 0; tt < 16; tt += 2) { tok_load(Tb, tt + 1); tok_finish(Ta, tt); if (tt + 2 < 16) tok_load(Ta, tt + 2); tok_finish(Tb, tt + 1); } }
    {
        const bf16* xbp = (const bf16*)(ws + WS_XB); unsigned char* h8 = ws + WS_H8; const pg8::ssq_t* ssm = (const pg8::ssq_t*)(ws + WS_SS) + (size_t)(2 * l) * M;
        const size_t m0 = (size_t)chunk * 128 + wave * 16;
        v4u ra[4], rb[4]; float sa = (float)ssm[m0] * pg8::SSQI, sb = 0.f;
#pragma unroll
        for (int i = 0; i < 4; ++i) ra[i] = *(const GAS v4u*)(xbp + m0 * DM + i * 512 + lane * 8);
#if I8GATE
        auto emit = [&](const v4u (&r)[4], float ssv, size_t m) {
            float x[4][8]; float mx = 0.f;
#pragma unroll
            for (int i = 0; i < 4; ++i) { unpack8(r[i], x[i]);
#pragma unroll
                for (int e = 0; e < 8; ++e) mx = fmaxf(mx, fabsf(x[i][e])); }
            {   unsigned um = __float_as_uint(mx);
#define FR_DPPMAX(ctrl, rmask) do { const unsigned t_ = (unsigned)__builtin_amdgcn_update_dpp((int)um, (int)um, ctrl, rmask, 0xF, false); um = t_ > um ? t_ : um; } while (0)
                FR_DPPMAX(0x121, 0xF); FR_DPPMAX(0x122, 0xF); FR_DPPMAX(0x124, 0xF); FR_DPPMAX(0x128, 0xF); FR_DPPMAX(0x142, 0xA); FR_DPPMAX(0x143, 0xC);
#undef FR_DPPMAX
                mx = __uint_as_float((unsigned)__builtin_amdgcn_readlane((int)um, 63)); }
            const float sc = mx > 0.f ? 127.f / mx : 0.f;
            if (lane == 0) ((float*)(ws + WS_RSG))[m] = mx * (1.0f / 127.f) * __builtin_amdgcn_rsqf(ssv * (1.0f / DM) + 1e-6f);
#pragma unroll
            for (int i = 0; i < 4; ++i) { typedef unsigned v2u_ __attribute__((ext_vector_type(2)));
                const v2u_ o = {pk4_i8(x[i][0], x[i][1], x[i][2], x[i][3], sc), pk4_i8(x[i][4], x[i][5], x[i][6], x[i][7], sc)};
                *(GAS v2u_*)(h8 + m * DM + i * 512 + lane * 8) = o; } };
#else
        auto emit = [&](const v4u (&r)[4], float ssv, size_t m) {
            const float rs = __builtin_amdgcn_rsqf(ssv * (1.0f / DM) + 1e-6f) * 8.f;
#pragma unroll
            for (int i = 0; i < 4; ++i) { float x[8]; unpack8(r[i], x);
                typedef unsigned v2u_ __attribute__((ext_vector_type(2)));
                const v2u_ o = {pk4_fp8(x[0] * rs, x[1] * rs, x[2] * rs, x[3] * rs), pk4_fp8(x[4] * rs, x[5] * rs, x[6] * rs, x[7] * rs)};
                *(GAS v2u_*)(h8 + m * DM + i * 512 + lane * 8) = o; } };
#endif
#pragma unroll 1
        for (int tt = 0; tt < 16; tt += 2) {
#pragma unroll
            for (int i = 0; i < 4; ++i) rb[i] = *(const GAS v4u*)(xbp + (m0 + tt + 1) * DM + i * 512 + lane * 8);
            sb = (float)ssm[m0 + tt + 1] * pg8::SSQI;
            emit(ra, sa, m0 + tt);
            if (tt + 2 < 16) {
#pragma unroll
                for (int i = 0; i < 4; ++i) ra[i] = *(const GAS v4u*)(xbp + (m0 + tt + 2) * DM + i * 512 + lane * 8);
                sa = (float)ssm[m0 + tt + 2] * pg8::SSQI; }
            emit(rb, sb, m0 + tt + 1); }
    }
    LDS_WAIT(); __syncthreads();
    if (wave == 0) {
        const int head = lane & 7, sub = lane >> 3; float v[16]; float run = 0.f;
#pragma unroll
        for (int i = 0; i < 16; ++i) { run += lf[(sub * 16 + i) * 8 + head]; v[i] = run; }
        float inc = run;
        { const float u = __shfl_up(inc, 8); if (lane >= 8) inc += u; } { const float u = __shfl_up(inc, 16); if (lane >= 16) inc += u; } { const float u = __shfl_up(inc, 32); if (lane >= 32) inc += u; }
        const float excl = inc - run; const int b = chunk >> 6, ch = chunk & 63;
        float* cl = (float*)(ws + WS_CL) + (size_t)(b * 8 + head) * SEQ + ch * 128 + sub * 16;
#pragma unroll
        for (int i = 0; i < 16; ++i) cl[i] = v[i] + excl;
        if (sub == 7) ((float*)(ws + WS_CTOT))[(b * 8 + head) * 64 + ch] = inc;
    }
    __syncthreads();
}
__device__ __forceinline__ void wq_items(CArgs& a, int l, LAS unsigned char* lds, int vcu, int NGW, int wave) {
    int lane = lane_id(); asm volatile("" : "+v"(lane)); const int gw = vcu * NWAVES + wave;
    unsigned char* ws = a.ws;
    if (I8BR)
    {   LAS float* scr = (LAS float*)(lds + wave * 16384);
        constexpr int I2 = (6144 / 32) * (1024 / 64);
        for (int r = gw; r < I2; r += NGW) { const int nblk = 6144 / 32, kb = r / nblk, nb = r % nblk, n0 = nb * 32, g = n0 >> 11;
            cvt_item_i8(a.in[9] + (size_t)(l * 3 + g) * 1024 * DM, DM, (n0 & 2047) + (lane & 31), nullptr, (const unsigned*)(ws + WS_CMAXB) + (size_t)l * 6144 + n0, (float*)(ws + WS_CSB) + n0, ws + WS_WB + (size_t)n0 * 1024, 1024, kb * 64, scr, lane); }
        if (I8GATE) { constexpr int I1 = (6144 / 32) * (DM / 64); const float* g_mix = a.in[1] + (size_t)l * DM;
            for (int r = gw; r < I1; r += NGW) { const int nblk = 6144 / 32, kb = r / nblk, nb = r % nblk, n0 = nb * 32, g = n0 >> 11;
                cvt_item_i8(a.in[8] + (size_t)(l * 3 + g) * DM * DM, DM, (n0 & 2047) + (lane & 31), g_mix, (const unsigned*)(ws + WS_CMAXG) + (size_t)l * 6144 + n0, (float*)(ws + WS_CSG) + n0, ws + WS_WG + (size_t)n0 * DM, DM, kb * 64, scr, lane); } } }
    if (I8FFN)
    {   LAS float* scr = (LAS float*)(lds + wave * 16384); const float* g_ffn = a.in[11] + (size_t)l * DM;
        constexpr int I4 = (2 * DFF / 32) * (DM / 64);
        for (int r = gw; r < I4; r += NGW) { const int nblk = 2 * DFF / 32, kb = r / nblk, nb = r % nblk, n0 = nb * 32, pn = n0 >> 8, w = n0 & 255;
            const float* src = (w < 128 ? a.in[12] : a.in[13]) + (size_t)l * DM * DFF;
            cvt_item_i8(src, DFF, pn * 128 + (w & 127) + (lane & 31), g_ffn, (const unsigned*)(ws + WS_CMAX) + (size_t)l * 2 * DFF + n0, (float*)(ws + WS_CS8) + n0, ws + WS_WGU + (size_t)n0 * DM, DM, kb * 64, scr, lane); } }
}
#ifdef XMAPALL
#define DSA_ITEM_B (qi & 3)
#define DSA_ITEM_JT (255 - ((qi >> 2) * 8 + x))
#else
#define DSA_ITEM_B (x >> 1)
#define DSA_ITEM_JT (2 * (127 - qi) + (x & 1))
#endif
#if defined(XSTAG) || defined(ISTAG)
#ifndef XSTAG
#define XSTAG 0
#endif
#ifndef ISTAG
#define ISTAG 0
#endif
#define XSTAGGER() do { const unsigned long long t0_ = __builtin_amdgcn_s_memrealtime(); const unsigned long long d_ = (unsigned long long)(bar.x & 7u) * (XSTAG) + (unsigned long long)((bx >> 3) & 3) * (ISTAG); \
        while (__builtin_amdgcn_s_memrealtime() - t0_ < d_) __builtin_amdgcn_s_sleep(2); } while (0)
#else
#define XSTAGGER() do {} while (0)
#endif
#ifndef PH_MASK
#define PH_MASK 2047
#endif
#ifndef GEMM_ALIGN
#define GEMM_ALIGN true
#endif
#ifndef GEMM_SP2
#define GEMM_SP2 true
#endif
#ifndef DUPM
#define DUPM 0
#endif
#ifndef PREFIX_MASK
#define PREFIX_MASK 0
#endif
#ifndef REP0
#define REP0 1
#endif
#ifndef REP1
#define REP1 1
#endif
#ifndef REP4
#define REP4 1
#endif
#ifndef REP6
#define REP6 1
#endif
#if defined(__HIP_DEVICE_COMPILE__)
__device__ __forceinline__ CArgs& kargs() { CArgs* p = (CArgs*)__builtin_amdgcn_kernarg_segment_ptr(); asm volatile("" : "+s"(p)); return *p; }
#else
__device__ CArgs& kargs();
#endif
__global__ void __launch_bounds__(NWAVES * 64, 2) hybrid_fwd(Args args_unused) {
    extern __shared__ __attribute__((aligned(16))) unsigned char lds_raw[];
    LAS unsigned char* lds = (LAS unsigned char*)lds_raw;
    volatile LAS unsigned* MISC = (volatile LAS unsigned*)(lds + MISC_OFF);
    const int wave = __builtin_amdgcn_readfirstlane((int)(threadIdx.x >> 6));
    const int G = gridDim.x, bx = blockIdx.x;
    const int vcu = (bx & 7) * (G >> 3) + (bx >> 3);
    gu32* ctl = (gu32*)(kargs().ws + WS_CTL);
    for (int u = threadIdx.x; u < (LDS_BYTES - RING_BYTES) / 4; u += NWAVES * 64) ((LAS unsigned*)(lds + RING_BYTES))[u] = 0u;
    __syncthreads();
    XcdBarrier bar = xcd_barrier_post((unsigned*)(ctl + CW_BAR), MISC + 8);
#ifdef MFMABENCH
    {
        typedef float bf4 __attribute__((ext_vector_type(4))); typedef __bf16 bb8 __attribute__((ext_vector_type(8))); typedef int bi8 __attribute__((ext_vector_type(8)));
        bf4 q0 = {0.f, 0.f, 0.f, 0.f}, q1 = q0, q2 = q0, q3 = q0, q4 = q0, q5 = q0, q6 = q0, q7 = q0;
        long xl = 0x3838383838383838L, yl = 0x3838383838383838L; asm volatile("" : "+v"(xl), "+v"(yl));
        bi8 x8 = {0x38383838, 0x38383838, 0x38383838, 0x38383838, 0x38383838, 0x38383838, 0x38383838, 0x38383838}, y8 = x8; asm volatile("" : "+v"(x8), "+v"(y8));
        bb8 xb8, yb8; { bi8 t = x8; xb8 = *(bb8*)&t; yb8 = xb8; } asm volatile("" : "+v"(xb8), "+v"(yb8));
#pragma unroll 1
        for (int it = 0; it < 4096; ++it) {
#if MFMABENCH == 1
#define MB_(q) q = __builtin_amdgcn_mfma_f32_16x16x32_bf16(xb8, yb8, q, 0, 0, 0)
#elif MFMABENCH == 2
#define MB_(q) q = __builtin_amdgcn_mfma_f32_16x16x32_fp8_fp8(xl, yl, q, 0, 0, 0)
#else
#define MB_(q) q = __builtin_amdgcn_mfma_scale_f32_16x16x128_f8f6f4(x8, y8, q, 0, 0, 0, 127, 0, 127)
#endif
            MB_(q0); MB_(q1); MB_(q2); MB_(q3); MB_(q4); MB_(q5); MB_(q6); MB_(q7);
#undef MB_
        }
        asm volatile("" :: "v"(q0), "v"(q1), "v"(q2), "v"(q3), "v"(q4), "v"(q5), "v"(q6), "v"(q7));
    }
#endif

    constexpr size_t SEG_E = SEG_BYTES / 2;
#ifdef PROBE
    unsigned long long tprev = __builtin_amdgcn_s_memrealtime(); float tac0 = 0.f, tac1 = 0.f, tac2 = 0.f, tac3 = 0.f, tac4 = 0.f, tac5 = 0.f, tac6 = 0.f, tac7 = 0.f, tac8 = 0.f, tac9 = 0.f;
#define STAMP(v_) do { const unsigned long long now_ = __builtin_amdgcn_s_memrealtime(); v_ += (float)(now_ - tprev); tprev = now_; } while (0)
#else
#define STAMP(v_) do { } while (0)
#endif
#define PH_PTRS() CArgs& args = kargs(); unsigned char* ws = args.ws; bf16* xb = (bf16*)(ws + WS_XB); bf16* proj = (bf16*)(ws + WS_PROJ); bf16* dsakv = (bf16*)(ws + WS_DSAKV); float* small = (float*)(ws + WS_SMALL); \
        pg8::ssq_t* ssA = (pg8::ssq_t*)(ws + WS_SS) + (size_t)(2 * l) * M; pg8::ssq_t* ssB = ssA + M; pg8::ssq_t* ssN = ssB + M; (void)xb; (void)proj; (void)dsakv; (void)small; (void)ssA; (void)ssB; (void)ssN; (void)args
#pragma unroll 1
    for (int l = 0; l < DEPTH; ++l) {
#pragma unroll 1
        for (int rep = 0; rep < REP0; ++rep) {
#if PH_MASK & 1
        { PH_PTRS(); p0_prologue(args, l, lds, vcu, G * NWAVES, wave); }
#endif
        xcd_barrier(bar);
        }
        STAMP(tac0);
#ifdef REPB
        for (int rb = 0; rb < REPB; ++rb) xcd_barrier(bar);
#endif
#pragma unroll 1
        for (int pass = (PREFIX_MASK ? 0 : 1); pass < 2; ++pass) {
        const int mixmask = pass ? 7 : PREFIX_MASK;
#pragma unroll 1
        for (int rep = 0; rep < REP1; ++rep) {
#if PH_MASK & 2
        {   PH_PTRS(); pg8::Gemm g{xb, (const bf16*)(ws + WS_WIN), M, NIN, DM, 0, wave}; pg8::StaticOrder S; S.init(M, NIN, G, bx);
            pg8::EpiInProj E{proj, dsakv, small, ssA};
            XSTAGGER(); pg8::gemm_phase<pg8::EpiInProj, pg8::StaticOrder, GEMM_ALIGN, GEMM_SP2>(lds, g, S, E); }
#endif
        xcd_barrier(bar);
        }
        STAMP(tac1);
#if PH_MASK & 4
        { PH_PTRS(); p2_post(args, l, lds, wave); wq_items(args, l, lds, vcu, G * NWAVES, wave); }
#endif
        xcd_barrier(bar);
        STAMP(tac2);
        {   PH_PTRS(); const float* cl = (const float*)(ws + WS_CL); const float* ctot = (const float*)(ws + WS_CTOT);
            att::lchar* al = (att::lchar*)lds;
            gu32* qh = (gu32*)(ws + WS_CTL) + CW_QUEUE + (l * 2 + pass) * 512;
            int x = (int)(bar.x & 7u), empties = 0;
            for (;;) {
                if (wave == 0 && lane_id() == 0) MISC[12] = __hip_atomic_fetch_add(qh + 64 * x, 1u, RLX_AGENT);
                __syncthreads();
                const int qi = (int)MISC[12];
                __syncthreads();
                if (qi >= 384) { if (++empties == 8) break; x = (x + 1) & 7; continue; }
                if (qi < 128) {
#if PH_MASK & 32
#if DUPM & 4
                    att::dsa_item(al, proj + 7 * SEG_E, (const bf16*)(ws + WS_IDXK), (const float*)(ws + WS_IDXW), proj + 6 * SEG_E, dsakv, (bf16*)(ws + WS_DUMMY), (unsigned*)(ws + WS_DMASK) + (size_t)bx * 8192, (unsigned*)(ws + WS_DSCR) + (size_t)bx * 16384, (bf16*)(ws + WS_DUMMY), (unsigned*)(ws + WS_CTL) + 64, args.in[6] + l * 128, args.in[7] + l * 128, (const float*)(ws + WS_TAB), DSA_ITEM_B, DSA_ITEM_JT, wave);
#endif
                    if (mixmask & 4) att::dsa_item(al, proj + 7 * SEG_E, (const bf16*)(ws + WS_IDXK), (const float*)(ws + WS_IDXW), proj + 6 * SEG_E, dsakv, proj + 6 * SEG_E, (unsigned*)(ws + WS_DMASK) + (size_t)bx * 8192, (unsigned*)(ws + WS_DSCR) + (size_t)bx * 16384, (bf16*)(ws + WS_DUMMY), (unsigned*)(ws + WS_CTL) + 64, args.in[6] + l * 128, args.in[7] + l * 128, (const float*)(ws + WS_TAB), DSA_ITEM_B, DSA_ITEM_JT, wave);
#endif
                } else if (qi < 256) {
#if PH_MASK & 16
                    const int u = qi - 128, bh = x + 8 * (u & 3);
#if DUPM & 2
                    att::dense_unit<1>(al, proj + 3 * SEG_E, proj + 4 * SEG_E, proj + 5 * SEG_E, (bf16*)(ws + WS_DUMMY), cl, ctot, args.in[4] + l * 128, args.in[5] + l * 128, bh >> 3, bh & 7, 31 - (u >> 2), wave);
#endif
                    if (mixmask & 2) att::dense_unit<1>(al, proj + 3 * SEG_E, proj + 4 * SEG_E, proj + 5 * SEG_E, proj + 3 * SEG_E, cl, ctot, args.in[4] + l * 128, args.in[5] + l * 128, bh >> 3, bh & 7, 31 - (u >> 2), wave);
#endif
                } else {
#if PH_MASK & 8
                    const int u = qi - 256, bh = x + 8 * (u & 3);
#if DUPM & 1
                    att::dense_unit<0>(al, proj + 0 * SEG_E, proj + 1 * SEG_E, proj + 2 * SEG_E, (bf16*)(ws + WS_DUMMY), cl, ctot, nullptr, nullptr, bh >> 3, bh & 7, 31 - (u >> 2), wave);
#endif
                    if (mixmask & 1) att::dense_unit<0>(al, proj + 0 * SEG_E, proj + 1 * SEG_E, proj + 2 * SEG_E, proj + 0 * SEG_E, cl, ctot, nullptr, nullptr, bh >> 3, bh & 7, 31 - (u >> 2), wave);
#endif
                }
            }
        }
        xcd_barrier(bar);
#if I8BR
        { PH_PTRS(); p3b_quant(args, l, lds, vcu, G * NWAVES, wave); }
        xcd_barrier(bar);
#endif
        STAMP(tac5);
        }
#pragma unroll 1
        for (int rep = 0; rep < REP4; ++rep) {
        {   PH_PTRS(); pg8::MergedOrder S{bx};
#if PH_MASK & 64
#if I8BR
            {   pg8::Gemm g{(const bf16*)(ws + WS_OB8), (const bf16*)(ws + WS_WB), M, 6144, 512, 32 * MiB, wave, WS_OB8_2 - WS_OB8, true};
                pg8::EpiBranch<true> E{proj + SEG_E, 3 * SEG_E, (const float*)(ws + WS_RSB), (const float*)(ws + WS_CSB)};
                XSTAGGER(); pg8::gemm_phase<pg8::EpiBranch<true>, pg8::MergedOrder, GEMM_ALIGN, GEMM_SP2, 2>(lds, g, S, E); }
#else
            {   pg8::Gemm g{proj, (const bf16*)(ws + WS_WB), M, 6144, 1024, 3 * SEG_BYTES, wave};
                pg8::EpiBranch<false> E{proj + SEG_E, 3 * SEG_E, nullptr, nullptr};
                XSTAGGER(); pg8::gemm_phase<pg8::EpiBranch<false>, pg8::MergedOrder, GEMM_ALIGN, GEMM_SP2>(lds, g, S, E); }
#endif
#endif
#ifdef REP4B
            {   pg8::Gemm g{proj, (const bf16*)(ws + WS_WB), M, 6144, 1024, 3 * SEG_BYTES, wave};
                pg8::EpiBranch<false> E{(bf16*)(ws + WS_DUMMY), 0, nullptr, nullptr};
                XSTAGGER(); pg8::gemm_phase<pg8::EpiBranch<false>, pg8::MergedOrder, GEMM_ALIGN, GEMM_SP2>(lds, g, S, E); }
#endif
#ifdef REP4G
            {   pg8::Gemm g{xb, (const bf16*)(ws + WS_WG), M, 6144, DM, 0, wave};
                pg8::EpiGate<false> E{(bf16*)(ws + WS_DUMMY), 0, ssA, 0.f, nullptr, nullptr};
                XSTAGGER(); pg8::gemm_phase<pg8::EpiGate<false>, pg8::MergedOrder, GEMM_ALIGN, GEMM_SP2>(lds, g, S, E); }
#endif
#if PH_MASK & 128
#if I8GATE
            {   pg8::Gemm g{(const bf16*)(ws + WS_H8), (const bf16*)(ws + WS_WG), M, 6144, DM / 2, 0, wave};
                pg8::EpiGate<true> E{proj + SEG_E, 3 * SEG_E, ssA, 0.f, (const float*)(ws + WS_RSG), (const float*)(ws + WS_CSG)};
                XSTAGGER(); pg8::gemm_phase<pg8::EpiGate<true>, pg8::MergedOrder, GEMM_ALIGN, GEMM_SP2, 2>(lds, g, S, E); }
#else
            {   pg8::Gemm g{(const bf16*)(ws + WS_H8), (const bf16*)(ws + WS_WG), M, 6144, DM / 2, 0, wave};
                pg8::EpiGate<false> E{proj + SEG_E, 3 * SEG_E, ssA, 1.0f / 2048.0f, nullptr, nullptr};
                XSTAGGER(); pg8::gemm_phase<pg8::EpiGate<false>, pg8::MergedOrder, GEMM_ALIGN, GEMM_SP2, 1>(lds, g, S, E); }
#endif
#endif
        }
        xcd_barrier(bar);
        }
        STAMP(tac6);
#if PH_MASK & 256
        {   PH_PTRS(); pg8::Gemm g{proj + SEG_E, (const bf16*)(ws + WS_WO), M, DM, DM, 0, wave}; pg8::StaticOrder S; S.init(M, DM, G, bx);
#ifdef REP5
            { pg8::EpiResid<false> E0{xb, nullptr, ssB + ((size_t)885 << 18), (bf16*)(ws + WS_DUMMY), 1.0f};
              XSTAGGER(); pg8::gemm_phase<pg8::EpiResid<false>, pg8::StaticOrder, GEMM_ALIGN, GEMM_SP2>(lds, g, S, E0); xcd_barrier(bar); }
#endif
            pg8::EpiResid<false> E{xb, nullptr, ssB, xb, 1.0f};
            XSTAGGER(); pg8::gemm_phase<pg8::EpiResid<false>, pg8::StaticOrder, GEMM_ALIGN, GEMM_SP2>(lds, g, S, E); }
#endif
        xcd_barrier(bar);
#if I8FFN
        { PH_PTRS(); p5b_quant(args, l, lds, vcu, G * NWAVES, wave); }
        xcd_barrier(bar);
#endif
        STAMP(tac7);
#pragma unroll 1
        for (int rep = 0; rep < REP6; ++rep) {
#if PH_MASK & 512
        {   PH_PTRS(); pg8::StaticOrder S; S.init(M, 2 * DFF, G, bx);
#if I8FFN
            pg8::Gemm g{(const bf16*)(ws + WS_H8), (const bf16*)(ws + WS_WGU), M, 2 * DFF, DM / 2, 0, wave};
            pg8::EpiSwiGLU<true> E{proj, ssB, F8DOWN(l) ? (unsigned char*)proj : nullptr, (const float*)(ws + WS_RS8), (const float*)(ws + WS_CS8)};
            XSTAGGER(); pg8::gemm_phase<pg8::EpiSwiGLU<true>, pg8::StaticOrder, GEMM_ALIGN, GEMM_SP2, 2>(lds, g, S, E); }
#else
            pg8::Gemm g{xb, (const bf16*)(ws + WS_WGU), M, 2 * DFF, DM, 0, wave};
            pg8::EpiSwiGLU<false> E{proj, ssB, F8DOWN(l) ? (unsigned char*)proj : nullptr, nullptr, nullptr};
            XSTAGGER(); pg8::gemm_phase<pg8::EpiSwiGLU<false>, pg8::StaticOrder, GEMM_ALIGN, GEMM_SP2>(lds, g, S, E); }
#endif
#endif
        xcd_barrier(bar);
        }
        STAMP(tac8);
#if PH_MASK & 1024
        {   PH_PTRS(); pg8::StaticOrder S; S.init(M, DM, G, bx);
            constexpr bool F8I = F8DOWN_INNER != 0, F8L = F8DOWN_LAST != 0;
            if (l + 1 < DEPTH) { pg8::Gemm g{proj, (const bf16*)(ws + WS_WD), M, DM, F8I ? DFF / 2 : DFF, 0, wave}; pg8::EpiResid<false> E{xb, nullptr, ssN, xb, F8I ? 1.0f / 4096.0f : 1.0f};
                XSTAGGER(); pg8::gemm_phase<pg8::EpiResid<false>, pg8::StaticOrder, GEMM_ALIGN, GEMM_SP2, F8I>(lds, g, S, E); }
            else { pg8::Gemm g{proj, (const bf16*)(ws + WS_WD), M, DM, F8L ? DFF / 2 : DFF, 0, wave}; pg8::EpiResid<true> E{xb, args.out, nullptr, nullptr, F8L ? 1.0f / 4096.0f : 1.0f};
                XSTAGGER(); pg8::gemm_phase<pg8::EpiResid<true>, pg8::StaticOrder, GEMM_ALIGN, GEMM_SP2, F8L>(lds, g, S, E); } }
#endif
        if (l + 1 < DEPTH) xcd_barrier(bar);
        STAMP(tac9);
    }
#if DSA_CHECK
    xcd_barrier(bar);
    if (bx == 0 && wave == 0 && lane_id() == 0 && __hip_atomic_load((unsigned*)(kargs().ws + WS_CTL) + 64, RLX_AGENT) != 0u) kargs().out[0] = 3.0e6f;
#endif
#ifdef PROBE
    xcd_barrier(bar);
    if (bx == 0) {
        const float tt[10] = {tac0, tac1, tac2, tac3, tac4, tac5, tac6, tac7, tac8, tac9};
        float ta = 0.f, tb = 0.f;
#pragma unroll
        for (int i = 0; i < 10; ++i) { if ((PROBE_A >> i) & 1) ta += tt[i]; if (PROBE_B >= 0 && ((PROBE_B >> i) & 1)) tb += tt[i]; }
        const float v = ta * 0.01f * 10.f; const int n = PROBE_B < 0 ? 1000000 : (int)(tb * 0.01f * 1000.f);
        float* o = kargs().out;
        for (int i = wave * 64 + lane_id(); i < n; i += NWAVES * 64) o[i] = v;
    }
#endif
}

extern "C" void kernel_launch(void* const* d_in, const int* in_sizes, int n_in, void* d_out, int out_size, void* d_ws, size_t ws_size, hipStream_t stream) {
    static int grid = 0;
    if (grid == 0) {
        if (n_in != 15 || in_sizes[0] != M * DM || out_size != M * DM || ws_size < WS_TOTAL) { fprintf(stderr, "kernel_launch: shape/workspace mismatch (n_in %d, ws %zu)\n", n_in, ws_size); grid = -1; return; }
        int dev = 0, cus = 0;
        if (hipGetDevice(&dev) != hipSuccess || hipDeviceGetAttribute(&cus, hipDeviceAttributeMultiprocessorCount, dev) != hipSuccess) { grid = -1; return; }
        if (hipFuncSetAttribute((const void*)hybrid_fwd, hipFuncAttributeMaxDynamicSharedMemorySize, LDS_BYTES) != hipSuccess) { fprintf(stderr, "kernel_launch: hipFuncSetAttribute failed\n"); grid = -1; return; }
        int per_cu = 0;
        if (hipOccupancyMaxActiveBlocksPerMultiprocessor(&per_cu, (const void*)hybrid_fwd, NWAVES * 64, LDS_BYTES) != hipSuccess || per_cu < 1) fprintf(stderr, "kernel_launch: occupancy query reports %d\n", per_cu);
        (void)hipGetLastError();
        if (cus < 256) { fprintf(stderr, "kernel_launch: needs 256 CUs, device has %d\n", cus); grid = -1; return; }
        grid = 256;
    }
    if (grid < 0) return;
    if (hipMemsetAsync((char*)d_ws + WS_CTL, 0, CTL_ZERO_BYTES, stream) != hipSuccess) return;
    Args a{};
    for (int i = 0; i < 15; ++i) a.in[i] = (const float*)d_in[i];
    a.out = (float*)d_out; a.ws = (unsigned char*)d_ws;
    hipLaunchKernelGGL(hybrid_fwd, dim3(grid), dim3(NWAVES * 64), LDS_BYTES, stream, a);
}
```
